# Optimizing an MI355X kernel written in HIP

```python
import math
import jax, jax.numpy as jnp
from jax import lax
import numpy as np

D_MODEL = 1024
BATCH = 4
SEQ = 8192
DEPTH = 1

HEAD_DIM = 64
N_HEADS = D_MODEL // HEAD_DIM
D_MIX = N_HEADS * HEAD_DIM
DIL_HEADS = 6
NSA_HEADS = N_HEADS - DIL_HEADS
DIL_PATTERNS = ((128, 1), (512, 4), (2048, 16))
NSA_KV_HEADS = 2
NSA_GROUP = NSA_HEADS // NSA_KV_HEADS
CMP_BLOCK = 32
CMP_STRIDE = 16
CMP_HIDDEN = 256
SEL_BLOCK = 64
SEL_TOPK = 16
WIN = 512
FORCE_SCORE = 1.0e4
N_BUCKETS = 32
MAX_DISTANCE = 2048
N_GROUPS = 4
EXPERTS_PER_GROUP = 4
N_EXPERTS = N_GROUPS * EXPERTS_PER_GROUP
D_EXPERT = 512
TOPK_IN_GROUP = 2
Q_BLOCK = 128
EPS = 1e-6
N_IN = 3 * DIL_HEADS * HEAD_DIM + NSA_HEADS * HEAD_DIM + 6 * NSA_KV_HEADS * HEAD_DIM + 3 * NSA_HEADS

kernel_name = "hybrid_dilated_nsa_hiermoe"


def rmsnorm(x, g):
    xf = x.astype(jnp.float32)
    y = xf * lax.rsqrt(jnp.mean(xf * xf, axis=-1, keepdims=True) + EPS)
    return (y * g.astype(jnp.float32)).astype(x.dtype)


def t5_bucket(dist):
    dist = jnp.maximum(dist, 0)
    max_exact = N_BUCKETS // 2
    large = max_exact + (jnp.log(jnp.maximum(dist, 1).astype(jnp.float32) / max_exact)
                         / math.log(MAX_DISTANCE / max_exact) * (N_BUCKETS - max_exact)).astype(jnp.int32)
    large = jnp.minimum(large, N_BUCKETS - 1)
    return jnp.where(dist < max_exact, dist, large)


def masked_softmax(s, mask, axis):
    s = jnp.where(mask, s, -jnp.inf)
    m = jnp.max(s, axis=axis, keepdims=True)
    m = jnp.where(jnp.isfinite(m), m, 0.0)
    e = jnp.where(mask, jnp.exp(s - m), 0.0)
    den = jnp.sum(e, axis=axis, keepdims=True)
    p = e / jnp.maximum(den, 1e-30)
    return p, m + jnp.log(den)


def compress(tok, pos_emb, w1, w2, n_cmp):
    B = tok.shape[0]
    idx = jnp.arange(n_cmp)[:, None] * CMP_STRIDE + jnp.arange(CMP_BLOCK)[None, :]
    blocks = jnp.take(tok, idx, axis=1) + pos_emb[None, None, :, None, :]
    flat = blocks.transpose(0, 1, 3, 2, 4).reshape(B, n_cmp, NSA_KV_HEADS, CMP_BLOCK * HEAD_DIM)
    return jax.nn.gelu(flat @ w1) @ w2


def hybrid_mixer(xn, w_in, w_out, cmp_pos_k, cmp_pos_v, cmp_k_w1, cmp_k_w2, cmp_v_w1, cmp_v_w2, rel_bias):
    B, T, _ = xn.shape
    scale = 1.0 / math.sqrt(HEAD_DIM)
    proj = xn @ w_in
    sizes = [DIL_HEADS * HEAD_DIM] * 3 + [NSA_HEADS * HEAD_DIM] + [NSA_KV_HEADS * HEAD_DIM] * 6 + [3 * NSA_HEADS]
    parts = jnp.split(proj, np.cumsum(sizes)[:-1].tolist(), axis=-1)
    q_a, k_a, v_a = [p.reshape(B, T, DIL_HEADS, HEAD_DIM) for p in parts[:3]]
    q_b = parts[3].reshape(B, T, NSA_KV_HEADS, NSA_GROUP, HEAD_DIM)
    k_ct, v_ct, k_s, v_s, k_w, v_w = [p.reshape(B, T, NSA_KV_HEADS, HEAD_DIM) for p in parts[4:10]]
    gates = jax.nn.sigmoid(parts[10].astype(jnp.float32)).reshape(B, T, NSA_KV_HEADS, NSA_GROUP, 3)

    bias_a = rel_bias[:, :DIL_HEADS].T
    bias_b = rel_bias[:, DIL_HEADS:].T.reshape(NSA_KV_HEADS, NSA_GROUP, N_BUCKETS)

    n_cmp = (T - CMP_BLOCK) // CMP_STRIDE + 1
    k_cmp = compress(k_ct, cmp_pos_k, cmp_k_w1, cmp_k_w2, n_cmp)
    v_cmp = compress(v_ct, cmp_pos_v, cmp_v_w1, cmp_v_w2, n_cmp)
    cmp_start = jnp.arange(n_cmp) * CMP_STRIDE
    cmp_end = cmp_start + CMP_BLOCK - 1
    n_sel = T // SEL_BLOCK
    n_top = min(SEL_TOPK, n_sel)
    sel_start = jnp.arange(n_sel) * SEL_BLOCK
    overlap = jnp.clip(jnp.minimum(cmp_start[:, None] + CMP_BLOCK, sel_start[None, :] + SEL_BLOCK)
                       - jnp.maximum(cmp_start[:, None], sel_start[None, :]), 0).astype(jnp.float32) / CMP_BLOCK
    k_sel_blocks = k_s.reshape(B, n_sel, SEL_BLOCK, NSA_KV_HEADS, HEAD_DIM).transpose(0, 3, 1, 2, 4)
    v_sel_blocks = v_s.reshape(B, n_sel, SEL_BLOCK, NSA_KV_HEADS, HEAD_DIM).transpose(0, 3, 1, 2, 4)
    pad = ((0, 0), (WIN, 0), (0, 0), (0, 0))
    k_w_pad = jnp.pad(k_w, pad)
    v_w_pad = jnp.pad(v_w, pad)

    bi = jnp.arange(B)[:, None, None]
    hi = jnp.arange(NSA_KV_HEADS)[None, :, None]
    hi6 = jnp.arange(NSA_KV_HEADS)[None, :, None, None, None, None]
    gi6 = jnp.arange(NSA_GROUP)[None, None, :, None, None, None]

    def block_fn(b):
        t0 = b * Q_BLOCK
        t = t0 + jnp.arange(Q_BLOCK)
        qa = lax.dynamic_slice_in_dim(q_a, t0, Q_BLOCK, axis=1)
        outs, lses = [], []
        for (w, d) in DIL_PATTERNS:
            dist = d * jnp.arange(w // d + 1)
            idx = t[:, None] - dist[None, :]
            valid = idx >= 0
            idx = jnp.maximum(idx, 0)
            kg = jnp.take(k_a, idx, axis=1)
            vg = jnp.take(v_a, idx, axis=1)
            s = jnp.einsum('bqhd,bqkhd->bhqk', qa, kg, preferred_element_type=jnp.float32) * scale
            s = s + bias_a[:, t5_bucket(dist)][None, :, None, :].astype(jnp.float32)
            p, lse = masked_softmax(s, valid[None, None], -1)
            outs.append(jnp.einsum('bhqk,bqkhd->bqhd', p, vg))
            lses.append(lse)
        wts = jax.nn.softmax(jnp.stack(lses, axis=0), axis=0)
        o_a = sum(jnp.swapaxes(wts[i], 1, 2) * outs[i] for i in range(len(DIL_PATTERNS)))

        qb = lax.dynamic_slice_in_dim(q_b, t0, Q_BLOCK, axis=1)
        dist_c = t[:, None] - cmp_end[None, :]
        s_c = jnp.einsum('bqkgd,bnkd->bkgqn', qb, k_cmp, preferred_element_type=jnp.float32) * scale
        s_c = s_c + bias_b[:, :, t5_bucket(dist_c)][None].astype(jnp.float32)
        p_c, _ = masked_softmax(s_c, (dist_c >= 0)[None, None, None], -1)
        o_c = jnp.einsum('bkgqn,bnkd->bqkgd', p_c, v_cmp)
        imp = jnp.einsum('bkgqn,ns->bkqs', p_c, overlap)
        blk = jnp.arange(n_sel)[None, :]
        cur = (t // SEL_BLOCK)[:, None]
        forced = (blk == cur) | (blk == cur - 1) | (blk == 0)
        imp = jnp.where(forced, FORCE_SCORE, jnp.where(blk <= cur, imp, -1.0))
        _, sel = lax.top_k(imp, n_top)
        sel_flat = sel.reshape(B, NSA_KV_HEADS, Q_BLOCK * n_top)
        kg = k_sel_blocks[bi, hi, sel_flat].reshape(B, NSA_KV_HEADS, Q_BLOCK, n_top, SEL_BLOCK, HEAD_DIM)
        vg = v_sel_blocks[bi, hi, sel_flat].reshape(B, NSA_KV_HEADS, Q_BLOCK, n_top, SEL_BLOCK, HEAD_DIM)
        pos = sel[..., None] * SEL_BLOCK + jnp.arange(SEL_BLOCK)
        dist_s = t[None, None, :, None, None] - pos
        s_s = jnp.einsum('bqkgd,bkqnld->bkgqnl', qb, kg, preferred_element_type=jnp.float32) * scale
        s_s = s_s + bias_b[hi6, gi6, t5_bucket(dist_s)[:, :, None]].astype(jnp.float32)
        flat_shape = (B, NSA_KV_HEADS, NSA_GROUP, Q_BLOCK, n_top * SEL_BLOCK)
        mask_s = jnp.broadcast_to((dist_s >= 0)[:, :, None], s_s.shape).reshape(flat_shape)
        p_s, _ = masked_softmax(s_s.reshape(flat_shape), mask_s, -1)
        p_s = p_s.reshape(s_s.shape)
        o_s = jnp.einsum('bkgqnl,bkqnld->bqkgd', p_s, vg)
        kw = lax.dynamic_slice_in_dim(k_w_pad, t0, Q_BLOCK + WIN, axis=1)
        vw = lax.dynamic_slice_in_dim(v_w_pad, t0, Q_BLOCK + WIN, axis=1)
        s_pos = t0 - WIN + jnp.arange(Q_BLOCK + WIN)
        dist_w = t[:, None] - s_pos[None, :]
        mask_w = (dist_w >= 0) & (dist_w < WIN) & (s_pos[None, :] >= 0)
        s_w = jnp.einsum('bqkgd,bskd->bkgqs', qb, kw, preferred_element_type=jnp.float32) * scale
        s_w = s_w + bias_b[:, :, t5_bucket(dist_w)][None].astype(jnp.float32)
        p_w, _ = masked_softmax(s_w, mask_w[None, None, None], -1)
        o_w = jnp.einsum('bkgqs,bskd->bqkgd', p_w, vw)
        g = lax.dynamic_slice_in_dim(gates, t0, Q_BLOCK, axis=1)
        o_b = g[..., 0:1] * o_c + g[..., 1:2] * o_s + g[..., 2:3] * o_w
        return jnp.concatenate([o_a.reshape(B, Q_BLOCK, DIL_HEADS * HEAD_DIM),
                                o_b.reshape(B, Q_BLOCK, NSA_HEADS * HEAD_DIM)], axis=-1)

    ys = lax.map(block_fn, jnp.arange(T // Q_BLOCK))
    y = ys.transpose(1, 0, 2, 3).reshape(B, T, D_MIX).astype(xn.dtype)
    return (y @ w_out).astype(xn.dtype)


def hier_moe(h, w_router_group, b_router_group, w_router_expert, b_router_expert, w_gate, w_up, w_down):
    B, T, D = h.shape
    xf = h.reshape(B * T, D)
    g_logits = (xf @ w_router_group + b_router_group).astype(jnp.float32)
    g_idx = jnp.argmax(g_logits, axis=-1)
    g_prob = jnp.take_along_axis(jax.nn.softmax(g_logits, axis=-1), g_idx[:, None], axis=1)[:, 0]
    e_logits = (jnp.einsum('nd,dge->nge', xf, w_router_expert) + b_router_expert).astype(jnp.float32)
    e_logits = jnp.take_along_axis(e_logits, g_idx[:, None, None], axis=1)[:, 0]
    top_v, top_i = lax.top_k(e_logits, TOPK_IN_GROUP)
    e_prob = jax.nn.softmax(top_v, axis=-1)
    expert_id = g_idx[:, None] * EXPERTS_PER_GROUP + top_i
    combine = g_prob[:, None] * jnp.sum(e_prob[..., None] * jax.nn.one_hot(expert_id, N_EXPERTS, dtype=jnp.float32), axis=1)
    y = jnp.zeros(xf.shape, jnp.float32)
    for e in range(N_EXPERTS):
        he = jax.nn.silu(xf @ w_gate[e]) * (xf @ w_up[e])
        y = y + combine[:, e:e + 1] * (he @ w_down[e])
    return y.reshape(B, T, D).astype(h.dtype)


def setup_inputs(seed: int = 0) -> dict:
    key = jax.random.key(seed)
    ks = jax.random.split(key, 20)
    f32 = jnp.float32
    nrm = lambda k, shape, s: s * jax.random.normal(k, shape, f32)
    L = DEPTH
    return {
        "x": jax.random.normal(ks[0], (BATCH, SEQ, D_MODEL), f32),
        "rel_bias": nrm(ks[1], (N_BUCKETS, N_HEADS), 0.1),
        "norm_mix": 1.0 + nrm(ks[2], (L, D_MODEL), 0.02),
        "w_in": nrm(ks[3], (L, D_MODEL, N_IN), D_MODEL ** -0.5),
        "w_out": nrm(ks[4], (L, D_MIX, D_MODEL), D_MIX ** -0.5),
        "cmp_pos_k": nrm(ks[5], (L, CMP_BLOCK, HEAD_DIM), 0.1),
        "cmp_pos_v": nrm(ks[6], (L, CMP_BLOCK, HEAD_DIM), 0.1),
        "cmp_k_w1": nrm(ks[7], (L, CMP_BLOCK * HEAD_DIM, CMP_HIDDEN), (CMP_BLOCK * HEAD_DIM) ** -0.5),
        "cmp_k_w2": nrm(ks[8], (L, CMP_HIDDEN, HEAD_DIM), CMP_HIDDEN ** -0.5),
        "cmp_v_w1": nrm(ks[9], (L, CMP_BLOCK * HEAD_DIM, CMP_HIDDEN), (CMP_BLOCK * HEAD_DIM) ** -0.5),
        "cmp_v_w2": nrm(ks[10], (L, CMP_HIDDEN, HEAD_DIM), CMP_HIDDEN ** -0.5),
        "norm_ffn": 1.0 + nrm(ks[11], (L, D_MODEL), 0.02),
        "w_router_group": nrm(ks[12], (L, D_MODEL, N_GROUPS), D_MODEL ** -0.5),
        "b_router_group": nrm(ks[13], (L, N_GROUPS), 0.01),
        "w_router_expert": nrm(ks[14], (L, D_MODEL, N_GROUPS, EXPERTS_PER_GROUP), D_MODEL ** -0.5),
        "b_router_expert": nrm(ks[15], (L, N_GROUPS, EXPERTS_PER_GROUP), 0.01),
        "w_gate": nrm(ks[16], (L, N_EXPERTS, D_MODEL, D_EXPERT), D_MODEL ** -0.5),
        "w_up": nrm(ks[17], (L, N_EXPERTS, D_MODEL, D_EXPERT), D_MODEL ** -0.5),
        "w_down": nrm(ks[18], (L, N_EXPERTS, D_EXPERT, D_MODEL), D_EXPERT ** -0.5),
        "norm_final": 1.0 + nrm(ks[19], (D_MODEL,), 0.02),
    }


def reference(x, rel_bias, norm_mix, w_in, w_out, cmp_pos_k, cmp_pos_v, cmp_k_w1, cmp_k_w2,
              cmp_v_w1, cmp_v_w2, norm_ffn, w_router_group, b_router_group, w_router_expert,
              b_router_expert, w_gate, w_up, w_down, norm_final):
    h = x
    for l in range(DEPTH):
        h = h + hybrid_mixer(rmsnorm(h, norm_mix[l]), w_in[l], w_out[l], cmp_pos_k[l], cmp_pos_v[l],
                             cmp_k_w1[l], cmp_k_w2[l], cmp_v_w1[l], cmp_v_w2[l], rel_bias)
        h = h + hier_moe(rmsnorm(h, norm_ffn[l]), w_router_group[l], b_router_group[l],
                         w_router_expert[l], b_router_expert[l], w_gate[l], w_up[l], w_down[l])
    return rmsnorm(h, norm_final)
```

```cpp
#include <hip/hip_runtime.h>
#include <cstdio>
#include <cstdint>

#ifndef MK_N_LAUNCHES
#define MK_N_LAUNCHES 1
#endif

typedef unsigned short bf16_t;
typedef short bf16x8 __attribute__((ext_vector_type(8)));
typedef float f32x4 __attribute__((ext_vector_type(4)));
typedef float f32x2 __attribute__((ext_vector_type(2)));
typedef float f32x16 __attribute__((ext_vector_type(16)));
typedef unsigned u32x4 __attribute__((ext_vector_type(4)));
typedef unsigned u32x2 __attribute__((ext_vector_type(2)));
#define LAS __attribute__((address_space(3)))
#define GAS __attribute__((address_space(1)))

constexpr int BATCH = 4, SEQ = 8192, M = BATCH * SEQ, D = 1024, NIN = 2590, NP = 2816;
constexpr int C_QA = 0, C_KA = 384, C_VA = 768, C_QB = 1152, C_KCT = 1792, C_VCT = 1920, C_KS = 2048, C_VS = 2176, C_KW = 2304, C_VW = 2432, C_GT = 2560;
constexpr int NCMP = 511;
constexpr float EPS = 1e-6f;
constexpr int NCLS = 24, MAXTILES = 152;
constexpr int NWAVES = 8, NTHR = 512;

constexpr size_t MiB = 1u << 20;
constexpr size_t WS_CTL = 0, CTL_ZERO_BYTES = 1 * MiB;
constexpr size_t WS_WIN = 2 * MiB;
constexpr size_t WS_WOUT = 8 * MiB;
constexpr size_t WS_CW1 = 10 * MiB;
constexpr size_t WS_CW2 = 12 * MiB;
constexpr size_t WS_CB1 = 12 * MiB + 256 * 1024;
constexpr size_t WS_WRH = 12 * MiB + 512 * 1024;
constexpr size_t WS_WRL = 12 * MiB + 640 * 1024;
constexpr size_t WS_RINFO = 13 * MiB;
constexpr size_t WS_ROWTOK = 13 * MiB + 512 * 1024;
constexpr size_t WS_ROWC = 14 * MiB;
constexpr size_t WS_WGU = 16 * MiB;
constexpr size_t WS_WD = 48 * MiB;
constexpr size_t WS_XN = 64 * MiB;
constexpr size_t WS_PROJ = 144 * MiB;
constexpr size_t WS_H1 = 322 * MiB;
constexpr size_t WS_KCMP = 326 * MiB;
constexpr size_t WS_VCMP = 326 * MiB + 512 * 1024;
constexpr size_t WS_IMP = 328 * MiB;
constexpr size_t WS_SEL = 360 * MiB;
constexpr size_t WS_MD = 364 * MiB;
constexpr size_t WS_VTS = 368 * MiB;
constexpr size_t WS_VTW = 376 * MiB;
constexpr size_t WS_VTA1 = 384 * MiB;
constexpr size_t WS_VTA4 = 408 * MiB;
constexpr size_t WS_VTA16 = 432 * MiB;
constexpr size_t WS_VCT = 456 * MiB;
constexpr size_t WS_KA1 = 328 * MiB;
constexpr size_t WS_KA4 = 457 * MiB;
constexpr size_t WS_KA16 = 481 * MiB;
constexpr size_t WS_HBF = 224 * MiB;
constexpr size_t WS_GATES = 505 * MiB;
constexpr size_t WS_END = 507 * MiB;

constexpr int CW_BAR = 4096;
constexpr int CW_HIST = 65536;
constexpr int CW_READY = 196608;
constexpr int CW_CMPDONE = 213760;
constexpr int CW_MIXQ = 212992;
constexpr int CW_PANEL = 131072;
constexpr size_t WS_RS1 = 15 * MiB + 768 * 1024;
constexpr size_t WS_XBUF = 15 * MiB;

constexpr int RING_BYTES = 131072;
constexpr int MISC_OFF = RING_BYTES;
constexpr int LDS_BYTES = 147456;

__device__ __forceinline__ unsigned f2bf(float f) { unsigned u = __builtin_bit_cast(unsigned, f); return (u + 0x7fffu + ((u >> 16) & 1u)) >> 16; }
__device__ __forceinline__ unsigned pk2(float lo, float hi) { return f2bf(lo) | (f2bf(hi) << 16); }
__device__ __forceinline__ float bf_lo(unsigned w) { return __builtin_bit_cast(float, w << 16); }
__device__ __forceinline__ float bf_hi(unsigned w) { return __builtin_bit_cast(float, w & 0xffff0000u); }
__device__ __forceinline__ float bf2f(bf16_t h) { return __builtin_bit_cast(float, (unsigned)h << 16); }
#define LDS_WAIT() asm volatile("s_waitcnt lgkmcnt(0)" ::: "memory")
#define VM_WAIT() asm volatile("s_waitcnt vmcnt(0)" ::: "memory")

__device__ __forceinline__ int t5_bucket(int dist) {
    if (dist < 16) return dist < 0 ? 0 : dist;
    int b = 16;
    b += dist >= 22; b += dist >= 30; b += dist >= 40; b += dist >= 54; b += dist >= 73; b += dist >= 99; b += dist >= 134; b += dist >= 182;
    b += dist >= 246; b += dist >= 332; b += dist >= 450; b += dist >= 609; b += dist >= 825; b += dist >= 1117; b += dist >= 1513;
    return b;
}
__device__ __forceinline__ float gelu_tanh(float x) {
    const float u = 0.7978845608028654f * (x + 0.044715f * x * x * x);
    const float e = __expf(2.f * u);
    const float th = 1.f - 2.f / (e + 1.f);
    return 0.5f * x * (1.f + th);
}

namespace pg8 {
constexpr int BM = 256, BK = 64, HALF = 128, HTB = HALF * BK * 2;
__host__ __device__ __forceinline__ int lds_byte(int r, int c) { const int st = (r >> 4) * 2 + (c >> 5), rr = r & 15, cc = c & 31, ob = rr * 64 + cc * 2; return st * 1024 + (ob ^ (((ob >> 9) & 1) << 5)); }
__host__ __device__ __forceinline__ void stage_rc(int b, int& R, int& C) { const int st = b / 1024, sb = b % 1024, swz = sb ^ (((sb >> 9) & 1) << 5); R = (st >> 1) * 16 + swz / 64; C = (st & 1) * 32 + (swz % 64) / 2; }
__host__ __device__ __forceinline__ int perm32(int rho) { const int n = rho >> 4, i = rho & 15; return 8 * (i >> 2) + 4 * n + (i & 3); }

struct Unit { const char* a; const char* b; long bjump; int orow, ocol, aux; const int* rows; };
struct Geo { unsigned lda, ldb, kstepA, kstepB; int nt, tjump; };

template <bool GATHER = false, class Epi, class Sched>
__device__ __forceinline__ void gemm_phase(LAS unsigned char* lds, const Geo g, const Sched& S, const Epi& E) {
    const int tid = threadIdx.x, wid = __builtin_amdgcn_readfirstlane(tid >> 6), lane = tid & 63, wr = wid >> 2, wc = wid & 3, fr = lane & 15, fq = lane >> 4;
    const int nt = g.nt;
    unsigned voffA[2], voffB[2];
#pragma unroll
    for (int i = 0; i < 2; ++i) { int R, C; stage_rc(tid * 16 + i * 8192, R, C); const int Rb = (R & ~31) + perm32(R & 31);
        voffA[i] = (unsigned)R * g.lda + (unsigned)C * 2u; voffB[i] = (unsigned)Rb * g.ldb + (unsigned)C * 2u; }
    unsigned gA[2][2] = {{0u, 0u}, {0u, 0u}}, ngA[2][2] = {{0u, 0u}, {0u, 0u}};
    auto gather_of = [&](const Unit& u, unsigned (&o)[2][2]) {
#pragma unroll
        for (int i = 0; i < 2; ++i) { int R, C; stage_rc(tid * 16 + i * 8192, R, C);
#pragma unroll
            for (int h = 0; h < 2; ++h) { const int t = u.rows[h * HALF + R]; o[h][i] = (unsigned)(t < 0 ? 0 : t) * g.lda + (unsigned)C * 2u; } } };
    const size_t kA = g.kstepA, kB = g.kstepB;
    const size_t hA = (size_t)HALF * g.lda, hB = (size_t)HALF * g.ldb;
    const unsigned ldsw = (unsigned)wid * 1024u;
    const int aoff = lds_byte(wr * 64 + fr, fq * 8), boff = lds_byte(wc * 32 + fr, fq * 8);
#define PG8_SA(b, h) (((b) * 2 + (h)) * HTB)
#define PG8_SB(b, h) ((4 + (b) * 2 + (h)) * HTB)
#define PG8_STAGE(bufoff, gbase, voff) do { _Pragma("unroll") for (int _i = 0; _i < 2; ++_i) \
        __builtin_amdgcn_global_load_lds((const unsigned*)((const char*)(gbase) + (voff)[_i]), (LAS unsigned*)(lds + (bufoff) + ldsw + _i * 8192), 16, 0, 0); } while (0)
#define PG8_STAGE_A(bufoff, h, gbase, VO) do { if (GATHER) { _Pragma("unroll") for (int _i = 0; _i < 2; ++_i) \
        __builtin_amdgcn_global_load_lds((const unsigned*)((const char*)(gbase) + (VO)[h][_i]), (LAS unsigned*)(lds + (bufoff) + ldsw + _i * 8192), 16, 0, 0); } else PG8_STAGE(bufoff, (gbase) + (h) * hA, voffA); } while (0)
#define PG8_LDA(dst, b, h) do { _Pragma("unroll") for (int m = 0; m < 4; ++m) _Pragma("unroll") for (int k = 0; k < 2; ++k) dst[m][k] = *(const LAS bf16x8*)(lds + PG8_SA(b, h) + aoff + m * 2048 + k * 1024); } while (0)
#define PG8_LDB(dst, b, h) do { _Pragma("unroll") for (int n = 0; n < 2; ++n) _Pragma("unroll") for (int k = 0; k < 2; ++k) dst[n][k] = *(const LAS bf16x8*)(lds + PG8_SB(b, h) + boff + n * 2048 + k * 1024); } while (0)
#define PG8_MMA(ai, bj, At, Bt) do { __builtin_amdgcn_s_setprio(1); _Pragma("unroll") for (int m = 0; m < 4; ++m) _Pragma("unroll") for (int n = 0; n < 2; ++n) _Pragma("unroll") for (int k = 0; k < 2; ++k) \
        acc[ai][bj][m][n] = __builtin_amdgcn_mfma_f32_16x16x32_bf16(Bt[n][k], At[m][k], acc[ai][bj][m][n], 0, 0, 0); __builtin_amdgcn_s_setprio(0); } while (0)
#define PG8_WAIT_V(n) asm volatile("s_waitcnt vmcnt(" #n ")" ::: "memory")
#define PG8_WAIT_L(n) asm volatile("s_waitcnt lgkmcnt(" #n ")" ::: "memory")
#define PG8_BAR __builtin_amdgcn_s_barrier()
#define PG8_SCHED __builtin_amdgcn_sched_barrier(0)
#define PG8_BP(base, jump, t) ((base) + (size_t)(t) * kB + (((t) >= g.tjump) ? (jump) : 0l))
    Unit cur, nxt; int ui = 0;
    if (!S.next(0, cur)) return;
    f32x4 acc[2][2][4][2];
#pragma unroll
    for (int a = 0; a < 2; ++a)
#pragma unroll
        for (int b = 0; b < 2; ++b)
#pragma unroll
            for (int m = 0; m < 4; ++m)
#pragma unroll
                for (int n = 0; n < 2; ++n) acc[a][b][m][n] = (f32x4){0.f, 0.f, 0.f, 0.f};
    bf16x8 At[4][2], B0[2][2], B1[2][2];
    const char* cA = cur.a; const char* cB = cur.b; long cJ = cur.bjump;
    S.a_ready(cur);
    if (GATHER) gather_of(cur, gA);
    PG8_STAGE(PG8_SB(0, 0), cB, voffB); PG8_STAGE(PG8_SB(0, 1), cB + hB, voffB); PG8_STAGE_A(PG8_SA(0, 0), 0, cA, gA); PG8_STAGE_A(PG8_SA(0, 1), 1, cA, gA);
    if (wr == 1) PG8_BAR;
    PG8_WAIT_V(2); PG8_BAR;
    PG8_STAGE(PG8_SB(1, 0), cB + kB, voffB); PG8_STAGE_A(PG8_SA(1, 0), 0, cA + kA, gA); PG8_STAGE(PG8_SB(1, 1), cB + hB + kB, voffB);
    PG8_WAIT_V(6); PG8_BAR;
    for (;;) {
        const bool has_next = S.next(ui + 1, nxt);
        const char* nA = has_next ? nxt.a : cA; const char* nB = has_next ? nxt.b : cB;
        if (GATHER) { if (has_next) gather_of(nxt, ngA); else {
#pragma unroll
            for (int h = 0; h < 2; ++h) { ngA[h][0] = gA[h][0]; ngA[h][1] = gA[h][1]; } } }
        for (int t = 0; t < nt; t += 2) {
            const bool last = (t == nt - 2);
            const char* a1 = cA + (size_t)(t + 1) * kA;
            const char* a2 = last ? nA : cA + (size_t)(t + 2) * kA; const char* b2 = last ? nB : PG8_BP(cB, cJ, t + 2);
            const char* a3 = a2 + kA; const char* b3 = b2 + kB;
            unsigned g2[2][2];
#pragma unroll
            for (int h = 0; h < 2; ++h) { g2[h][0] = last ? ngA[h][0] : gA[h][0]; g2[h][1] = last ? ngA[h][1] : gA[h][1]; }
            if (last && has_next) S.a_ready(nxt);
            PG8_LDB(B0, 0, 0); PG8_LDB(B1, 0, 1); PG8_SCHED; PG8_LDA(At, 0, 0); PG8_STAGE_A(PG8_SA(1, 1), 1, a1, gA);
            PG8_WAIT_V(8); PG8_WAIT_L(0); PG8_BAR; PG8_MMA(0, 0, At, B0); PG8_MMA(0, 1, At, B1); PG8_BAR; PG8_SCHED;
            PG8_LDA(At, 0, 1); PG8_STAGE(PG8_SB(0, 0), b2, voffB); PG8_STAGE(PG8_SB(0, 1), b2 + hB, voffB); PG8_STAGE_A(PG8_SA(0, 0), 0, a2, g2);
            PG8_WAIT_V(8); PG8_WAIT_L(0); PG8_BAR; PG8_MMA(1, 0, At, B0); PG8_MMA(1, 1, At, B1); PG8_BAR; PG8_SCHED;
            PG8_LDB(B0, 1, 0); PG8_LDB(B1, 1, 1); PG8_SCHED; PG8_LDA(At, 1, 0); PG8_STAGE_A(PG8_SA(0, 1), 1, a2, g2);
            PG8_WAIT_V(8); PG8_WAIT_L(0); PG8_BAR; PG8_MMA(0, 0, At, B0); PG8_MMA(0, 1, At, B1); PG8_BAR; PG8_SCHED;
            PG8_LDA(At, 1, 1); PG8_STAGE(PG8_SB(1, 0), b3, voffB); PG8_STAGE(PG8_SB(1, 1), b3 + hB, voffB); PG8_STAGE_A(PG8_SA(1, 0), 0, a3, g2);
            PG8_WAIT_V(8); PG8_WAIT_L(0); PG8_BAR; PG8_MMA(1, 0, At, B0); PG8_MMA(1, 1, At, B1); PG8_BAR; PG8_SCHED;
        }
        if (wr == 0) PG8_BAR;
        E(acc, cur, wr, wc, fr, fq);
        if (!has_next) break;
#pragma unroll
        for (int a = 0; a < 2; ++a)
#pragma unroll
            for (int b = 0; b < 2; ++b)
#pragma unroll
                for (int m = 0; m < 4; ++m)
#pragma unroll
                    for (int n = 0; n < 2; ++n) acc[a][b][m][n] = (f32x4){0.f, 0.f, 0.f, 0.f};
        cur = nxt; cA = nA; cB = nB; cJ = nxt.bjump; ++ui;
        if (GATHER) {
#pragma unroll
            for (int h = 0; h < 2; ++h) { gA[h][0] = ngA[h][0]; gA[h][1] = ngA[h][1]; } }
        if (wr == 1) PG8_BAR;
    }
    PG8_WAIT_V(0);
    PG8_BAR;
#undef PG8_SA
#undef PG8_SB
#undef PG8_STAGE
#undef PG8_STAGE_A
#undef PG8_LDA
#undef PG8_LDB
#undef PG8_MMA
#undef PG8_WAIT_V
#undef PG8_WAIT_L
#undef PG8_BAR
#undef PG8_SCHED
#undef PG8_BP
}
}

#define XB_TMO      128
#define XB_XCNT(j)  (256  + 64 * (j))
#define XB_XSUB(j)  (1280 + 64 * (j))
#define XB_XGEN(j)  (2304 + 64 * (j))
#define XB_TOP      3328
#define XB_TOPGEN   3392
#define XCD_BAR_WORDS 3456
#define XB_SPIN_CAP (1u << 18)
__device__ __forceinline__ unsigned xb_ld(unsigned* p)              { return __hip_atomic_load(p, __ATOMIC_RELAXED, __HIP_MEMORY_SCOPE_AGENT); }
__device__ __forceinline__ unsigned xb_add(unsigned* p, unsigned v) { return __hip_atomic_fetch_add(p, v, __ATOMIC_RELAXED, __HIP_MEMORY_SCOPE_AGENT); }
__device__ __forceinline__ unsigned xb_xcc_id() { return (unsigned)__builtin_amdgcn_s_getreg((3 << 11) | 20) & 0xFu; }
#define XB_SPIN(cond, bar) do { unsigned _sp = 0; while (cond) { __builtin_amdgcn_s_sleep(1); \
    if ((++_sp & 255u) == 0u) { if (xb_ld(&(bar)[XB_TMO])) break; if (_sp > XB_SPIN_CAP) { atomicAdd(&(bar)[XB_TMO], 1u); break; } } } } while (0)
struct XcdBarrier { unsigned* bar; unsigned x; volatile LAS unsigned* st; };
__device__ __forceinline__ XcdBarrier xcd_barrier_post(unsigned* bar, volatile LAS unsigned* st) {
    XcdBarrier b; b.bar = bar; b.x = xb_xcc_id(); b.st = st;
    if (threadIdx.x == 0) (void)xb_add(&bar[XB_XCNT(b.x)], 1u);
    return b;
}
__device__ __forceinline__ void xcd_barrier_complete(unsigned* bar, unsigned x, unsigned& nloc, unsigned& nx) {
    const unsigned G = gridDim.x * gridDim.y * gridDim.z;
    unsigned sum, cnt, mine, sp = 0u;
    for (;;) {
        sum = 0u; cnt = 0u; mine = 0u;
#pragma unroll
        for (unsigned j = 0; j < 16; ++j) { const unsigned c = xb_ld(&bar[XB_XCNT(j)]); sum += c; cnt += (c > 0u) ? 1u : 0u; mine = (j == x) ? c : mine; }
        if (sum == G) break;
        __builtin_amdgcn_s_sleep(1);
        if ((++sp & 255u) == 0u) { if (xb_ld(&bar[XB_TMO])) break; if (sp > XB_SPIN_CAP) { atomicAdd(&bar[XB_TMO], 1u); break; } }
    }
    nloc = mine > 0u ? mine : 1u; nx = cnt > 0u ? cnt : 1u;
}
__device__ __forceinline__ void xcd_barrier(const XcdBarrier& b) {
    asm volatile("s_waitcnt vmcnt(0)" ::: "memory");
    __syncthreads();
    if (threadIdx.x == 0) {
        unsigned* bar = b.bar;
        __builtin_amdgcn_s_waitcnt(0);
        unsigned nloc = b.st[0], nx = b.st[1];
        if (nloc == 0u) { xcd_barrier_complete(bar, b.x, nloc, nx); b.st[0] = nloc; b.st[1] = nx; }
        const unsigned old = xb_add(&bar[XB_XSUB(b.x)], 1u);
        const unsigned gen = old / nloc;
        if (old + 1u == (gen + 1u) * nloc) {
            __builtin_amdgcn_fence(__ATOMIC_RELEASE, "agent");
            asm volatile("s_waitcnt vmcnt(0)" ::: "memory");
            const unsigned og = xb_add(&bar[XB_TOP], 1u);
            const unsigned tg = og / nx;
            if (og + 1u == (tg + 1u) * nx) xb_add(&bar[XB_TOPGEN], 1u);
            else XB_SPIN(xb_ld(&bar[XB_TOPGEN]) == tg, bar);
            __builtin_amdgcn_fence(__ATOMIC_ACQUIRE, "agent");
            xb_add(&bar[XB_XGEN(b.x)], 1u);
            asm volatile("s_waitcnt vmcnt(0)" ::: "memory");
        } else {
            XB_SPIN(xb_ld(&bar[XB_XGEN(b.x)]) == gen, bar);
            __builtin_amdgcn_fence(__ATOMIC_ACQUIRE, "agent");
            asm volatile("s_waitcnt vmcnt(0)" ::: "memory");
        }
    }
    __syncthreads();
}

struct Args { const float* in[20]; float* out; unsigned char* ws; int ph_lo, ph_hi; };

struct Frame {
    LAS unsigned char* lds;
    unsigned char* ws;
    const float* const* in;
    float* out;
    int tid, lane, wave, vcu, G;
};

__device__ __forceinline__ float wave_sum(float v) {
#pragma unroll
    for (int o = 1; o < 64; o <<= 1) v += __shfl_xor(v, o);
    return v;
}

struct TrDesc { const float* W; bf16_t* WT; int N, nvalid, dpitch, rowbase, blk, blkstride, kb, nb; const float* kg; };
__device__ __forceinline__ void tr_load(f32x4 (&v)[8], const TrDesc& d, int lane) {
    const int k0 = 64 * d.kb, n = 32 * d.nb + (lane & 7) * 4;
#pragma unroll
    for (int i = 0; i < 8; ++i) { const int kk = 8 * i + (lane >> 3); const float* p = d.W + (size_t)(k0 + kk) * d.N + n;
        if (n + 3 < d.nvalid) v[i] = *(const f32x4*)p; else { v[i].x = n < d.nvalid ? p[0] : 0.f; v[i].y = n + 1 < d.nvalid ? p[1] : 0.f; v[i].z = n + 2 < d.nvalid ? p[2] : 0.f; v[i].w = 0.f; } }
}
__device__ __forceinline__ void tr_finish(const f32x4 (&v)[8], const TrDesc& d, LAS float* scr, int lane) {
    const int k0 = 64 * d.kb, n0 = 32 * d.nb, c4 = (lane & 7) * 4;
#pragma unroll
    for (int i = 0; i < 8; ++i) { const int kk = 8 * i + (lane >> 3); LAS float* q = scr + kk * 33 + c4; const float gk = d.kg ? d.kg[k0 + kk] : 1.f; q[0] = v[i].x * gk; q[1] = v[i].y * gk; q[2] = v[i].z * gk; q[3] = v[i].w * gk; }
    LDS_WAIT(); asm volatile("" ::: "memory");
    const int c = lane & 7;
#pragma unroll
    for (int j = 0; j < 4; ++j) { const int nl = (lane >> 3) + 8 * j; const int n = n0 + nl; const LAS float* s = scr + (8 * c) * 33 + nl;
        const int drow = d.rowbase + (n / d.blk) * d.blkstride + (n % d.blk);
        u32x4 o; o.x = pk2(s[0 * 33], s[1 * 33]); o.y = pk2(s[2 * 33], s[3 * 33]); o.z = pk2(s[4 * 33], s[5 * 33]); o.w = pk2(s[6 * 33], s[7 * 33]);
        *(u32x4*)(d.WT + (size_t)drow * d.dpitch + k0 + 8 * c) = o; }
    LDS_WAIT(); asm volatile("" ::: "memory");
}

__device__ __forceinline__ void rms_row_to_bf16(const float* xrow, const float* gain, bf16_t* orow, int lane) {
    const f32x4* xr = (const f32x4*)xrow + lane; const f32x4* gr = (const f32x4*)gain + lane;
    f32x4 v[4]; float s = 0.f;
#pragma unroll
    for (int j = 0; j < 4; ++j) { v[j] = xr[64 * j]; s += (v[j].x * v[j].x + v[j].y * v[j].y) + (v[j].z * v[j].z + v[j].w * v[j].w); }
    const float rstd = rsqrtf(wave_sum(s) * (1.f / D) + EPS);
    unsigned long long* o8 = (unsigned long long*)orow + lane;
#pragma unroll
    for (int j = 0; j < 4; ++j) { const f32x4 g = gr[64 * j];
        o8[64 * j] = (unsigned long long)pk2(v[j].x * rstd * g.x, v[j].y * rstd * g.y) | ((unsigned long long)pk2(v[j].z * rstd * g.z, v[j].w * rstd * g.w) << 32); }
}

__device__ __forceinline__ void p0_prologue(Frame& F) {
    LAS float* scr = (LAS float*)(F.lds + F.wave * 16384);
    const int gw = F.vcu * NWAVES + F.wave, NGW = F.G * NWAVES;
    unsigned char* ws = F.ws;
    constexpr int I_WIN = 16 * 88, I_WOUT = 16 * 32, I_CW1 = 32 * 8, I_CW2 = 4 * 2, I_GU = 16 * 16, I_DN = 8 * 32;
    constexpr int NITEMS = I_WIN + I_WOUT + 2 * I_CW1 + 2 * I_CW2 + 32 * I_GU + 16 * I_DN;
    auto describe = [&](int it) -> TrDesc { int r = it < NITEMS ? it : NITEMS - 1;
        if (r < I_WIN) return TrDesc{F.in[3], (bf16_t*)(ws + WS_WIN), NIN, NIN, 1024, 0, 1 << 30, 0, r / 88, r % 88, F.in[2]}; r -= I_WIN;
        if (r < I_WOUT) return TrDesc{F.in[4], (bf16_t*)(ws + WS_WOUT), 1024, 1024, 1024, 0, 1 << 30, 0, r / 32, r % 32, nullptr}; r -= I_WOUT;
        if (r < 2 * I_CW1) { const int kv = r / I_CW1; r -= kv * I_CW1; return TrDesc{F.in[kv ? 9 : 7], (bf16_t*)(ws + WS_CW1) + (size_t)kv * 256 * 2048, 256, 256, 2048, 0, 1 << 30, 0, r / 8, r % 8, nullptr}; } r -= 2 * I_CW1;
        if (r < 2 * I_CW2) { const int kv = r / I_CW2; r -= kv * I_CW2; return TrDesc{F.in[kv ? 10 : 8], (bf16_t*)(ws + WS_CW2) + (size_t)kv * 64 * 256, 64, 64, 256, 0, 1 << 30, 0, r / 2, r % 2, nullptr}; } r -= 2 * I_CW2;
        if (r < 32 * I_GU) { const int eu = r / I_GU; r -= eu * I_GU; const int e = eu >> 1, up = eu & 1;
            return TrDesc{F.in[up ? 17 : 16] + (size_t)e * 1024 * 512, (bf16_t*)(ws + WS_WGU), 512, 512, 1024, e * 1024 + up * 128, 128, 256, r / 16, r % 16, F.in[11]}; } r -= 32 * I_GU;
        { const int e = r / I_DN; r -= e * I_DN;
            return TrDesc{F.in[18] + (size_t)e * 512 * 1024, (bf16_t*)(ws + WS_WD) + (size_t)e * 1024 * 512, 1024, 1024, 512, 0, 1 << 30, 0, r / 32, r % 32, nullptr}; } };
    { TrDesc d0 = describe(gw); f32x4 v0[8]; if (gw < NITEMS) tr_load(v0, d0, F.lane);
#pragma unroll 1
      for (int it = gw; it < NITEMS; it += NGW) { const TrDesc d1 = describe(it + NGW); f32x4 v1[8]; tr_load(v1, d1, F.lane);
          tr_finish(v0, d0, scr, F.lane); d0 = d1;
#pragma unroll
          for (int i = 0; i < 8; ++i) v0[i] = v1[i]; } }
    { bf16_t* wrh = (bf16_t*)(ws + WS_WRH); bf16_t* wrl = (bf16_t*)(ws + WS_WRL);
      for (int i = blockIdx.x * NTHR + F.tid; i < 32 * 1024; i += F.G * NTHR) { const int c = i >> 10, k = i & 1023;
          float w = 0.f; if (c < 4) w = F.in[12][k * 4 + c]; else if (c < 20) w = F.in[14][k * 16 + (c - 4)];
          const unsigned h = f2bf(w); const float hf = __builtin_bit_cast(float, h << 16); wrh[i] = (bf16_t)h; wrl[i] = (bf16_t)f2bf(w - hf); } }
    if ((int)blockIdx.x < 64) { const int kv = blockIdx.x >> 5, chunk = blockIdx.x & 31, j = F.tid & 255, half = F.tid >> 8; const float* pos = F.in[kv ? 6 : 5]; const float* w1 = F.in[kv ? 9 : 7];
        const int i0 = chunk * 64 + half * 32; float s = 0.f;
#pragma unroll
        for (int k = 0; k < 32; ++k) s += pos[i0 + k] * w1[(size_t)(i0 + k) * 256 + j];
        ((float*)(ws + WS_CB1))[(kv * 64 + chunk * 2 + half) * 256 + j] = s; }
    { const f32x4* gr = (const f32x4*)F.in[2] + F.lane; f32x4 gg[4];
#pragma unroll
      for (int j = 0; j < 4; ++j) gg[j] = gr[64 * j];
      for (int m0 = gw; m0 < M; m0 += 4 * NGW) {
          f32x4 v[4][4];
#pragma unroll
          for (int r = 0; r < 4; ++r) { const int m = m0 + r * NGW < M ? m0 + r * NGW : m0; const f32x4* xr = (const f32x4*)(F.in[0] + (size_t)m * D) + F.lane;
#pragma unroll
              for (int j = 0; j < 4; ++j) v[r][j] = __builtin_nontemporal_load(xr + 64 * j); }
#pragma unroll
          for (int r = 0; r < 4; ++r) { const int m = m0 + r * NGW; float s = 0.f;
#pragma unroll
              for (int j = 0; j < 4; ++j) s += (v[r][j].x * v[r][j].x + v[r][j].y * v[r][j].y) + (v[r][j].z * v[r][j].z + v[r][j].w * v[r][j].w);
              const float rstd = rsqrtf(wave_sum(s) * (1.f / D) + EPS);
              if (m < M) { unsigned long long* o8 = (unsigned long long*)((bf16_t*)F.out + (size_t)m * D) + F.lane;
                  if (F.lane == 0) ((float*)(ws + WS_RS1))[m] = rstd;
#pragma unroll
                  for (int j = 0; j < 4; ++j) o8[64 * j] = (unsigned long long)pk2(v[r][j].x, v[r][j].y) | ((unsigned long long)pk2(v[r][j].z, v[r][j].w) << 32); } } } }
}

struct SchedGrid {
    const char* A; const char* B; size_t a_tile, b_tile; int nN, nU, G, c;
    __device__ __forceinline__ void a_ready(const pg8::Unit&) const {}
    __device__ __forceinline__ bool next(int i, pg8::Unit& u) const { const int L = i * G + c; if (L >= nU) return false; const int pm = L / nN, pn = L - pm * nN;
        u.a = A + (size_t)pm * a_tile; u.b = B + (size_t)pn * b_tile; u.bjump = 0; u.orow = pm * 256; u.ocol = pn * 256; u.aux = 0; return true; }
};
struct EpiBf16 {
    bf16_t* O; int ldc; const float* rs;
    __device__ __forceinline__ void operator()(const f32x4 (&acc)[2][2][4][2], const pg8::Unit& u, int wr, int wc, int fr, int fq) const {
#pragma unroll
        for (int ai = 0; ai < 2; ++ai)
#pragma unroll
            for (int m = 0; m < 4; ++m) { const int row = u.orow + ai * 128 + wr * 64 + m * 16 + fr; bf16_t* rowp = O + (size_t)row * ldc + u.ocol + wc * 32 + 8 * fq; const float sc = rs[row];
#pragma unroll
                for (int bj = 0; bj < 2; ++bj) { const f32x4 v0 = acc[ai][bj][m][0] * sc, v1 = acc[ai][bj][m][1] * sc;
                    u32x4 w; w.x = pk2(v0[0], v0[1]); w.y = pk2(v0[2], v0[3]); w.z = pk2(v1[0], v1[1]); w.w = pk2(v1[2], v1[3]);
                    *(u32x4*)(rowp + bj * 128) = w; } }
    }
};
struct SchedCmp1 {
    const bf16_t* PROJ; const bf16_t* W1; int G, c;
    __device__ __forceinline__ void a_ready(const pg8::Unit&) const {}
    __device__ __forceinline__ bool next(int i, pg8::Unit& u) const { const int L = i * G + c; if (L >= 32) return false;
        const int kv = L >> 4, kvh = (L >> 3) & 1, b = (L >> 1) & 3, nh = L & 1;
        u.a = (const char*)(PROJ + ((size_t)(b * SEQ + 16 * 256 * nh)) * NP + (kv ? C_VCT : C_KCT) + kvh * 64);
        u.b = (const char*)(W1 + (size_t)kv * 256 * 2048); u.bjump = 0;
        u.orow = (kv * 2 + kvh) * 2048 + b * 512 + nh * 256; u.ocol = 0; u.aux = kv; return true; }
};
struct EpiCmp1 {
    bf16_t* O; LAS const float* cb1;
    __device__ __forceinline__ void operator()(const f32x4 (&acc)[2][2][4][2], const pg8::Unit& u, int wr, int wc, int fr, int fq) const {
        f32x4 bv[2][2];
#pragma unroll
        for (int bj = 0; bj < 2; ++bj)
#pragma unroll
            for (int n = 0; n < 2; ++n) bv[bj][n] = *(LAS const f32x4*)(cb1 + u.aux * 256 + bj * 128 + wc * 32 + 8 * fq + 4 * n);
#pragma unroll
        for (int ai = 0; ai < 2; ++ai)
#pragma unroll
            for (int m = 0; m < 4; ++m) { bf16_t* rowp = O + (size_t)(u.orow + ai * 128 + wr * 64 + m * 16 + fr) * 256 + wc * 32 + 8 * fq;
#pragma unroll
                for (int bj = 0; bj < 2; ++bj) { f32x4 v0 = acc[ai][bj][m][0] + bv[bj][0], v1 = acc[ai][bj][m][1] + bv[bj][1];
#pragma unroll
                    for (int j = 0; j < 4; ++j) { v0[j] = gelu_tanh(v0[j]); v1[j] = gelu_tanh(v1[j]); }
                    u32x4 w; w.x = pk2(v0[0], v0[1]); w.y = pk2(v0[2], v0[3]); w.z = pk2(v1[0], v1[1]); w.w = pk2(v1[2], v1[3]);
                    *(u32x4*)(rowp + bj * 128) = w; } }
    }
};
struct EpiWout {
    const bf16_t* X; bf16_t* O;
    __device__ __forceinline__ void operator()(const f32x4 (&acc)[2][2][4][2], const pg8::Unit& u, int wr, int wc, int fr, int fq) const {
#pragma unroll
        for (int ai = 0; ai < 2; ++ai)
#pragma unroll
            for (int m = 0; m < 4; ++m) { const size_t off = (size_t)(u.orow + ai * 128 + wr * 64 + m * 16 + fr) * D + u.ocol + wc * 32 + 8 * fq;
#pragma unroll
                for (int bj = 0; bj < 2; ++bj) { const u32x4 xw = __builtin_nontemporal_load((const u32x4*)(X + off + bj * 128));
                    const f32x4 v0 = (f32x4){bf_lo(xw.x), bf_hi(xw.x), bf_lo(xw.y), bf_hi(xw.y)} + acc[ai][bj][m][0], v1 = (f32x4){bf_lo(xw.z), bf_hi(xw.z), bf_lo(xw.w), bf_hi(xw.w)} + acc[ai][bj][m][1];
                    u32x4 w; w.x = pk2(v0[0], v0[1]); w.y = pk2(v0[2], v0[3]); w.z = pk2(v1[0], v1[1]); w.w = pk2(v1[2], v1[3]);
                    *(u32x4*)(O + off + bj * 128) = w; } }
    }
};

__device__ __forceinline__ void moe_tables(Frame& F, bool want_pre) {
    LAS int* T = (LAS int*)(F.lds + MISC_OFF);
    const int* hist = (const int*)(F.ws + WS_CTL) + CW_HIST;
    const int tid = F.tid;
    int tot = 0, pre = 0;
    if (tid < 384) { const int c = tid >> 4, part = tid & 15;
        for (int w = part * 16; w < part * 16 + 16; ++w) { const int v = (w < F.G) ? hist[w * NCLS + c] : 0; tot += v; if (want_pre && w < (int)blockIdx.x) pre += v; } }
#pragma unroll
    for (int o = 1; o < 16; o <<= 1) { tot += __shfl_xor(tot, o); pre += __shfl_xor(pre, o); }
    if (tid < 384 && (tid & 15) == 0) { T[tid >> 4] = tot; T[24 + (tid >> 4)] = pre; }
    __syncthreads();
    if (tid == 0) { int p = 0; for (int c = 0; c < NCLS; ++c) { T[48 + c] = p; const int nt = (T[c] + 255) >> 8; for (int k = 0; k < nt; ++k) T[80 + p + k] = c; p += nt; } T[48 + NCLS] = p; }
    __syncthreads();
}
__device__ __forceinline__ void cls_experts(int cls, int& ea, int& eb) { const int gi = cls / 6, pr = cls - gi * 6; const int a = pr < 3 ? 0 : (pr < 5 ? 1 : 2); const int b = pr < 3 ? pr + 1 : (pr < 5 ? pr - 1 : 3); ea = gi * 4 + a; eb = gi * 4 + b; }

struct SchedUp {
    const char* HS; const char* WGU; LAS int* T; int G, c; const int* rowtok;
    __device__ __forceinline__ void a_ready(const pg8::Unit&) const {}
    __device__ __forceinline__ bool next(int i, pg8::Unit& u) const { const int L = i * G + c; const int TT = __builtin_amdgcn_readfirstlane(T[48 + NCLS]); const int rt = L >> 3, pn = L & 7; if (rt >= TT) return false;
        const int cls = __builtin_amdgcn_readfirstlane(T[80 + rt]); int ea, eb; cls_experts(cls, ea, eb); const int e = pn < 4 ? ea : eb;
        u.a = HS; u.rows = rowtok + rt * 256; u.b = WGU + (size_t)(e * 4 + (pn & 3)) * 256 * 2048; u.bjump = 0; u.orow = rt * 256; u.ocol = (pn >> 2) * 512 + (pn & 3) * 128; u.aux = pn >> 2; return true; }
};
struct EpiUp {
    bf16_t* HE; const f32x4* rowc; unsigned* ready;
    __device__ __forceinline__ void operator()(const f32x4 (&acc)[2][2][4][2], const pg8::Unit& u, int wr, int wc, int fr, int fq) const {
        const __amdgpu_buffer_rsrc_t rs = __builtin_amdgcn_make_buffer_rsrc(HE, 0, MAXTILES * 256 * 2048, 0x00020000);
#pragma unroll
        for (int ai = 0; ai < 2; ++ai)
#pragma unroll
            for (int m = 0; m < 4; ++m) { const int row = u.orow + ai * 128 + wr * 64 + m * 16 + fr; const f32x4 rc = rowc[row]; const float cw = (u.aux ? rc.y : rc.x) * rc.z, rsd = rc.z;
                float o[8];
#pragma unroll
                for (int n = 0; n < 2; ++n)
#pragma unroll
                    for (int j = 0; j < 4; ++j) { const float gt = acc[ai][0][m][n][j] * rsd, up = acc[ai][1][m][n][j]; o[n * 4 + j] = gt / (1.f + __expf(-gt)) * up * cw; }
                u32x4 w; w.x = pk2(o[0], o[1]); w.y = pk2(o[2], o[3]); w.z = pk2(o[4], o[5]); w.w = pk2(o[6], o[7]);
                __builtin_amdgcn_raw_buffer_store_b128(w, rs, (unsigned)((row * 1024 + u.ocol + wc * 32 + 8 * fq) * 2), 0, 16); }
        asm volatile("s_waitcnt vmcnt(0)" ::: "memory");
        if (fr + fq == 0) __hip_atomic_fetch_add(ready + 64 * (u.orow >> 8), 1u, __ATOMIC_RELAXED, __HIP_MEMORY_SCOPE_AGENT);
    }
};
struct SchedDown {
    const char* HE; const char* WD; LAS int* T; int G, c; const unsigned* ready;
    __device__ __forceinline__ bool next(int i, pg8::Unit& u) const { const int L = i * G + c; const int TT = __builtin_amdgcn_readfirstlane(T[48 + NCLS]); const int rt = L >> 2, pn = L & 3; if (rt >= TT) return false;
        const int cls = __builtin_amdgcn_readfirstlane(T[80 + rt]); int ea, eb; cls_experts(cls, ea, eb);
        u.a = HE + (size_t)rt * 256 * 2048; u.b = WD + (size_t)ea * 1024 * 1024 + (size_t)pn * 256 * 1024; u.bjump = (long)(eb - ea) * 1024 * 1024 - 8 * 128; u.orow = rt * 256; u.ocol = pn * 256; u.aux = 0; return true; }
    __device__ __forceinline__ void a_ready(const pg8::Unit& u) const {
        if (threadIdx.x < 64) { const unsigned* w = ready + 64 * (u.orow >> 8); unsigned sp = 0;
            while ((unsigned)__builtin_amdgcn_readfirstlane(__hip_atomic_load(w, __ATOMIC_RELAXED, __HIP_MEMORY_SCOPE_AGENT)) < 64u) { if (++sp > (1u << 20)) break; __builtin_amdgcn_s_sleep(2); }
            __builtin_amdgcn_fence(__ATOMIC_ACQUIRE, "agent");
            asm volatile("s_waitcnt vmcnt(0)" ::: "memory"); }
        asm volatile("" ::: "memory"); __builtin_amdgcn_s_barrier(); asm volatile("" ::: "memory");
    }
};
struct EpiDown {
    float* O; const int* rowtok;
    __device__ __forceinline__ void operator()(const f32x4 (&acc)[2][2][4][2], const pg8::Unit& u, int wr, int wc, int fr, int fq) const {
#pragma unroll
        for (int ai = 0; ai < 2; ++ai)
#pragma unroll
            for (int m = 0; m < 4; ++m) { const int tok = rowtok[u.orow + ai * 128 + wr * 64 + m * 16 + fr];
                if (tok >= 0) { float* p = O + (size_t)tok * D + u.ocol + wc * 32 + 8 * fq;
#pragma unroll
                    for (int bj = 0; bj < 2; ++bj)
#pragma unroll
                        for (int n = 0; n < 2; ++n) { f32x4* q = (f32x4*)(p + bj * 128 + 4 * n); *q = *q + acc[ai][bj][m][n]; } } }
    }
};

struct EpiDownNorm {
    float* O; const bf16_t* H; const int* rowtok; const float* gfin; float* xbuf; unsigned* cnt; LAS unsigned char* sc;
    __device__ __forceinline__ void operator()(f32x4 (&acc)[2][2][4][2], const pg8::Unit& u, int wr, int wc, int fr, int fq) const {
        LAS float* P = (LAS float*)sc; LAS float* S = (LAS float*)(sc + 4096); LAS unsigned* flag = (LAS unsigned*)(sc + 5120);
        const int wid = wr * 4 + wc, lane = fq * 16 + fr, rt = u.orow >> 8, pn = u.ocol >> 8;
        int tokv[2][4];
#pragma unroll
        for (int ai = 0; ai < 2; ++ai)
#pragma unroll
            for (int m = 0; m < 4; ++m) { const int rl = ai * 128 + wr * 64 + m * 16 + fr; const int tok = rowtok[u.orow + rl]; tokv[ai][m] = tok; float s = 0.f;
                if (tok >= 0) { const bf16_t* p = H + (size_t)tok * D + u.ocol + wc * 32 + 8 * fq;
#pragma unroll
                    for (int bj = 0; bj < 2; ++bj) { const u32x4 hw = *(const u32x4*)(p + bj * 128);
                        const f32x4 v0 = (f32x4){bf_lo(hw.x), bf_hi(hw.x), bf_lo(hw.y), bf_hi(hw.y)} + acc[ai][bj][m][0], v1 = (f32x4){bf_lo(hw.z), bf_hi(hw.z), bf_lo(hw.w), bf_hi(hw.w)} + acc[ai][bj][m][1];
                        acc[ai][bj][m][0] = v0; acc[ai][bj][m][1] = v1; s += (v0[0] * v0[0] + v0[1] * v0[1]) + (v0[2] * v0[2] + v0[3] * v0[3]) + (v1[0] * v1[0] + v1[1] * v1[1]) + (v1[2] * v1[2] + v1[3] * v1[3]); } }
                s += __shfl_xor(s, 16); s += __shfl_xor(s, 32);
                if (fq == 0) P[rl * 4 + wc] = s; }
        asm volatile("s_waitcnt lgkmcnt(0)" ::: "memory"); __builtin_amdgcn_s_barrier(); asm volatile("" ::: "memory");
        const int row = wid * 32 + (lane & 31);
        if (lane < 32) { const float t = (P[row * 4 + 0] + P[row * 4 + 1]) + (P[row * 4 + 2] + P[row * 4 + 3]);
            __hip_atomic_store(xbuf + ((size_t)(rt * 256 + row) * 4 + pn), t, __ATOMIC_RELAXED, __HIP_MEMORY_SCOPE_AGENT); }
        asm volatile("s_waitcnt vmcnt(0)" ::: "memory");
        if (lane == 0) __hip_atomic_fetch_add(cnt + 64 * rt, 1u, __ATOMIC_RELAXED, __HIP_MEMORY_SCOPE_AGENT);
        if (wid == 0) { unsigned sp = 0; bool dead = false;
            for (;;) { if ((unsigned)__builtin_amdgcn_readfirstlane(__hip_atomic_load(cnt + 64 * rt, __ATOMIC_RELAXED, __HIP_MEMORY_SCOPE_AGENT)) >= 32u) break;
                if (++sp > (1u << 20)) { dead = true; break; } __builtin_amdgcn_s_sleep(2); }
            __builtin_amdgcn_fence(__ATOMIC_ACQUIRE, "agent");
            if (lane == 0) flag[0] = dead ? 1u : 0u; }
        asm volatile("s_waitcnt vmcnt(0) lgkmcnt(0)" ::: "memory"); __builtin_amdgcn_s_barrier(); asm volatile("" ::: "memory");
        if (lane < 32) { const float* sl = xbuf + (size_t)(rt * 256 + row) * 4; float t = 0.f;
#pragma unroll
            for (int k = 0; k < 4; ++k) t += __hip_atomic_load(sl + k, __ATOMIC_RELAXED, __HIP_MEMORY_SCOPE_AGENT);
            S[row] = rsqrtf(t * (1.f / D) + EPS); }
        asm volatile("s_waitcnt vmcnt(0) lgkmcnt(0)" ::: "memory"); __builtin_amdgcn_s_barrier(); asm volatile("" ::: "memory");
        f32x4 gv[2][2];
#pragma unroll
        for (int bj = 0; bj < 2; ++bj)
#pragma unroll
            for (int n = 0; n < 2; ++n) gv[bj][n] = *(const f32x4*)(gfin + u.ocol + wc * 32 + 8 * fq + bj * 128 + 4 * n);
#pragma unroll
        for (int ai = 0; ai < 2; ++ai)
#pragma unroll
            for (int m = 0; m < 4; ++m) { const int tok = tokv[ai][m]; if (tok >= 0) { const float rs = S[ai * 128 + wr * 64 + m * 16 + fr]; float* p = O + (size_t)tok * D + u.ocol + wc * 32 + 8 * fq;
#pragma unroll
                for (int bj = 0; bj < 2; ++bj)
#pragma unroll
                    for (int n = 0; n < 2; ++n) __builtin_nontemporal_store(acc[ai][bj][m][n] * rs * gv[bj][n], (f32x4*)(p + bj * 128 + 4 * n)); } }
        asm volatile("s_waitcnt lgkmcnt(0)" ::: "memory"); __builtin_amdgcn_s_barrier(); asm volatile("" ::: "memory");
    }
};
__device__ __forceinline__ void p1_gates(Frame& F) {
    const bf16_t* XN = (const bf16_t*)F.out; const float* RS = (const float*)(F.ws + WS_RS1); const bf16_t* WG = (const bf16_t*)(F.ws + WS_WIN) + (size_t)C_GT * 1024; bf16_t* GT = (bf16_t*)(F.ws + WS_GATES);
    const int gw = F.vcu * NWAVES + F.wave, NGW = F.G * NWAVES, tl = F.lane & 15, kg = F.lane >> 4;
    for (int it = gw; it < M / 16; it += NGW) { const int row0 = it * 16; f32x4 c0 = {0.f, 0.f, 0.f, 0.f}, c1 = c0;
        const bf16_t* ap = XN + (size_t)(row0 + tl) * 1024 + kg * 8; const bf16_t* bp = WG + (size_t)tl * 1024 + kg * 8;
#pragma unroll 8
        for (int ks = 0; ks < 32; ++ks) { const bf16x8 a = *(const bf16x8*)(ap + ks * 32);
            c0 = __builtin_amdgcn_mfma_f32_16x16x32_bf16(a, *(const bf16x8*)(bp + ks * 32), c0, 0, 0, 0); c1 = __builtin_amdgcn_mfma_f32_16x16x32_bf16(a, *(const bf16x8*)(bp + 16 * 1024 + ks * 32), c1, 0, 0, 0); }
#pragma unroll
        for (int r = 0; r < 4; ++r) { const float sc = RS[row0 + 4 * kg + r]; GT[(size_t)(row0 + 4 * kg + r) * 32 + tl] = (bf16_t)f2bf(c0[r] * sc); GT[(size_t)(row0 + 4 * kg + r) * 32 + 16 + tl] = (bf16_t)f2bf(c1[r] * sc); } }
}
__device__ __forceinline__ void p3_cmp2(Frame& F, int it0, int it1, int step) {
    const bf16_t* H1 = (const bf16_t*)(F.ws + WS_H1); const bf16_t* W2 = (const bf16_t*)(F.ws + WS_CW2); bf16_t* KC = (bf16_t*)(F.ws + WS_KCMP);
    const int r32 = F.lane & 31, hi = F.lane >> 5;
    for (int it = it0; it < it1; it += step) { const int row0 = it * 32; const int combo = row0 >> 11, kv = combo >> 1, kvh = combo & 1, b = (row0 >> 9) & 3, n0 = row0 & 511;
        f32x16 c0 = {}, c1 = {};
        const bf16_t* ap = H1 + (size_t)(row0 + r32) * 256 + hi * 8; const bf16_t* bp = W2 + (size_t)kv * 64 * 256 + (size_t)r32 * 256 + hi * 8;
#pragma unroll 4
        for (int ks = 0; ks < 16; ++ks) { const bf16x8 a = *(const bf16x8*)(ap + ks * 16); const bf16x8 b0 = *(const bf16x8*)(bp + ks * 16), b1 = *(const bf16x8*)(bp + 32 * 256 + ks * 16);
            c0 = __builtin_amdgcn_mfma_f32_32x32x16_bf16(a, b0, c0, 0, 0, 0); c1 = __builtin_amdgcn_mfma_f32_32x32x16_bf16(a, b1, c1, 0, 0, 0); }
        bf16_t* op = KC + (size_t)kv * (4 * 2 * 512 * 64) + ((size_t)(b * 2 + kvh) * 512 + n0) * 64;
#pragma unroll
        for (int r = 0; r < 16; ++r) { const int row = (r & 3) + 8 * (r >> 2) + 4 * hi; if (n0 + row == 511) { c0[r] = 0.f; c1[r] = 0.f; }
            op[row * 64 + r32] = (bf16_t)f2bf(c0[r]); op[row * 64 + 32 + r32] = (bf16_t)f2bf(c1[r]); }
        if (kv) { bf16_t* vt = (bf16_t*)(F.ws + WS_VCT) + ((size_t)(b * 2 + kvh) * 64 + r32) * 512 + n0 + 4 * hi;
#pragma unroll
            for (int u = 0; u < 4; ++u) { *(u32x2*)(vt + 8 * u) = (u32x2){pk2(c0[4 * u], c0[4 * u + 1]), pk2(c0[4 * u + 2], c0[4 * u + 3])};
                *(u32x2*)(vt + (size_t)32 * 512 + 8 * u) = (u32x2){pk2(c1[4 * u], c1[4 * u + 1]), pk2(c1[4 * u + 2], c1[4 * u + 3])}; } } }
}

__device__ __forceinline__ void load_q64(float (&q)[64], const bf16_t* p) {
#pragma unroll
    for (int c = 0; c < 8; ++c) { const u32x4 v = *(const u32x4*)(p + 8 * c); q[8 * c] = bf_lo(v.x); q[8 * c + 1] = bf_hi(v.x); q[8 * c + 2] = bf_lo(v.y); q[8 * c + 3] = bf_hi(v.y); q[8 * c + 4] = bf_lo(v.z); q[8 * c + 5] = bf_hi(v.z); q[8 * c + 6] = bf_lo(v.w); q[8 * c + 7] = bf_hi(v.w); }
}
__device__ __forceinline__ float dot64(const float (&q)[64], const bf16_t* p) {
    float s0 = 0.f, s1 = 0.f;
#pragma unroll
    for (int c = 0; c < 8; ++c) { const u32x4 v = *(const u32x4*)(p + 8 * c);
        s0 += q[8 * c] * bf_lo(v.x) + q[8 * c + 2] * bf_lo(v.y) + q[8 * c + 4] * bf_lo(v.z) + q[8 * c + 6] * bf_lo(v.w);
        s1 += q[8 * c + 1] * bf_hi(v.x) + q[8 * c + 3] * bf_hi(v.y) + q[8 * c + 5] * bf_hi(v.z) + q[8 * c + 7] * bf_hi(v.w); }
    return s0 + s1;
}
__device__ __forceinline__ void axpy64(float (&o)[64], float p, const bf16_t* vp) {
#pragma unroll
    for (int c = 0; c < 8; ++c) { const u32x4 v = *(const u32x4*)(vp + 8 * c);
        o[8 * c] += p * bf_lo(v.x); o[8 * c + 1] += p * bf_hi(v.x); o[8 * c + 2] += p * bf_lo(v.y); o[8 * c + 3] += p * bf_hi(v.y);
        o[8 * c + 4] += p * bf_lo(v.z); o[8 * c + 5] += p * bf_hi(v.z); o[8 * c + 6] += p * bf_lo(v.w); o[8 * c + 7] += p * bf_hi(v.w); }
}
#ifndef MK_PROBE
#define MK_PROBE 0
#endif
#define MK_PBR 2
constexpr size_t WS_AUX = 460 * MiB;
constexpr float PROBE_K = 64.f;
__device__ __forceinline__ void store64(bf16_t* p, const float (&oi)[64], float sc) {
    float o[64];
#pragma unroll
    for (int d = 0; d < 64; ++d) o[d] = oi[d];
#if (MK_PROBE & 3)
    { float f[64]; load_q64(f, p);
#pragma unroll
      for (int d = 0; d < 64; ++d) { const float nv = o[d] * sc; o[d] = (nv + PROBE_K * (f[d] - nv)) / sc; } }
#endif
#pragma unroll
    for (int c = 0; c < 8; ++c) { u32x4 w; w.x = pk2(o[8 * c] * sc, o[8 * c + 1] * sc); w.y = pk2(o[8 * c + 2] * sc, o[8 * c + 3] * sc); w.z = pk2(o[8 * c + 4] * sc, o[8 * c + 5] * sc); w.w = pk2(o[8 * c + 6] * sc, o[8 * c + 7] * sc); *(u32x4*)(p + 8 * c) = w; }
}

__device__ __forceinline__ void nv_mixer_a(Frame& F) {
    const bf16_t* PROJ = (const bf16_t*)(F.ws + WS_PROJ); bf16_t* OMIX = (bf16_t*)(F.ws + WS_XN); const float* relb = F.in[1];
    for (int idx = blockIdx.x * NTHR + F.tid; idx < 6 * M; idx += F.G * NTHR) {
        const int h = idx / M, row = idx - h * M, b = row >> 13, t = row & (SEQ - 1);
        float q[64], o[64];
        load_q64(q, PROJ + (size_t)row * NP + C_QA + h * 64);
#pragma unroll
        for (int d = 0; d < 64; ++d) o[d] = 0.f;
        float m = -INFINITY, l = 0.f;
        for (int p = 0; p < 3; ++p) { const int dil = p == 0 ? 1 : (p == 1 ? 4 : 16);
            for (int j = 0; j <= 128; ++j) { const int kt = t - dil * j; if (kt < 0) break;
                const bf16_t* kr = PROJ + (size_t)(b * SEQ + kt) * NP;
                const float s = dot64(q, kr + C_KA + h * 64) * 0.125f + relb[t5_bucket(dil * j) * 16 + h];
                if (s > m) { const float c = __expf(m - s); l *= c;
#pragma unroll
                    for (int d = 0; d < 64; ++d) o[d] *= c;
                    m = s; }
                const float pe = __expf(s - m); l += pe; axpy64(o, pe, kr + C_VA + h * 64); } }
        store64(OMIX + (size_t)row * D + h * 64, o, 1.f / l);
    }
}
__device__ __forceinline__ void nv_nsa_a(Frame& F) {
    const bf16_t* PROJ = (const bf16_t*)(F.ws + WS_PROJ); const bf16_t* KCMP = (const bf16_t*)(F.ws + WS_KCMP); const float* relb = F.in[1];
    float* IMP = (float*)(F.ws + WS_IMP); int* SEL = (int*)(F.ws + WS_SEL); f32x2* MD = (f32x2*)(F.ws + WS_MD);
    for (int idx = blockIdx.x * NTHR + F.tid; idx < 2 * M; idx += F.G * NTHR) {
        const int kvh = idx / M, row = idx - kvh * M, b = row >> 13, t = row & (SEQ - 1);
        int nv = t >= 31 ? ((t - 31) >> 4) + 1 : 0; if (nv > NCMP) nv = NCMP;
        const bf16_t* Kc = KCMP + (size_t)(b * 2 + kvh) * 512 * 64;
        float* imp = IMP + ((size_t)row * 2 + kvh) * 128;
        for (int s = 0; s < 128; s += 4) *(f32x4*)(imp + s) = (f32x4){0.f, 0.f, 0.f, 0.f};
        for (int g = 0; g < 5; ++g) { const int hb = kvh * 5 + g;
            float q[64]; load_q64(q, PROJ + (size_t)row * NP + C_QB + hb * 64);
            float m = -INFINITY;
            for (int n = 0; n < nv; ++n) { const float s = dot64(q, Kc + n * 64) * 0.125f + relb[t5_bucket(t - 16 * n - 31) * 16 + 6 + hb]; m = fmaxf(m, s); }
            float den = 0.f;
            for (int n = 0; n < nv; ++n) { const float s = dot64(q, Kc + n * 64) * 0.125f + relb[t5_bucket(t - 16 * n - 31) * 16 + 6 + hb]; den += __expf(s - m); }
            MD[(size_t)row * 10 + hb] = (f32x2){nv > 0 ? m : 0.f, den};
            const float inv = nv > 0 ? 1.f / den : 0.f;
            float acc = 0.f;
            for (int n = 0; n < nv; ++n) { const float s = dot64(q, Kc + n * 64) * 0.125f + relb[t5_bucket(t - 16 * n - 31) * 16 + 6 + hb]; const float p = __expf(s - m) * inv;
                if ((n & 3) < 3) acc += p; else { acc += 0.5f * p; imp[n >> 2] += acc; acc = 0.5f * p; } }
            if (nv > 0) imp[nv >> 2] += acc;
        }
        const int cur = t >> 6; unsigned taken[4] = {0u, 0u, 0u, 0u};
        int* sel = SEL + ((size_t)row * 2 + kvh) * 16;
        for (int k = 0; k < 16; ++k) { float best = -INFINITY; int bi = 0;
            for (int s = 0; s < 128; ++s) { if ((taken[s >> 5] >> (s & 31)) & 1u) continue;
                const bool forced = (s == cur) | (s == cur - 1) | (s == 0);
                const float v = forced ? 1.0e4f : (s <= cur ? imp[s] : -1.f);
                if (v > best) { best = v; bi = s; } }
            taken[bi >> 5] |= 1u << (bi & 31); sel[k] = bi; }
    }
}
__device__ __forceinline__ void nv_nsa_b(Frame& F) {
    const bf16_t* PROJ = (const bf16_t*)(F.ws + WS_PROJ); const bf16_t* KCMP = (const bf16_t*)(F.ws + WS_KCMP); const bf16_t* VCMP = (const bf16_t*)(F.ws + WS_VCMP); const float* relb = F.in[1];
    const int* SEL = (const int*)(F.ws + WS_SEL); const f32x2* MD = (const f32x2*)(F.ws + WS_MD); bf16_t* OMIX = (bf16_t*)(F.ws + WS_XN);
    for (int idx = blockIdx.x * NTHR + F.tid; idx < 10 * M; idx += F.G * NTHR) {
        const int hb = idx / M, row = idx - hb * M, b = row >> 13, t = row & (SEQ - 1), kvh = hb / 5;
        const bf16_t* prow = PROJ + (size_t)row * NP;
        float q[64], o[64]; load_q64(q, prow + C_QB + hb * 64);
#pragma unroll
        for (int d = 0; d < 64; ++d) o[d] = 0.f;
        float g0 = 1.f / (1.f + __expf(-bf2f(((const bf16_t*)(F.ws + WS_GATES))[(size_t)row * 32 + hb * 3 + 0]))), g1 = 1.f / (1.f + __expf(-bf2f(((const bf16_t*)(F.ws + WS_GATES))[(size_t)row * 32 + hb * 3 + 1]))), g2 = 1.f / (1.f + __expf(-bf2f(((const bf16_t*)(F.ws + WS_GATES))[(size_t)row * 32 + hb * 3 + 2])));
#if MK_PROBE == 4
        if (MK_PBR != 0) g0 = 0.f; if (MK_PBR != 1) g1 = 0.f; if (MK_PBR != 2) g2 = 0.f;
#endif
        const float* rb = relb + 6 + hb;
        { int nv = t >= 31 ? ((t - 31) >> 4) + 1 : 0; if (nv > NCMP) nv = NCMP;
          const bf16_t* Kc = KCMP + (size_t)(b * 2 + kvh) * 512 * 64; const bf16_t* Vc = VCMP + (size_t)(b * 2 + kvh) * 512 * 64;
          const f32x2 md = MD[(size_t)row * 10 + hb]; const float w = nv > 0 ? g0 / md.y : 0.f;
          for (int n = 0; n < nv; ++n) { const float s = dot64(q, Kc + n * 64) * 0.125f + rb[t5_bucket(t - 16 * n - 31) * 16]; axpy64(o, __expf(s - md.x) * w, Vc + n * 64); } }
        { const int* sel = SEL + ((size_t)row * 2 + kvh) * 16; const bf16_t* base = PROJ + (size_t)(b * SEQ) * NP + kvh * 64;
          float m = -INFINITY;
          for (int k = 0; k < 16; ++k) { const int p0 = sel[k] * 64; for (int l = 0; l < 64 && p0 + l <= t; ++l) { const int pos = p0 + l; m = fmaxf(m, dot64(q, base + (size_t)pos * NP + C_KS) * 0.125f + rb[t5_bucket(t - pos) * 16]); } }
          float den = 0.f;
          for (int k = 0; k < 16; ++k) { const int p0 = sel[k] * 64; for (int l = 0; l < 64 && p0 + l <= t; ++l) { const int pos = p0 + l; den += __expf(dot64(q, base + (size_t)pos * NP + C_KS) * 0.125f + rb[t5_bucket(t - pos) * 16] - m); } }
          const float w = g1 / den;
          for (int k = 0; k < 16; ++k) { const int p0 = sel[k] * 64; for (int l = 0; l < 64 && p0 + l <= t; ++l) { const int pos = p0 + l; const bf16_t* kr = base + (size_t)pos * NP;
              axpy64(o, __expf(dot64(q, kr + C_KS) * 0.125f + rb[t5_bucket(t - pos) * 16] - m) * w, kr + C_VS); } } }
        { const bf16_t* base = PROJ + (size_t)(b * SEQ) * NP + kvh * 64; const int lo = t - 511 < 0 ? 0 : t - 511;
          float m = -INFINITY;
          for (int pos = lo; pos <= t; ++pos) m = fmaxf(m, dot64(q, base + (size_t)pos * NP + C_KW) * 0.125f + rb[t5_bucket(t - pos) * 16]);
          float den = 0.f;
          for (int pos = lo; pos <= t; ++pos) den += __expf(dot64(q, base + (size_t)pos * NP + C_KW) * 0.125f + rb[t5_bucket(t - pos) * 16] - m);
          const float w = g2 / den;
          for (int pos = lo; pos <= t; ++pos) { const bf16_t* kr = base + (size_t)pos * NP; axpy64(o, __expf(dot64(q, kr + C_KW) * 0.125f + rb[t5_bucket(t - pos) * 16] - m) * w, kr + C_VW); } }
#if MK_PROBE == 4
        { float f[64], fb[64]; bf16_t* p = OMIX + (size_t)row * D + 384 + hb * 64; load_q64(f, p); load_q64(fb, (const bf16_t*)(F.ws + WS_AUX) + (size_t)row * 640 + hb * 64);
#pragma unroll
          for (int d = 0; d < 64; ++d) o[d] = f[d] + PROBE_K * (fb[d] - o[d]);
#pragma unroll
          for (int c = 0; c < 8; ++c) { u32x4 w; w.x = pk2(o[8 * c], o[8 * c + 1]); w.y = pk2(o[8 * c + 2], o[8 * c + 3]); w.z = pk2(o[8 * c + 4], o[8 * c + 5]); w.w = pk2(o[8 * c + 6], o[8 * c + 7]); *(u32x4*)(p + 8 * c) = w; } }
#else
        store64(OMIX + (size_t)row * D + 384 + hb * 64, o, 1.f);
#endif
    }
}

constexpr float LOG2E = 1.4426950408889634f;
constexpr float QSC = 0.125f * LOG2E;
constexpr int ATT_TBN = 0;
constexpr int TBN_SZ = 3616, TBN_PAD = 1088, ATT_BIAS = 3648;
constexpr int TBW_PAD = 64;
constexpr int ATT_TBA = 0;
constexpr int TBA_SZ = 1076, TBA_P16 = 0, TBA_O16 = 16, TBA_P4 = 176, TBA_O4 = 64, TBA_P1 = 436, TBA_O1 = 256;
constexpr int ATT_KVR = 4352;
constexpr int KVR_KROW = 128, KVR_VROW = 136, KVR_VOFF = 64 * KVR_KROW, KVR_SLOT = 64 * KVR_KROW + 64 * KVR_VROW;
constexpr int ATT_TBW = ATT_KVR + 4 * KVR_SLOT, TBW_SZ = 576;
constexpr int ATT_WAVE = ATT_TBW + 5 * TBW_SZ * 2, ATT_WSZ = 8192;
constexpr int ATT_TBWM = ATT_WAVE + 8 * ATT_WSZ, TBWM_LO = 448, TBWM_SZ = 128;
static_assert(6 * TBA_SZ * 4 <= ATT_TBW && ATT_BIAS + 5 * 33 * 4 <= ATT_KVR && ATT_TBWM + 5 * TBWM_SZ * 2 <= LDS_BYTES - 16, "attention LDS map");

typedef __bf16 bf16x2_t __attribute__((ext_vector_type(2)));
__device__ __forceinline__ unsigned cvtpk(float lo, float hi) { f32x2 v = {lo, hi}; bf16x2_t b = __builtin_convertvector(v, bf16x2_t); return __builtin_bit_cast(unsigned, b); }
__device__ __forceinline__ f32x4 mfma16(bf16x8 a, bf16x8 b, f32x4 c) { return __builtin_amdgcn_mfma_f32_16x16x32_bf16(a, b, c, 0, 0, 0); }
__device__ __forceinline__ float ex2(float x) { return __builtin_amdgcn_exp2f(x); }
__device__ __forceinline__ float kgmax(float v) { v = fmaxf(v, __shfl_xor(v, 16)); v = fmaxf(v, __shfl_xor(v, 32)); return v; }
__device__ __forceinline__ float kgsum(float v) { v += __shfl_xor(v, 16); v += __shfl_xor(v, 32); return v; }
__device__ __forceinline__ float dpp_shr(float v, int n) {
    int r = 0;
    if (n == 1) r = __builtin_amdgcn_update_dpp(0, __builtin_bit_cast(int, v), 0x111, 0xf, 0xf, true);
    if (n == 2) r = __builtin_amdgcn_update_dpp(0, __builtin_bit_cast(int, v), 0x112, 0xf, 0xf, true);
    if (n == 4) r = __builtin_amdgcn_update_dpp(0, __builtin_bit_cast(int, v), 0x114, 0xf, 0xf, true);
    return __builtin_bit_cast(float, r);
}
__device__ __forceinline__ float dpp_ror(float v, int n) {
    int r = 0;
    if (n == 1) r = __builtin_amdgcn_update_dpp(0, __builtin_bit_cast(int, v), 0x121, 0xf, 0xf, false);
    if (n == 2) r = __builtin_amdgcn_update_dpp(0, __builtin_bit_cast(int, v), 0x122, 0xf, 0xf, false);
    if (n == 4) r = __builtin_amdgcn_update_dpp(0, __builtin_bit_cast(int, v), 0x124, 0xf, 0xf, false);
    if (n == 8) r = __builtin_amdgcn_update_dpp(0, __builtin_bit_cast(int, v), 0x128, 0xf, 0xf, false);
    return __builtin_bit_cast(float, r);
}
__device__ __forceinline__ float rowmax16(float v) { v = fmaxf(v, dpp_ror(v, 8)); v = fmaxf(v, dpp_ror(v, 4)); v = fmaxf(v, dpp_ror(v, 2)); v = fmaxf(v, dpp_ror(v, 1)); return v; }
__device__ __forceinline__ int dpp_rori(int v, int n) {
    if (n == 1) return __builtin_amdgcn_update_dpp(0, v, 0x121, 0xf, 0xf, false);
    if (n == 2) return __builtin_amdgcn_update_dpp(0, v, 0x122, 0xf, 0xf, false);
    if (n == 4) return __builtin_amdgcn_update_dpp(0, v, 0x124, 0xf, 0xf, false);
    return __builtin_amdgcn_update_dpp(0, v, 0x128, 0xf, 0xf, false);
}
__device__ __forceinline__ int rowmax16i(int v) { v = max(v, dpp_rori(v, 8)); v = max(v, dpp_rori(v, 4)); v = max(v, dpp_rori(v, 2)); v = max(v, dpp_rori(v, 1)); return v; }
__device__ __forceinline__ int rowmin16(int v) { float f = (float)v;
    f = fminf(f, dpp_ror(f, 8)); f = fminf(f, dpp_ror(f, 4)); f = fminf(f, dpp_ror(f, 2)); f = fminf(f, dpp_ror(f, 1)); return (int)f; }
__device__ __forceinline__ float sum5(float v) { const float t1 = v + dpp_shr(v, 1); const float t2 = t1 + dpp_shr(t1, 2); return t2 + dpp_shr(v, 4); }

__device__ __forceinline__ bf16x8 ones8() { const u32x4 w = {0x3f803f80u, 0x3f803f80u, 0x3f803f80u, 0x3f803f80u}; return __builtin_bit_cast(bf16x8, w); }

struct ColState { float m; f32x4 la; f32x4 o[4]; };
__device__ __forceinline__ void cs_init(ColState& s) { s.m = -INFINITY; s.la = (f32x4){0.f, 0.f, 0.f, 0.f};
#pragma unroll
    for (int d = 0; d < 4; ++d) s.o[d] = (f32x4){0.f, 0.f, 0.f, 0.f}; }

constexpr float RESC_THR = 8.f;
template <int NC, class BF>
__device__ __forceinline__ void step32(ColState (&st)[NC], const bf16x8 (&q)[NC][2], const bf16x8 ka0, const bf16x8 ka1, const bf16x8 kb0, const bf16x8 kb1, const bf16x8 (&V)[4], const BF& bias) {
    bf16x8 P[NC];
    const f32x4 z = {0.f, 0.f, 0.f, 0.f};
    const f32x2 qs = {QSC, QSC};
#pragma unroll
    for (int c = 0; c < NC; ++c) {
        f32x4 sA = mfma16(ka0, q[c][0], z); sA = mfma16(ka1, q[c][1], sA);
        f32x4 sB = mfma16(kb0, q[c][0], z); sB = mfma16(kb1, q[c][1], sB);
        f32x2 x0 = (f32x2){sA[0], sA[1]} * qs + (f32x2){bias(c, 0, 0), bias(c, 0, 1)}, x1 = (f32x2){sA[2], sA[3]} * qs + (f32x2){bias(c, 0, 2), bias(c, 0, 3)};
        f32x2 x2 = (f32x2){sB[0], sB[1]} * qs + (f32x2){bias(c, 1, 0), bias(c, 1, 1)}, x3 = (f32x2){sB[2], sB[3]} * qs + (f32x2){bias(c, 1, 2), bias(c, 1, 3)};
        const float mx = fmaxf(fmaxf(fmaxf(fmaxf(x0.x, x0.y), x1.x), fmaxf(fmaxf(x1.y, x2.x), x2.y)), fmaxf(x3.x, x3.y));
        if (__builtin_expect(__any(mx > st[c].m + RESC_THR), 0)) {
            const float mn = fmaxf(st[c].m, kgmax(mx)), mref = (mn == -INFINITY) ? 0.f : mn;
            const float alpha = ex2(st[c].m - mref);
            st[c].la = st[c].la * alpha; st[c].m = mn;
#pragma unroll
            for (int d = 0; d < 4; ++d) st[c].o[d] = st[c].o[d] * alpha;
        }
        const float mref = (st[c].m == -INFINITY) ? 0.f : st[c].m; const f32x2 mm = {mref, mref};
        x0 = x0 - mm; x1 = x1 - mm; x2 = x2 - mm; x3 = x3 - mm;
        const f32x2 p0 = {ex2(x0.x), ex2(x0.y)}, p1 = {ex2(x1.x), ex2(x1.y)}, p2 = {ex2(x2.x), ex2(x2.y)}, p3 = {ex2(x3.x), ex2(x3.y)};
        u32x4 pw = {cvtpk(p0.x, p0.y), cvtpk(p1.x, p1.y), cvtpk(p2.x, p2.y), cvtpk(p3.x, p3.y)};
        P[c] = __builtin_bit_cast(bf16x8, pw);
    }
    __builtin_amdgcn_s_setprio(1);
#pragma unroll
    for (int d = 0; d < 4; ++d)
#pragma unroll
        for (int c = 0; c < NC; ++c) st[c].o[d] = mfma16(V[d], P[c], st[c].o[d]);
#pragma unroll
    for (int c = 0; c < NC; ++c) st[c].la = mfma16(ones8(), P[c], st[c].la);
    __builtin_amdgcn_s_setprio(0);
}
template <class BF>
__device__ __forceinline__ void scores64(f32x2 (&x)[8], const bf16x8 (&q)[2], const bf16x8 (&kf)[4][2], const BF& bias) {
    const f32x4 z = {0.f, 0.f, 0.f, 0.f};
    const f32x2 qs = {QSC, QSC};
#pragma unroll
    for (int t = 0; t < 4; ++t) { f32x4 s = mfma16(kf[t][0], q[0], z); s = mfma16(kf[t][1], q[1], s);
        x[2 * t] = (f32x2){s[0], s[1]} * qs + (f32x2){bias(t, 0), bias(t, 1)}; x[2 * t + 1] = (f32x2){s[2], s[3]} * qs + (f32x2){bias(t, 2), bias(t, 3)}; }
}
template <class VF>
__device__ __forceinline__ void step64_tail(ColState& st, f32x2 (&x)[8], const VF& ldv) {
    float mx = fmaxf(x[0].x, x[0].y);
#pragma unroll
    for (int k = 1; k < 8; ++k) mx = fmaxf(fmaxf(mx, x[k].x), x[k].y);
    const float thr = (st.m == -INFINITY) ? -INFINITY : RESC_THR;
    if (__builtin_expect(__any(mx > thr), 0)) {
        const float mold = (st.m == -INFINITY) ? 0.f : st.m;
        const float mn = fmaxf(st.m, kgmax(mx) + mold), mref = (mn == -INFINITY) ? 0.f : mn;
        const float alpha = ex2(st.m - mref), dm = mref - mold;
        st.la = st.la * alpha; st.m = mn;
#pragma unroll
        for (int d = 0; d < 4; ++d) st.o[d] = st.o[d] * alpha;
#pragma unroll
        for (int k = 0; k < 8; ++k) { x[k].x -= dm; x[k].y -= dm; }
    }
    f32x2 p[8];
#pragma unroll
    for (int k = 0; k < 8; ++k) p[k] = (f32x2){ex2(x[k].x), ex2(x[k].y)};
#pragma unroll
    for (int h = 0; h < 2; ++h) { u32x4 pw = {cvtpk(p[4 * h].x, p[4 * h].y), cvtpk(p[4 * h + 1].x, p[4 * h + 1].y), cvtpk(p[4 * h + 2].x, p[4 * h + 2].y), cvtpk(p[4 * h + 3].x, p[4 * h + 3].y)};
        const bf16x8 P = __builtin_bit_cast(bf16x8, pw);
        bf16x8 V[4]; ldv(h, V);
        __builtin_amdgcn_s_setprio(1);
#pragma unroll
        for (int d = 0; d < 4; ++d) st.o[d] = mfma16(V[d], P, st.o[d]);
        st.la = mfma16(ones8(), P, st.la);
        __builtin_amdgcn_s_setprio(0); }
}
__device__ __forceinline__ void ldv4(bf16x8 (&V)[4], const bf16_t* vA, const bf16_t* vB, const size_t vstep) {
#pragma unroll
    for (int d = 0; d < 4; ++d) { const u32x2 va = *(const u32x2*)(vA + d * vstep), vb = *(const u32x2*)(vB + d * vstep); u32x4 vw = {va.x, va.y, vb.x, vb.y}; V[d] = __builtin_bit_cast(bf16x8, vw); }
}

struct AttnG {
    const bf16_t* PROJ; const bf16_t* KCMP; const bf16_t* VCT; const bf16_t* VTS; const bf16_t* VTW; const bf16_t* VTA1; const bf16_t* VTA4; const bf16_t* VTA16; const bf16_t* KA1; const bf16_t* KA4; const bf16_t* KA16; bf16_t* OMIX;
};

__device__ __forceinline__ void attn_tables_nsa(Frame& F, int kvh) {
    LAS unsigned char* BKT = (LAS unsigned char*)(F.lds + ATT_TBN); LAS float* BIAS = (LAS float*)(F.lds + ATT_BIAS); const float* relb = F.in[1];
    for (int e = F.tid; e < TBN_SZ; e += NTHR) { const int d = e - TBN_PAD; BKT[e] = (unsigned char)(d < 0 ? 32 : t5_bucket(d)); }
    if (F.tid < 5 * 33) { const int g = F.tid / 33, k = F.tid - g * 33; BIAS[F.tid] = k == 32 ? -INFINITY : relb[k * 16 + 6 + kvh * 5 + g] * LOG2E; }
    { LAS unsigned short* TBW = (LAS unsigned short*)(F.lds + ATT_TBW);
      for (int e = F.tid; e < 5 * TBW_SZ; e += NTHR) { const int g = e / TBW_SZ, d = e - g * TBW_SZ - TBW_PAD; TBW[e] = d < 0 ? (unsigned short)0xff80u : (unsigned short)f2bf(relb[t5_bucket(d) * 16 + 6 + kvh * 5 + g] * LOG2E); } }
    { LAS unsigned short* TBWM = (LAS unsigned short*)(F.lds + ATT_TBWM);
      for (int e = F.tid; e < 5 * TBWM_SZ; e += NTHR) { const int g = e / TBWM_SZ, d = e - g * TBWM_SZ + TBWM_LO; TBWM[e] = d > 511 ? (unsigned short)0xff80u : (unsigned short)f2bf(relb[t5_bucket(d) * 16 + 6 + kvh * 5 + g] * LOG2E); } }
    __syncthreads();
}
__device__ __forceinline__ void attn_tables_mixa(Frame& F) {
    LAS float* TBA = (LAS float*)(F.lds + ATT_TBA); const float* relb = F.in[1];
    for (int e = F.tid; e < 6 * TBA_SZ; e += NTHR) { const int h = e / TBA_SZ, k = e - h * TBA_SZ; int j, dil;
        if (k < TBA_P4) { j = k - TBA_P16 - TBA_O16; dil = 16; } else if (k < TBA_P1) { const int e2 = k - TBA_P4, lo = e2 / 65, hi = e2 - lo * 65; j = 4 * hi + lo - TBA_O4; dil = 4; } else { j = k - TBA_P1 - TBA_O1; dil = 1; }
        TBA[e] = (j < 0 || j > 128) ? -INFINITY : relb[t5_bucket(dil * j) * 16 + h] * LOG2E; }
    __syncthreads();
}

__device__ __forceinline__ void vt_item(const bf16_t* src  , int dil, int cls, int m64, bf16_t* dst  , LAS unsigned char* wl, int lane, bool blocked) {
    constexpr int RS = 136;
#pragma unroll
    for (int it = 0; it < 8; ++it) { const int k = it * 8 + (lane >> 3), c = lane & 7; const int t = cls + dil * (64 * m64 + k);
        const u32x4 v = *(const u32x4*)(src + (size_t)t * NP + c * 8);
        *(LAS u32x2*)(wl + k * RS + c * 16) = (u32x2){v.x, v.y}; *(LAS u32x2*)(wl + k * RS + c * 16 + 8) = (u32x2){v.z, v.w}; }
    LDS_WAIT(); asm volatile("" ::: "memory");
    const int pos0 = cls * (SEQ / dil) + 64 * m64;
#pragma unroll
    for (int it = 0; it < 8; ++it) { const int dim = (lane >> 3) + 8 * it, c = lane & 7; unsigned short e[8];
#pragma unroll
        for (int k = 0; k < 8; ++k) e[k] = *(const LAS unsigned short*)(wl + (8 * c + k) * RS + dim * 2);
        u32x4 o = {(unsigned)e[0] | ((unsigned)e[1] << 16), (unsigned)e[2] | ((unsigned)e[3] << 16), (unsigned)e[4] | ((unsigned)e[5] << 16), (unsigned)e[6] | ((unsigned)e[7] << 16)};
        const int pos = pos0 + 8 * c;
        *(u32x4*)(blocked ? dst + (size_t)(pos >> 4) * 1024 + dim * 16 + (pos & 15) : dst + (size_t)dim * SEQ + pos) = o; }
    LDS_WAIT(); asm volatile("" ::: "memory");
}
__device__ __forceinline__ void kt_item(const bf16_t* src  , int dil, int cls, int m64, bf16_t* dst, int lane) {
    const int pos0 = cls * (SEQ / dil) + 64 * m64;
#pragma unroll
    for (int it = 0; it < 8; ++it) { const int k = it * 8 + (lane >> 3), c = lane & 7; const int t = cls + dil * (64 * m64 + k), pos = pos0 + k;
        const u32x4 v = *(const u32x4*)(src + (size_t)t * NP + c * 8);
        *(u32x4*)(dst + (size_t)(pos >> 4) * 1024 + (c >> 2) * 512 + (pos & 15) * 32 + (c & 3) * 8) = v; }
}
__device__ __forceinline__ void vt_phase(Frame& F, int w0, int nw) {
    const bf16_t* PROJ = (const bf16_t*)(F.ws + WS_PROJ); LAS unsigned char* wl = F.lds + F.wave * 16384;
    for (int it = w0; it < 2048 + 2 * 3072; it += nw) {
        if (it < 2048) { const int w = it >> 10, r = it & 1023, bk = r >> 7, m64 = r & 127, b = bk >> 1, kvh = bk & 1;
            vt_item(PROJ + (size_t)b * SEQ * NP + (w ? C_VW : C_VS) + kvh * 64, 1, 0, m64, (bf16_t*)(F.ws + (w ? WS_VTW : WS_VTS)) + (size_t)bk * 64 * SEQ, wl, F.lane, false); }
        else { const int r0 = it - 2048, lay = r0 / 3072, r = r0 - lay * 3072, bh = r >> 7, m = r & 127, b = bh / 6, h = bh - b * 6;
            const int dil = lay == 0 ? 1 : 16; const int per = 128 / dil, cls = m / per, m64 = m - cls * per;
            vt_item(PROJ + (size_t)b * SEQ * NP + C_VA + h * 64, dil, cls, m64, (bf16_t*)(F.ws + (lay == 0 ? WS_VTA1 : WS_VTA16)) + (size_t)bh * 64 * SEQ, wl, F.lane, true);
            kt_item(PROJ + (size_t)b * SEQ * NP + C_KA + h * 64, dil, cls, m64, (bf16_t*)(F.ws + (lay == 0 ? WS_KA1 : WS_KA16)) + (size_t)bh * 64 * SEQ, F.lane); }
    }
}

struct KVF { bf16x8 ka0, ka1, kb0, kb1; bf16x8 V[4]; };
__device__ __forceinline__ void mixa_item(const AttnG& G, LAS const float* TBh, int b, int h, int r16, int i0, int lane_in) {
    int lane = lane_in; asm volatile("" : "+v"(lane));
    const int i = lane & 15, kg = lane >> 4;
    const int tq = r16 + 16 * (i0 + i);
    const bf16_t* Pb = G.PROJ + (size_t)b * SEQ * NP;
    bf16x8 q[1][2];
    { const bf16_t* qp = Pb + (size_t)tq * NP + C_QA + h * 64 + 8 * kg; q[0][0] = *(const bf16x8*)qp; q[0][1] = *(const bf16x8*)(qp + 32); }
    ColState st[1]; cs_init(st[0]);
    const bf16_t* Kb = Pb + C_KA + h * 64 + 8 * kg;
    const size_t khead = (size_t)(b * 6 + h) * 64 * SEQ + (size_t)i * 32 + 8 * kg;
    const size_t vhead = (size_t)(b * 6 + h) * 64 * SEQ + (size_t)i * 16 + 4 * kg;
    const int r4 = r16 & 3, c4 = r16 >> 2;
    const size_t khead4 = (size_t)(b * 6 + h) * 64 * SEQ + (size_t)(r4 + 4 * (i >> 2)) * 512 * 64 + (size_t)(i & 3) * 32 + 8 * kg;
    const size_t vhead4 = (size_t)(b * 6 + h) * 64 * SEQ + (size_t)(r4 + 4 * kg) * 512 * 64 + (size_t)i * 16;
    const int j4 = c4 + 4 * i + 128 - kg + TBA_O4, jt4 = TBA_P4 + (j4 & 3) * 65 + (j4 >> 2);
    auto ks0_of = [&](int s) -> int { return s < 5 ? i0 - 144 + 32 * s : (s < 11 ? 4 * i0 - 128 + 32 * (s - 5) : 16 * i0 - 128 + 32 * (s - 11)); };
    auto jt_of = [&](int s) -> int { return s < 5 ? (i + 144 - 4 * kg + TBA_P16 + TBA_O16) - 32 * s : (s < 11 ? jt4 - 8 * (s - 5) : (r16 + 16 * i + 128 - 4 * kg + TBA_P1 + TBA_O1) - 32 * (s - 11)); };
    auto load = [&](KVF& f, int s) { const int ks0 = ks0_of(s); const int kA = ks0 < 0 ? 0 : ks0, kB = ks0 + 16 < 0 ? 0 : ks0 + 16;
        const bf16_t* ra; const bf16_t* rb; const bf16_t* va; const bf16_t* vb2;
        if (s >= 5 && s < 11) {
            const int pA = kA >> 2, pB = kB >> 2;
            ra = G.KA16 + khead4 + (size_t)(pA >> 4) * 1024 + (pA & 15) * 32; rb = G.KA16 + khead4 + (size_t)(pB >> 4) * 1024 + (pB & 15) * 32;
            va = G.VTA16 + vhead4 + (size_t)(pA >> 4) * 1024 + (pA & 15); vb2 = G.VTA16 + vhead4 + (size_t)(pB >> 4) * 1024 + (pB & 15);
        } else {
            const bf16_t* kb_ = (s < 5 ? G.KA16 + r16 * 512 * 64 : G.KA1) + khead;
            ra = kb_ + (size_t)(kA >> 4) * 1024; rb = kb_ + (size_t)(kB >> 4) * 1024;
            const bf16_t* vb = (s < 5 ? G.VTA16 + r16 * 512 * 64 : G.VTA1) + vhead;
            va = vb + (size_t)(kA >> 4) * 1024; vb2 = vb + (size_t)(kB >> 4) * 1024; }
        f.ka0 = *(const bf16x8*)ra; f.ka1 = *(const bf16x8*)(ra + 512); f.kb0 = *(const bf16x8*)rb; f.kb1 = *(const bf16x8*)(rb + 512);
        ldv4(f.V, va, vb2, (size_t)256); };
    auto comp = [&](const KVF& f, int s) { const int ks0 = ks0_of(s); const int jt = jt_of(s);
        const int jA = ks0 >= 0 ? jt : TBA_P16 + 3, jB = ks0 + 16 >= 0 ? jt - ((s >= 5 && s < 11) ? 4 : 16) : TBA_P16 + 3;
        step32<1>(st, q, f.ka0, f.ka1, f.kb0, f.kb1, f.V, [&](int, int tile, int r) -> float { return TBh[(tile == 0 ? jA : jB) - r]; }); };
    KVF fa, fb, fc;
    load(fa, 0); load(fb, 1);
#pragma unroll 1
    for (int s = 0; s < 21; s += 3) { load(fc, s + 2); comp(fa, s); load(fa, s + 3); comp(fb, s + 1); load(fb, s + 4); comp(fc, s + 2); }
    comp(fa, 21); comp(fb, 22);
    const float inv = 1.f / st[0].la[0];
    bf16_t* op = G.OMIX + (size_t)(b * SEQ + tq) * D + h * 64 + 4 * kg;
#pragma unroll
    for (int d = 0; d < 4; ++d) { const f32x4 o = st[0].o[d] * inv; *(u32x2*)(op + 16 * d) = (u32x2){cvtpk(o[0], o[1]), cvtpk(o[2], o[3])}; }
}

#if MK_PROBE == 4
#define AUX_STORE(BR, J, D, VAL) do { if (MK_PBR == (BR) && cv[J]) { const f32x4 v_ = (VAL); *(u32x2*)(AUXP + (size_t)(b * SEQ + tcol[J]) * 640 + hb * 64 + 4 * kg + 16 * (D)) = (u32x2){cvtpk(v_[0], v_[1]), cvtpk(v_[2], v_[3])}; } } while (0)
#else
#define AUX_STORE(BR, J, D, VAL) do { } while (0)
#endif
__device__ __forceinline__ void nsa_group(Frame& F, const AttnG& G, int b, int kvh, int grp) {
    int lane = F.lane; asm volatile("" : "+v"(lane));
    const int t0 = 64 * grp + 8 * F.wave;
    LAS unsigned char* wl = F.lds + ATT_WAVE + F.wave * ATT_WSZ;
    const int i = lane & 15, kg = lane >> 4, g = i % 5, i5 = i / 5, hb = kvh * 5 + g;
    const int cur = grp, bk = b * 2 + kvh;
    const bf16_t* Pb = G.PROJ + (size_t)b * SEQ * NP; const bf16_t* GTb = (const bf16_t*)(F.ws + WS_GATES) + (size_t)b * SEQ * 32;
#if MK_PROBE == 4
    bf16_t* AUXP = (bf16_t*)((unsigned char*)G.OMIX - WS_XN + WS_AUX);
#endif
    LAS const unsigned char* BKT = (LAS const unsigned char*)(F.lds + ATT_TBN) + TBN_PAD; LAS const float* BIASg = (LAS const float*)(F.lds + ATT_BIAS) + g * 33;
    auto tbg = [&](int d) -> float { return BIASg[BKT[d]]; };
    const float b31 = BIASg[31];
    LAS const unsigned short* TBWg = (LAS const unsigned short*)(F.lds + ATT_TBW) + g * TBW_SZ + TBW_PAD;
    auto tbn = [&](int d) -> float { return __builtin_bit_cast(float, (unsigned)TBWg[d] << 16); };
    int tcol[3]; bool cv[3]; bf16x8 q[3][2];
#pragma unroll
    for (int j = 0; j < 3; ++j) { int tql = 3 * j + i5; cv[j] = (i < 15) && (tql < 8); if (tql > 7) tql = 7; tcol[j] = t0 + tql;
        const bf16_t* qp = Pb + (size_t)tcol[j] * NP + C_QB + hb * 64 + 8 * kg; q[j][0] = *(const bf16x8*)qp; q[j][1] = *(const bf16x8*)(qp + 32); }
    auto gate_of = [&](int j, int k) -> float { return 1.f / (1.f + __expf(-bf2f(GTb[(size_t)tcol[j] * 32 + hb * 3 + k]))); };
    LAS unsigned char* ring = F.lds + ATT_KVR;
    const int sr = F.tid >> 3, scc = F.tid & 7;
    int bc = 0;
#define RING_WRITE(SLOT, KR, VR, WITHV) do { LAS unsigned char* sl_ = ring + (SLOT) * KVR_SLOT; *(LAS u32x4*)(sl_ + sr * 128 + ((scc ^ ((sr >> 1) & 7)) << 4)) = KR; \
        if (WITHV) { *(LAS u32x2*)(sl_ + KVR_VOFF + sr * KVR_VROW + scc * 16) = (u32x2){VR.x, VR.y}; *(LAS u32x2*)(sl_ + KVR_VOFF + sr * KVR_VROW + scc * 16 + 8) = (u32x2){VR.z, VR.w}; } } while (0)
    const int fsw = (i >> 1) & 7;
    const int kofs0 = i * 128 + ((kg ^ fsw) << 4), kofs1 = i * 128 + (((kg + 4) ^ fsw) << 4);
#define RING_K(SL, KF) do { _Pragma("unroll") for (int kt_ = 0; kt_ < 4; ++kt_) { KF[kt_][0] = *(LAS const bf16x8*)((SL) + 2048 * kt_ + kofs0); KF[kt_][1] = *(LAS const bf16x8*)((SL) + 2048 * kt_ + kofs1); } } while (0)
#define RING_K2(SL, HF, KF) do { _Pragma("unroll") for (int kt_ = 0; kt_ < 2; ++kt_) { KF[kt_][0] = *(LAS const bf16x8*)((SL) + 4096 * (HF) + 2048 * kt_ + kofs0); KF[kt_][1] = *(LAS const bf16x8*)((SL) + 4096 * (HF) + 2048 * kt_ + kofs1); } } while (0)
#define RING_V(SL, HF, VV) do { _Pragma("unroll") for (int d_ = 0; d_ < 4; ++d_) { const u32x2 va_ = *(LAS const u32x2*)((SL) + KVR_VOFF + (i + 16 * d_) * KVR_VROW + 64 * (HF) + 8 * kg), vb_ = *(LAS const u32x2*)((SL) + KVR_VOFF + (i + 16 * d_) * KVR_VROW + 64 * (HF) + 32 + 8 * kg); \
        u32x4 vw_ = {va_.x, va_.y, vb_.x, vb_.y}; VV[d_] = __builtin_bit_cast(bf16x8, vw_); } } while (0)
#define RING_BAR() asm volatile("s_waitcnt lgkmcnt(0)\n\ts_barrier" ::: "memory")
    auto ring_run = [&](const int nb, auto ksrc, auto vsrc, const bool withv, auto compute) {
        const int ns = (nb + 1) >> 1;
        u32x4 k0, v0 = {0u, 0u, 0u, 0u}, k1, v1 = v0;
        auto ld = [&](int p) { const int n0 = 2 * p < nb ? 2 * p : nb - 1, n1 = 2 * p + 1 < nb ? 2 * p + 1 : nb - 1;
            k0 = *(const u32x4*)ksrc(n0); k1 = *(const u32x4*)ksrc(n1); if (withv) { v0 = *(const u32x4*)vsrc(n0); v1 = *(const u32x4*)vsrc(n1); } };
        if (nb > 0) { ld(0); const int s0 = 2 * (bc & 1); RING_WRITE(s0, k0, v0, withv); RING_WRITE(s0 + 1, k1, v1, withv); ld(1); }
        RING_BAR();
#pragma unroll 1
        for (int p = 0; p < ns; ++p) {
            const int s0 = 2 * ((bc + p) & 1);
            compute(2 * p, (LAS const unsigned char*)(ring + s0 * KVR_SLOT));
            if (2 * p + 1 < nb) compute(2 * p + 1, (LAS const unsigned char*)(ring + (s0 + 1) * KVR_SLOT));
            if (p + 1 < ns) { const int s1 = 2 - s0; RING_WRITE(s1, k0, v0, withv); RING_WRITE(s1 + 1, k1, v1, withv); }
            RING_BAR();
            ld(p + 2);
        }
        bc += ns;
    };
    f32x4 out[3][4];
    {
        int NVg = (64 * grp + 63 >= 31) ? ((64 * grp + 63 - 31) >> 4) + 1 : 0; if (NVg > NCMP) NVg = NCMP;
        const int ncb = (NVg + 63) >> 6;
        const bf16_t* kcs = G.KCMP + ((size_t)bk * 512 + sr) * 64 + scc * 8;
        const bf16_t* vcs = G.VCT + ((size_t)bk * 64 + sr) * 512 + scc * 8;
        const f32x4 z = {0.f, 0.f, 0.f, 0.f};
        float m1[3] = {-INFINITY, -INFINITY, -INFINITY}, l1[3] = {0.f, 0.f, 0.f};
        ring_run(ncb, [&](int n) { return kcs + (size_t)n * 64 * 64; }, [&](int n) { return vcs + n * 64; }, false, [&](int cb, LAS const unsigned char* sl) {
            const bool cfar = (t0 - 31 - 16 * (64 * cb + 63)) >= 1513;
            bf16x8 kf[4][2]; RING_K(sl, kf);
#pragma unroll
            for (int j = 0; j < 3; ++j) { const float mold = (m1[j] == -INFINITY) ? 0.f : m1[j]; float x[16];
                if (cfar) { const float bm = b31 - mold;
#pragma unroll
                    for (int kt = 0; kt < 4; ++kt) { f32x4 sc = mfma16(kf[kt][0], q[j][0], z); sc = mfma16(kf[kt][1], q[j][1], sc);
#pragma unroll
                        for (int r = 0; r < 4; ++r) x[4 * kt + r] = sc[r] * QSC + bm; }
                } else {
                    LAS const unsigned char* pb1 = BKT + (tcol[j] - 31 - 64 * kg - 1024 * cb - 816);
#pragma unroll
                    for (int kt = 0; kt < 4; ++kt) { f32x4 sc = mfma16(kf[kt][0], q[j][0], z); sc = mfma16(kf[kt][1], q[j][1], sc);
#pragma unroll
                        for (int r = 0; r < 4; ++r) x[4 * kt + r] = (sc[r] * QSC + BIASg[pb1[816 - 256 * kt - 16 * r]]) - mold; }
                }
                float mx = fmaxf(x[0], x[1]);
#pragma unroll
                for (int k = 2; k < 16; ++k) mx = fmaxf(mx, x[k]);
                const float thr = (m1[j] == -INFINITY) ? -INFINITY : RESC_THR;
                if (__builtin_expect(__any(mx > thr), 0)) { const float mn = fmaxf(m1[j], mx + mold), mref = (mn == -INFINITY) ? 0.f : mn, dm = mref - mold;
                    l1[j] *= ex2(m1[j] - mref); m1[j] = mn;
#pragma unroll
                    for (int k = 0; k < 16; ++k) x[k] -= dm; }
                float sm = 0.f;
#pragma unroll
                for (int k = 0; k < 16; ++k) sm += ex2(x[k]);
                l1[j] += sm; }
        });
        float Mr[3], iL[3];
#pragma unroll
        for (int j = 0; j < 3; ++j) { const float Mx = kgmax(m1[j]); const float Mr_ = (Mx == -INFINITY) ? 0.f : Mx; const float L = kgsum(l1[j] * ex2(m1[j] - Mr_));
            Mr[j] = L > 0.f ? Mr_ + __builtin_amdgcn_logf(L) : INFINITY; iL[j] = 1.f; }
        ColState st[3];
#pragma unroll
        for (int j = 0; j < 3; ++j) cs_init(st[j]);
        LAS float* IOWN = (LAS float*)wl; LAS float* ICAR = (LAS float*)(wl + 4096);
        ring_run(ncb, [&](int n) { return kcs + (size_t)n * 64 * 64; }, [&](int n) { return vcs + n * 64; }, true, [&](int cb, LAS const unsigned char* sl) {
            const bool cfar = (t0 - 31 - 16 * (64 * cb + 63)) >= 1513;
#pragma unroll 1
            for (int hf = 0; hf < 2; ++hf) {
                bf16x8 kf2[2][2]; RING_K2(sl, hf, kf2);
                bf16x8 V[4]; RING_V(sl, hf, V);
                const int kt = 4 * cb + 2 * hf;
                bf16x8 P[3];
#pragma unroll
                for (int j = 0; j < 3; ++j) { f32x4 sA = mfma16(kf2[0][0], q[j][0], z); sA = mfma16(kf2[0][1], q[j][1], sA); f32x4 sB = mfma16(kf2[1][0], q[j][0], z); sB = mfma16(kf2[1][1], q[j][1], sB);
                    const int db = tcol[j] - 31 - 64 * kg - 256 * kt; float p[8];
                    if (cfar) { const float bm = b31 - Mr[j];
#pragma unroll
                        for (int r = 0; r < 4; ++r) { p[r] = ex2(sA[r] * QSC + bm); p[4 + r] = ex2(sB[r] * QSC + bm); }
                    } else { LAS const unsigned char* pb2 = BKT + (db - 304);
#pragma unroll
                        for (int r = 0; r < 4; ++r) { p[r] = ex2(sA[r] * QSC + BIASg[pb2[304 - 16 * r]] - Mr[j]); p[4 + r] = ex2(sB[r] * QSC + BIASg[pb2[48 - 16 * r]] - Mr[j]); } }
                    const float ownA = sum5((p[0] + p[1]) + (p[2] + 0.5f * p[3])), carA = sum5(0.5f * p[3]), ownB = sum5((p[4] + p[5]) + (p[6] + 0.5f * p[7])), carB = sum5(0.5f * p[7]);
                    if (cv[j] && g == 4) { const int tql = 3 * j + i5; IOWN[tql * 128 + 4 * kt + kg] = ownA; ICAR[tql * 128 + 4 * kt + kg] = carA; IOWN[tql * 128 + 4 * kt + 4 + kg] = ownB; ICAR[tql * 128 + 4 * kt + 4 + kg] = carB; }
                    u32x4 pw = {cvtpk(p[0], p[1]), cvtpk(p[2], p[3]), cvtpk(p[4], p[5]), cvtpk(p[6], p[7])}; P[j] = __builtin_bit_cast(bf16x8, pw); }
#pragma unroll
                for (int d = 0; d < 4; ++d)
#pragma unroll
                    for (int j = 0; j < 3; ++j) st[j].o[d] = mfma16(V[d], P[j], st[j].o[d]);
            }
        });
#pragma unroll
        for (int j = 0; j < 3; ++j) { const float g0 = gate_of(j, 0);
#pragma unroll
            for (int d = 0; d < 4; ++d) { out[j][d] = st[j].o[d] * g0; AUX_STORE(0, j, d, out[j][d]); } }
    }
    LDS_WAIT(); asm volatile("" ::: "memory");
    unsigned selb[2];
    {
        int l2 = lane; asm volatile("" : "+v"(l2)); const int i = l2 & 15, kg = l2 >> 4;
        LAS const float* IOWN = (LAS const float*)wl; LAS const float* ICAR = (LAS const float*)(wl + 4096);
        const int ncand = cur - 2 > 0 ? cur - 2 : 0, nforced = cur == 0 ? 1 : (cur == 1 ? 2 : 3), nfree = 16 - nforced;
#pragma unroll
        for (int ps = 0; ps < 2; ++ps) { const int tql = ps * 4 + kg; int v[8]; unsigned sb = 0u;
#pragma unroll
            for (int k = 0; k < 8; ++k) { const int s = i + 16 * k; const bool forced = (s == 0) | (s == cur) | (s == cur - 1); const bool cand = (s >= 1) && (s <= cur - 2);
                if (forced && s <= cur) sb |= 1u << k;
                const float imp = cand ? IOWN[tql * 128 + s] + ICAR[tql * 128 + s - 1] : 0.f;
                v[k] = cand ? (int)((__builtin_bit_cast(unsigned, imp) & ~127u) | (unsigned)(127 - s)) : -1; }
            if (ncand <= nfree) {
#pragma unroll
                for (int k = 0; k < 8; ++k) { const int s = i + 16 * k; if ((s >= 1) && (s <= cur - 2)) sb |= 1u << k; }
            } else {
#pragma unroll 1
                for (int rd = 0; rd < nfree; ++rd) {
                    int lm = max(max(max(v[0], v[1]), max(v[2], v[3])), max(max(v[4], v[5]), max(v[6], v[7])));
                    const int rm = rowmax16i(lm);
#pragma unroll
                    for (int k = 0; k < 8; ++k) if (v[k] == rm) { v[k] = -1; sb |= 1u << k; }
                }
            }
            selb[ps] = sb; }
    }
    LDS_WAIT(); asm volatile("" ::: "memory");
    LAS unsigned char* SELB = wl + 6144;
    SELB[(0 * 4 + kg) * 16 + i] = (unsigned char)selb[0]; SELB[(1 * 4 + kg) * 16 + i] = (unsigned char)selb[1];
    LAS unsigned char* FM = wl + 6272;
    { LDS_WAIT(); asm volatile("" ::: "memory");
#pragma unroll
      for (int hh = 0; hh < 2; ++hh) { const int s = lane + 64 * hh; unsigned m = 0u;
#pragma unroll
          for (int tk = 0; tk < 8; ++tk) m |= (((unsigned)SELB[tk * 16 + (s & 15)] >> (s >> 4)) & 1u) << tk;
          FM[s] = (unsigned char)m; }
      LDS_WAIT(); asm volatile("" ::: "memory"); }
#define PARK_OUT() do { _Pragma("unroll") for (int j = 0; j < 3; ++j) _Pragma("unroll") for (int d = 0; d < 4; ++d) \
        *(LAS u32x2*)(wl + ((j * 4 + d) * 64 + lane) * 8) = (u32x2){cvtpk(out[j][d][0], out[j][d][1]), cvtpk(out[j][d][2], out[j][d][3])}; } while (0)
#define UNPARK(J, D) ({ const u32x2 pk_ = *(LAS const u32x2*)(wl + (((J) * 4 + (D)) * 64 + lane) * 8); (f32x4){bf_lo(pk_.x), bf_hi(pk_.x), bf_lo(pk_.y), bf_hi(pk_.y)}; })
    PARK_OUT();
    {
        ColState sw[3];
#pragma unroll
        for (int j = 0; j < 3; ++j) cs_init(sw[j]);
        const bf16_t* kws = Pb + (size_t)sr * NP + C_KW + kvh * 64 + scc * 8; const bf16_t* vws = G.VTW + ((size_t)bk * 64 + sr) * SEQ + scc * 8;
        const int blo = cur - 8 > 0 ? cur - 8 : 0;
        ring_run(cur - blo + 1, [&](int n) { return kws + (size_t)64 * (blo + n) * NP; }, [&](int n) { return vws + 64 * (blo + n); }, true, [&](int n_, LAS const unsigned char* sl) {
            const int blk = blo + n_;
            LAS const unsigned short* tb = (blk == cur - 8) ? (LAS const unsigned short*)(F.lds + ATT_TBWM) + g * TBWM_SZ - TBWM_LO : TBWg;
#pragma unroll 1
            for (int hf = 0; hf < 2; ++hf) {
                bf16x8 kf2[2][2]; RING_K2(sl, hf, kf2);
                bf16x8 V[4]; RING_V(sl, hf, V);
                LAS const volatile unsigned short* pw[3];
#pragma unroll
                for (int j = 0; j < 3; ++j) { pw[j] = tb + (tcol[j] - 64 * blk - 32 * hf - 4 * kg - 19); asm volatile("" : "+v"(pw[j])); }
                step32<3>(sw, q, kf2[0][0], kf2[0][1], kf2[1][0], kf2[1][1], V, [&](int c, int tile, int r) -> float { return __builtin_bit_cast(float, (unsigned)pw[c][19 - 16 * tile - r] << 16); }); }
        });
#pragma unroll
        for (int j = 0; j < 3; ++j) { const float sc = gate_of(j, 2) / sw[j].la[0];
#pragma unroll
            for (int d = 0; d < 4; ++d) { AUX_STORE(2, j, d, sw[j].o[d] * sc); out[j][d] = UNPARK(j, d) + sw[j].o[d] * sc; } }
    }
    LDS_WAIT(); asm volatile("" ::: "memory");
    PARK_OUT();
    {
        ColState ss[3];
#pragma unroll
        for (int j = 0; j < 3; ++j) cs_init(ss[j]);
        const bf16_t* kgs = Pb + (size_t)sr * NP + C_KS + kvh * 64 + scc * 8; const bf16_t* vgs = G.VTS + ((size_t)bk * 64 + sr) * SEQ + scc * 8;
        ring_run(cur + 1, [&](int n) { return kgs + (size_t)64 * n * NP; }, [&](int n) { return vgs + 64 * n; }, true, [&](int s, LAS const unsigned char* sl) {
            const unsigned fm = __builtin_amdgcn_readfirstlane((unsigned)FM[s]);
            if (fm != 0u) {
                const bool far = (t0 - 64 * s - 63) >= 1513;
                bf16x8 kf[4][2]; RING_K(sl, kf);
                auto ldv = [&](int h, bf16x8 (&VV)[4]) { RING_V(sl, h, VV); };
#pragma unroll
                for (int j = 0; j < 3; ++j) if ((fm >> (3 * j)) & 7u) {
                    const bool colok = cv[j] && ((fm >> (3 * j + i5)) & 1u);
                    f32x2 x[8];
                    const float mref = (ss[j].m == -INFINITY) ? 0.f : ss[j].m;
                    if (far) {
                        const float bc_ = colok ? b31 - mref : -INFINITY;
                        scores64(x, q[j], kf, [&](int, int) -> float { return bc_; });
                    } else {
                        LAS const unsigned char* pb = BKT + (colok ? tcol[j] - 64 * s - 4 * kg : -1) - 51;
                        scores64(x, q[j], kf, [&](int tile, int r) -> float { return BIASg[pb[51 - 16 * tile - r]]; });
#pragma unroll
                        for (int k = 0; k < 8; ++k) { x[k].x -= mref; x[k].y -= mref; }
                    }
                    step64_tail(ss[j], x, ldv);
                }
            }
        });
#pragma unroll
        for (int j = 0; j < 3; ++j) { const float sc = gate_of(j, 1) / ss[j].la[0];
#pragma unroll
            for (int d = 0; d < 4; ++d) { AUX_STORE(1, j, d, ss[j].o[d] * sc); out[j][d] = UNPARK(j, d) + ss[j].o[d] * sc; } }
    }
#pragma unroll
    for (int j = 0; j < 3; ++j) if (cv[j]) { bf16_t* op = G.OMIX + (size_t)(b * SEQ + tcol[j]) * D + 384 + hb * 64 + 4 * kg;
#pragma unroll
        for (int d = 0; d < 4; ++d) *(u32x2*)(op + 16 * d) = (u32x2){cvtpk(out[j][d][0], out[j][d][1]), cvtpk(out[j][d][2], out[j][d][3])}; }
    LDS_WAIT(); asm volatile("" ::: "memory");
#undef PARK_OUT
#undef UNPARK
#undef RING_WRITE
#undef RING_BAR
#undef RING_K
#undef RING_K2
#undef RING_V
}

__device__ __forceinline__ bool mixa_dynamic(int G) { return G % 8 == 0 && G > 64; }
__device__ __forceinline__ int mixa_early(int G) { return G > 64 ? (G - 32) * NWAVES * 4 : 0; }
__device__ __forceinline__ void mixa_run(Frame& F, const AttnG& G, const unsigned* stop, unsigned stopn, bool early_static) {
    LAS const float* TBA = (LAS const float*)(F.lds + ATT_TBA); const int NGW = F.G * NWAVES, total = 4 * 6 * 512;
    if (mixa_dynamic(F.G)) {
        unsigned* qh = (unsigned*)(F.ws + WS_CTL) + CW_MIXQ; const int per = NGW / 8, x0 = (int)(blockIdx.x & 7);
        for (int k = 0; k < 8; ++k) { const int x = (x0 + k) & 7;
            for (;;) { int qi = 0;
                if (F.lane == 0) { const bool go = stop == nullptr || __hip_atomic_load(stop, __ATOMIC_RELAXED, __HIP_MEMORY_SCOPE_AGENT) < stopn;
                    qi = go ? (int)__hip_atomic_fetch_add(qh + 64 * x, 1u, __ATOMIC_RELAXED, __HIP_MEMORY_SCOPE_AGENT) : (1 << 28); }
                qi = __builtin_amdgcn_readfirstlane(qi);
                if (qi >= (1 << 28)) return;
                const int it = (qi / per) * NGW + x * per + (qi % per); if (it >= total) break;
                const int bh = it >> 9, tile = it & 511, b = bh / 6, h = bh - b * 6, r16 = tile & 15, i0 = (tile >> 4) * 16;
                mixa_item(G, TBA + h * TBA_SZ, b, h, r16, i0, F.lane); } }
    } else {
        const int n1 = mixa_early(F.G);
        int it, step, end;
        if (early_static) { it = ((int)blockIdx.x - 32) * NWAVES + F.wave; step = (F.G - 32) * NWAVES; end = n1; } else { it = n1 + F.vcu * NWAVES + F.wave; step = NGW; end = total; }
        for (; it < end; it += step) { const int bh = it >> 9, tile = it & 511, b = bh / 6, h = bh - b * 6, r16 = tile & 15, i0 = (tile >> 4) * 16;
            mixa_item(G, TBA + h * TBA_SZ, b, h, r16, i0, F.lane); }
    }
}
__device__ __forceinline__ void mixa_early_phase(Frame& F) {
    AttnG G{(const bf16_t*)(F.ws + WS_PROJ), (const bf16_t*)(F.ws + WS_KCMP), (const bf16_t*)(F.ws + WS_VCT), (const bf16_t*)(F.ws + WS_VTS), (const bf16_t*)(F.ws + WS_VTW),
            (const bf16_t*)(F.ws + WS_VTA1), (const bf16_t*)(F.ws + WS_VTA4), (const bf16_t*)(F.ws + WS_VTA16), (const bf16_t*)(F.ws + WS_KA1), (const bf16_t*)(F.ws + WS_KA4), (const bf16_t*)(F.ws + WS_KA16), (bf16_t*)(F.ws + WS_XN)};
    attn_tables_mixa(F);
    mixa_run(F, G, (const unsigned*)(F.ws + WS_CTL) + CW_CMPDONE, 32u, true);
}
__device__ __forceinline__ void attn_phase(Frame& F) {
    const int kvh = blockIdx.x & 1;
    AttnG G{(const bf16_t*)(F.ws + WS_PROJ), (const bf16_t*)(F.ws + WS_KCMP), (const bf16_t*)(F.ws + WS_VCT), (const bf16_t*)(F.ws + WS_VTS), (const bf16_t*)(F.ws + WS_VTW),
            (const bf16_t*)(F.ws + WS_VTA1), (const bf16_t*)(F.ws + WS_VTA4), (const bf16_t*)(F.ws + WS_VTA16), (const bf16_t*)(F.ws + WS_KA1), (const bf16_t*)(F.ws + WS_KA4), (const bf16_t*)(F.ws + WS_KA16), (bf16_t*)(F.ws + WS_XN)};
    attn_tables_nsa(F, kvh);
    { for (int idx = (int)(blockIdx.x >> 1); idx < 512; idx += (F.G >> 1)) { const int b = idx >> 7; int grp = idx & 127; if (b & 1) grp = 127 - grp;
          nsa_group(F, G, b, kvh, grp); } }
    __syncthreads();
    attn_tables_mixa(F);
    mixa_run(F, G, nullptr, 0u, false);
}

__device__ __forceinline__ void p7_router(Frame& F) {
    const bf16_t* h = (const bf16_t*)(F.ws + WS_HBF); const float* gffn = F.in[11];
    const bf16_t* wrh = (const bf16_t*)(F.ws + WS_WRH); const bf16_t* wrl = (const bf16_t*)(F.ws + WS_WRL);
    constexpr int WROW = 2128, WHALF = 21 * WROW;
    LAS float* LG = (LAS float*)(F.lds + 2 * WHALF + 128) + F.wave * 512;
    LAS int* CLS = (LAS int*)(F.lds + 2 * WHALF + 128 + 8 * 2048);
    for (int c = F.tid; c < 2 * 21 * 128; c += NTHR) { const int hl = c / (21 * 128), r = (c / 128) % 21, ch = c & 127;
        const u32x4 v = r < 20 ? *(const u32x4*)((hl ? wrl : wrh) + (size_t)r * 1024 + ch * 8) : (u32x4){0u, 0u, 0u, 0u};
        *(LAS u32x4*)(F.lds + hl * WHALF + r * WROW + ch * 16) = v; }
    __syncthreads();
    const int lane = F.lane, tl = lane & 15, kg = lane >> 4;
    const int row1 = tl < 4 ? 16 + tl : 20;
    const int tok0 = blockIdx.x * 128 + F.wave * 16;
    if (tok0 < M) {
        f32x4 acc0 = {0.f, 0.f, 0.f, 0.f}, acc1 = {0.f, 0.f, 0.f, 0.f}; float ss = 0.f;
        const bf16_t* hp = h + (size_t)(tok0 + tl) * D + 8 * kg;
#pragma unroll 4
        for (int ks = 0; ks < 32; ++ks) {
            const u32x4 hw = *(const u32x4*)(hp + 32 * ks); const f32x4 a0 = {bf_lo(hw.x), bf_hi(hw.x), bf_lo(hw.y), bf_hi(hw.y)}, a1 = {bf_lo(hw.z), bf_hi(hw.z), bf_lo(hw.w), bf_hi(hw.w)};
            const f32x4 g0 = *(const f32x4*)(gffn + 32 * ks + 8 * kg), g1 = *(const f32x4*)(gffn + 32 * ks + 8 * kg + 4);
            ss += (a0.x * a0.x + a0.y * a0.y) + (a0.z * a0.z + a0.w * a0.w) + (a1.x * a1.x + a1.y * a1.y) + (a1.z * a1.z + a1.w * a1.w);
            float y[8] = {a0.x * g0.x, a0.y * g0.y, a0.z * g0.z, a0.w * g0.w, a1.x * g1.x, a1.y * g1.y, a1.z * g1.z, a1.w * g1.w};
            unsigned hi[8], lo[8];
#pragma unroll
            for (int j = 0; j < 8; ++j) { hi[j] = f2bf(y[j]); lo[j] = f2bf(y[j] - __builtin_bit_cast(float, hi[j] << 16)); }
            u32x4 ah = {hi[0] | (hi[1] << 16), hi[2] | (hi[3] << 16), hi[4] | (hi[5] << 16), hi[6] | (hi[7] << 16)};
            u32x4 al = {lo[0] | (lo[1] << 16), lo[2] | (lo[3] << 16), lo[4] | (lo[5] << 16), lo[6] | (lo[7] << 16)};
            const bf16x8 Ah = __builtin_bit_cast(bf16x8, ah), Al = __builtin_bit_cast(bf16x8, al);
            const int bo = (32 * ks + 8 * kg) * 2;
            const bf16x8 Bh0 = *(LAS const bf16x8*)(F.lds + tl * WROW + bo), Bh1 = *(LAS const bf16x8*)(F.lds + row1 * WROW + bo), Bl0 = *(LAS const bf16x8*)(F.lds + WHALF + tl * WROW + bo), Bl1 = *(LAS const bf16x8*)(F.lds + WHALF + row1 * WROW + bo);
            acc0 = __builtin_amdgcn_mfma_f32_16x16x32_bf16(Ah, Bh0, acc0, 0, 0, 0); acc0 = __builtin_amdgcn_mfma_f32_16x16x32_bf16(Ah, Bl0, acc0, 0, 0, 0); acc0 = __builtin_amdgcn_mfma_f32_16x16x32_bf16(Al, Bh0, acc0, 0, 0, 0);
            acc1 = __builtin_amdgcn_mfma_f32_16x16x32_bf16(Ah, Bh1, acc1, 0, 0, 0); acc1 = __builtin_amdgcn_mfma_f32_16x16x32_bf16(Ah, Bl1, acc1, 0, 0, 0); acc1 = __builtin_amdgcn_mfma_f32_16x16x32_bf16(Al, Bh1, acc1, 0, 0, 0);
        }
        ss += __shfl_xor(ss, 16); ss += __shfl_xor(ss, 32);
        const float rstd = rsqrtf(ss * (1.f / D) + EPS);
#pragma unroll
        for (int r = 0; r < 4; ++r) { LG[(4 * kg + r) * 32 + tl] = acc0[r]; LG[(4 * kg + r) * 32 + 16 + tl] = acc1[r]; }
        LDS_WAIT(); asm volatile("" ::: "memory");
        if (lane < 16) {
            const float* brg = F.in[13]; const float* bre = F.in[15];
            float gl[4]; int gi = 0;
#pragma unroll
            for (int j = 0; j < 4; ++j) gl[j] = LG[lane * 32 + j] * rstd + brg[j];
#pragma unroll
            for (int j = 1; j < 4; ++j) if (gl[j] > gl[gi]) gi = j;
            float gden = 0.f;
#pragma unroll
            for (int j = 0; j < 4; ++j) gden += __expf(gl[j] - gl[gi]);
            const float gprob = 1.f / gden;
            float el[4];
#pragma unroll
            for (int j = 0; j < 4; ++j) el[j] = LG[lane * 32 + 4 + gi * 4 + j] * rstd + bre[gi * 4 + j];
            int i0 = 0;
#pragma unroll
            for (int j = 1; j < 4; ++j) if (el[j] > el[i0]) i0 = j;
            int i1 = (i0 == 0) ? 1 : 0;
#pragma unroll
            for (int j = 0; j < 4; ++j) if (j != i0 && j != i1 && el[j] > el[i1]) i1 = j;
            const float p0 = 1.f / (1.f + __expf(el[i1] - el[i0])), p1 = 1.f - p0;
            const int a = i0 < i1 ? i0 : i1, bb = i0 < i1 ? i1 : i0;
            const int pair = (a == 0 ? 0 : (a == 1 ? 3 : 5)) + (bb - a - 1);
            const int cls = gi * 6 + pair;
            const float ca = gprob * (i0 == a ? p0 : p1), cb = gprob * (i0 == a ? p1 : p0);
            f32x4 ri; ri.x = __builtin_bit_cast(float, cls); ri.y = rstd; ri.z = ca; ri.w = cb;
            *(f32x4*)(F.ws + WS_RINFO + (size_t)(tok0 + lane) * 16) = ri;
            CLS[F.wave * 16 + lane] = cls;
        }
    }
    __syncthreads();
    if (F.tid < NCLS) { int n = 0; if ((int)blockIdx.x * 128 < M) for (int i = 0; i < 128; ++i) n += (CLS[i] == F.tid); ((int*)(F.ws + WS_CTL) + CW_HIST)[blockIdx.x * NCLS + F.tid] = n; }
    __syncthreads();
}
__device__ __forceinline__ void p8_scatter(Frame& F) {
    moe_tables(F, true);
    LAS int* T = (LAS int*)(F.lds + MISC_OFF);
    LAS int* CLS = (LAS int*)(F.lds + 32768); LAS int* DST = (LAS int*)(F.lds + 32768 + 1024);
    int* rowtok = (int*)(F.ws + WS_ROWTOK); f32x4* rowc = (f32x4*)(F.ws + WS_ROWC);
    const int tok0 = blockIdx.x * 128;
    f32x4 ri = {0.f, 0.f, 0.f, 0.f};
    if (F.tid < 128) { ri = *(const f32x4*)(F.ws + WS_RINFO + (size_t)(tok0 + F.tid) * 16); CLS[F.tid] = __builtin_bit_cast(int, ri.x); }
    __syncthreads();
    if (F.tid < 128) { const int c = CLS[F.tid]; int rank = 0; for (int j = 0; j < F.tid; ++j) rank += (CLS[j] == c);
        const int dst = 256 * T[48 + c] + T[24 + c] + rank; DST[F.tid] = dst; rowtok[dst] = tok0 + F.tid; rowc[dst] = (f32x4){ri.z, ri.w, ri.y, 0.f}; }
    if ((int)blockIdx.x < NCLS) { const int c = blockIdx.x; const int lo = 256 * T[48 + c] + T[c], hi = 256 * T[48 + c + 1]; for (int r = lo + F.tid; r < hi; r += NTHR) { rowtok[r] = -1; rowc[r] = (f32x4){0.f, 0.f, 0.f, 0.f}; } }
}
__device__ __forceinline__ void p11_final(Frame& F) {
    const int gw = F.vcu * NWAVES + F.wave, NGW = F.G * NWAVES; const f32x4* gr = (const f32x4*)F.in[19] + F.lane; f32x4 gg[4];
#pragma unroll
    for (int j = 0; j < 4; ++j) gg[j] = gr[64 * j];
    for (int m0 = gw; m0 < M; m0 += 4 * NGW) {
        f32x4 v[4][4];
#pragma unroll
        for (int r = 0; r < 4; ++r) { const int m = m0 + r * NGW < M ? m0 + r * NGW : m0; const f32x4* xr = (const f32x4*)(F.out + (size_t)m * D) + F.lane;
#pragma unroll
            for (int j = 0; j < 4; ++j) v[r][j] = xr[64 * j]; }
#pragma unroll
        for (int r = 0; r < 4; ++r) { const int m = m0 + r * NGW; float s = 0.f;
#pragma unroll
            for (int j = 0; j < 4; ++j) s += (v[r][j].x * v[r][j].x + v[r][j].y * v[r][j].y) + (v[r][j].z * v[r][j].z + v[r][j].w * v[r][j].w);
            const float rstd = rsqrtf(wave_sum(s) * (1.f / D) + EPS);
            if (m < M) { f32x4* xr = (f32x4*)(F.out + (size_t)m * D) + F.lane;
#pragma unroll
                for (int j = 0; j < 4; ++j) xr[64 * j] = v[r][j] * rstd * gg[j]; } } }
}

constexpr int N_PHASES = 13;
__global__ void __launch_bounds__(NTHR, 2) __attribute__((target("no-packed-fp32-ops"))) mk_fwd(Args args) {
    extern __shared__ __attribute__((aligned(16))) unsigned char lds_raw[];
    Frame F;
    F.lds = (LAS unsigned char*)lds_raw; F.ws = args.ws; F.in = args.in; F.out = args.out;
    F.tid = threadIdx.x; F.lane = F.tid & 63; F.wave = __builtin_amdgcn_readfirstlane(F.tid >> 6);
    F.G = gridDim.x; { const int bx = blockIdx.x; F.vcu = (F.G % 8 == 0) ? (bx % 8) * (F.G / 8) + bx / 8 : bx; }
    volatile LAS unsigned* XBW = (volatile LAS unsigned*)(F.lds + LDS_BYTES - 16);
    if (F.tid < 4) XBW[F.tid] = 0u;
    __syncthreads();
    unsigned* ctl = (unsigned*)(F.ws + WS_CTL);
    const int lo = args.ph_lo, hi = args.ph_hi;
    XcdBarrier bar; bar.bar = ctl + CW_BAR; bar.x = 0; bar.st = XBW;
    if (hi - lo > 1) bar = xcd_barrier_post(ctl + CW_BAR, XBW);
#define IN(k) (lo <= (k) && (k) < hi)
#define SEAM(k) do { if (IN(k) && IN((k) + 1)) xcd_barrier(bar); } while (0)
    unsigned char* ws = F.ws;

    if (IN(0)) { p0_prologue(F); } SEAM(0);
    if (IN(1)) {
        SchedGrid S{(const char*)F.out, (const char*)(ws + WS_WIN), (size_t)256 * 2048, (size_t)256 * 2048, 10, (M / 256) * 10, F.G, F.vcu};
        EpiBf16 E{(bf16_t*)(ws + WS_PROJ), NP, (const float*)(ws + WS_RS1)};
        pg8::gemm_phase(F.lds, pg8::Geo{2048u, 2048u, 128u, 128u, 16, 1 << 30}, S, E);
        p1_gates(F);
    } SEAM(1);
    if (IN(2)) {
        vt_phase(F, (int)blockIdx.x * NWAVES + F.wave, F.G * NWAVES);
        if (hi - lo > 1) xcd_barrier(bar);
        if (F.G <= 64 || (int)blockIdx.x < 32) {
        { LAS float* cbl = (LAS float*)(F.lds + MISC_OFF + 4096);
          const int kv = F.tid >> 8, j = F.tid & 255; const float* pp = (const float*)(ws + WS_CB1) + (size_t)kv * 64 * 256 + j; float s = 0.f;
#pragma unroll 16
          for (int c = 0; c < 64; ++c) s += pp[c * 256];
          cbl[F.tid] = s; __syncthreads(); }
        SchedCmp1 S{(const bf16_t*)(ws + WS_PROJ), (const bf16_t*)(ws + WS_CW1), F.G, (int)blockIdx.x};
        EpiCmp1 E{(bf16_t*)(ws + WS_H1), (LAS const float*)(F.lds + MISC_OFF + 4096)};
        pg8::gemm_phase(F.lds, pg8::Geo{16u * NP * 2u, 4096u, NP * 2u, 128u, 32, 1 << 30}, S, E);
        asm volatile("s_waitcnt vmcnt(0)" ::: "memory"); __syncthreads();
        for (int L = (int)blockIdx.x; L < 32; L += F.G) { const int kv = L >> 4, kvh = (L >> 3) & 1, b = (L >> 1) & 3, nh = L & 1; const int orow = (kv * 2 + kvh) * 2048 + b * 512 + nh * 256;
            p3_cmp2(F, (orow >> 5) + F.wave, (orow >> 5) + 8, 8); }
        if (F.tid == 0) __hip_atomic_fetch_add((unsigned*)(ws + WS_CTL) + CW_CMPDONE, 1u, __ATOMIC_RELAXED, __HIP_MEMORY_SCOPE_AGENT);
        } else mixa_early_phase(F);
    } SEAM(2);
    if (IN(4)) { attn_phase(F); } SEAM(4);
#if MK_PROBE
    if (IN(5)) { if (MK_PROBE & 1) nv_mixer_a(F); if (MK_PROBE & 6) nv_nsa_a(F); } SEAM(5);
    if (IN(6)) { if (MK_PROBE & 6) nv_nsa_b(F); } SEAM(6);
#endif
    if (IN(7)) {
        SchedGrid S{(const char*)(ws + WS_XN), (const char*)(ws + WS_WOUT), (size_t)256 * 2048, (size_t)256 * 2048, 4, (M / 256) * 4, F.G, F.vcu};
        EpiWout E{(const bf16_t*)F.out, (bf16_t*)(ws + WS_HBF)};
        pg8::gemm_phase(F.lds, pg8::Geo{2048u, 2048u, 128u, 128u, 16, 1 << 30}, S, E);
    } SEAM(7);
    if (IN(8)) { p7_router(F); } SEAM(8);
    if (IN(9)) { p8_scatter(F); } SEAM(9);
    if (IN(10)) {
        moe_tables(F, false);
        LAS int* T = (LAS int*)(F.lds + MISC_OFF); unsigned* ready = (unsigned*)(ws + WS_CTL) + CW_READY;
        { SchedUp S{(const char*)(ws + WS_HBF), (const char*)(ws + WS_WGU), T, F.G, F.vcu, (const int*)(ws + WS_ROWTOK)};
          EpiUp E{(bf16_t*)(ws + WS_PROJ), (const f32x4*)(ws + WS_ROWC), ready};
          pg8::gemm_phase<true>(F.lds, pg8::Geo{2048u, 2048u, 128u, 128u, 16, 1 << 30}, S, E); }
        __syncthreads();
        { const int nup = __builtin_amdgcn_readfirstlane(T[48 + NCLS]) * 8; int c = (F.vcu - nup) % F.G; if (c < 0) c += F.G;
          SchedDown S{(const char*)(ws + WS_PROJ), (const char*)(ws + WS_WD), T, F.G, c, ready};
          EpiDownNorm E{F.out, (const bf16_t*)(ws + WS_HBF), (const int*)(ws + WS_ROWTOK), F.in[19], (float*)(ws + WS_XBUF), (unsigned*)(ws + WS_CTL) + CW_PANEL, F.lds + MISC_OFF + 8192};
          pg8::gemm_phase(F.lds, pg8::Geo{2048u, 1024u, 128u, 128u, 16, 8}, S, E); }
    }
#undef IN
#undef SEAM
}

extern "C" void kernel_launch(void* const* d_in, const int* in_sizes, int n_in, void* d_out, int out_size, void* d_ws, size_t ws_size, hipStream_t stream) {
    static int grid = 0;
    if (grid == 0) {
        if (n_in != 20 || in_sizes[0] != M * D || out_size != M * D || ws_size < WS_END) { fprintf(stderr, "kernel_launch: unexpected shapes (n_in %d, in0 %d, out %d, ws %zu); nothing launched\n", n_in, n_in > 0 ? in_sizes[0] : -1, out_size, ws_size); grid = -1; return; }
        int dev = 0, cus = 0, per_cu = 0;
        if (hipGetDevice(&dev) != hipSuccess || hipDeviceGetAttribute(&cus, hipDeviceAttributeMultiprocessorCount, dev) != hipSuccess) { grid = -1; return; }
        if (hipFuncSetAttribute((const void*)mk_fwd, hipFuncAttributeMaxDynamicSharedMemorySize, LDS_BYTES) != hipSuccess) { fprintf(stderr, "kernel_launch: hipFuncSetAttribute failed\n"); grid = -1; return; }
        if (hipOccupancyMaxActiveBlocksPerMultiprocessor(&per_cu, (const void*)mk_fwd, NTHR, LDS_BYTES) != hipSuccess || per_cu < 1) fprintf(stderr, "kernel_launch: occupancy query reports %d\n", per_cu);
        (void)hipGetLastError();
        grid = cus;
        if (grid > 256) grid = 256;
    }
    if (grid < 0) return;
    (void)hipMemsetAsync((char*)d_ws + WS_CTL, 0, CTL_ZERO_BYTES, stream);
    Args a{};
    for (int i = 0; i < 20; ++i) a.in[i] = (const float*)d_in[i];
    a.out = (float*)d_out; a.ws = (unsigned char*)d_ws;
#if MK_N_LAUNCHES == 1
    a.ph_lo = 0; a.ph_hi = N_PHASES;
    hipLaunchKernelGGL(mk_fwd, dim3(grid), dim3(NTHR), LDS_BYTES, stream, a);
#else
    for (int p = 0; p < N_PHASES; ++p) { a.ph_lo = p; a.ph_hi = p + 1; hipLaunchKernelGGL(mk_fwd, dim3(grid), dim3(NTHR), LDS_BYTES, stream, a); }
#endif
}
```

```cpp
#include <hip/hip_runtime.h>
#include <cstdio>
#include <cstdint>

#ifndef MK_N_LAUNCHES
#define MK_N_LAUNCHES 1
#endif

typedef unsigned short bf16_t;
typedef short bf16x8 __attribute__((ext_vector_type(8)));
typedef float f32x4 __attribute__((ext_vector_type(4)));
typedef float f32x2 __attribute__((ext_vector_type(2)));
typedef float f32x16 __attribute__((ext_vector_type(16)));
typedef unsigned u32x4 __attribute__((ext_vector_type(4)));
typedef unsigned u32x2 __attribute__((ext_vector_type(2)));
#define LAS __attribute__((address_space(3)))
#define GAS __attribute__((address_space(1)))

constexpr int BATCH = 4, SEQ = 8192, M = BATCH * SEQ, D = 1024, NIN = 2590, NP = 2816;
constexpr int C_QA = 0, C_KA = 384, C_VA = 768, C_QB = 1152, C_KCT = 1792, C_VCT = 1920, C_KS = 2048, C_VS = 2176, C_KW = 2304, C_VW = 2432, C_GT = 2560;
constexpr int NCMP = 511;
constexpr float EPS = 1e-6f;
constexpr int NCLS = 24, MAXTILES = 152;
constexpr int NWAVES = 8, NTHR = 512;

constexpr size_t MiB = 1u << 20;
constexpr size_t WS_CTL = 0, CTL_ZERO_BYTES = 1 * MiB;
constexpr size_t WS_WIN = 2 * MiB;
constexpr size_t WS_WOUT = 8 * MiB;
constexpr size_t WS_CW1 = 10 * MiB;
constexpr size_t WS_CW2 = 12 * MiB;
constexpr size_t WS_CB1 = 12 * MiB + 256 * 1024;
constexpr size_t WS_WRH = 12 * MiB + 512 * 1024;
constexpr size_t WS_WRL = 12 * MiB + 640 * 1024;
constexpr size_t WS_RINFO = 13 * MiB;
constexpr size_t WS_ROWTOK = 13 * MiB + 512 * 1024;
constexpr size_t WS_ROWC = 14 * MiB;
constexpr size_t WS_WGU = 16 * MiB;
constexpr size_t WS_WD = 48 * MiB;
constexpr size_t WS_XN = 64 * MiB;
constexpr size_t WS_PROJ = 144 * MiB;
constexpr size_t WS_H1 = 322 * MiB;
constexpr size_t WS_KCMP = 326 * MiB;
constexpr size_t WS_VCMP = 326 * MiB + 512 * 1024;
constexpr size_t WS_IMP = 328 * MiB;
constexpr size_t WS_SEL = 360 * MiB;
constexpr size_t WS_MD = 364 * MiB;
constexpr size_t WS_VTS = 368 * MiB;
constexpr size_t WS_VTW = 376 * MiB;
constexpr size_t WS_VTA1 = 384 * MiB;
constexpr size_t WS_VTA4 = 408 * MiB;
constexpr size_t WS_VTA16 = 432 * MiB;
constexpr size_t WS_VCT = 456 * MiB;
constexpr size_t WS_KA1 = 328 * MiB;
constexpr size_t WS_KA4 = 457 * MiB;
constexpr size_t WS_KA16 = 481 * MiB;
constexpr size_t WS_HBF = 224 * MiB;
constexpr size_t WS_GATES = 505 * MiB;
constexpr size_t WS_END = 507 * MiB;

constexpr int CW_BAR = 4096;
constexpr int CW_HIST = 65536;
constexpr int CW_READY = 196608;
constexpr int CW_CMPDONE = 213760;
constexpr int CW_MIXQ = 212992;
constexpr int CW_PANEL = 131072;
constexpr size_t WS_XBUF = 15 * MiB;

constexpr int RING_BYTES = 131072;
constexpr int MISC_OFF = RING_BYTES;
constexpr int LDS_BYTES = 147456;

__device__ __forceinline__ unsigned f2bf(float f) { unsigned u = __builtin_bit_cast(unsigned, f); return (u + 0x7fffu + ((u >> 16) & 1u)) >> 16; }
__device__ __forceinline__ unsigned pk2(float lo, float hi) { return f2bf(lo) | (f2bf(hi) << 16); }
__device__ __forceinline__ float bf_lo(unsigned w) { return __builtin_bit_cast(float, w << 16); }
__device__ __forceinline__ float bf_hi(unsigned w) { return __builtin_bit_cast(float, w & 0xffff0000u); }
__device__ __forceinline__ float bf2f(bf16_t h) { return __builtin_bit_cast(float, (unsigned)h << 16); }
#define LDS_WAIT() asm volatile("s_waitcnt lgkmcnt(0)" ::: "memory")
#define VM_WAIT() asm volatile("s_waitcnt vmcnt(0)" ::: "memory")

__device__ __forceinline__ int t5_bucket(int dist) {
    if (dist < 16) return dist < 0 ? 0 : dist;
    int b = 16;
    b += dist >= 22; b += dist >= 30; b += dist >= 40; b += dist >= 54; b += dist >= 73; b += dist >= 99; b += dist >= 134; b += dist >= 182;
    b += dist >= 246; b += dist >= 332; b += dist >= 450; b += dist >= 609; b += dist >= 825; b += dist >= 1117; b += dist >= 1513;
    return b;
}
__device__ __forceinline__ float gelu_tanh(float x) {
    const float u = 0.7978845608028654f * (x + 0.044715f * x * x * x);
    const float e = __expf(2.f * u);
    const float th = 1.f - 2.f / (e + 1.f);
    return 0.5f * x * (1.f + th);
}

namespace pg8 {
constexpr int BM = 256, BK = 64, HALF = 128, HTB = HALF * BK * 2;
__host__ __device__ __forceinline__ int lds_byte(int r, int c) { const int st = (r >> 4) * 2 + (c >> 5), rr = r & 15, cc = c & 31, ob = rr * 64 + cc * 2; return st * 1024 + (ob ^ (((ob >> 9) & 1) << 5)); }
__host__ __device__ __forceinline__ void stage_rc(int b, int& R, int& C) { const int st = b / 1024, sb = b % 1024, swz = sb ^ (((sb >> 9) & 1) << 5); R = (st >> 1) * 16 + swz / 64; C = (st & 1) * 32 + (swz % 64) / 2; }
__host__ __device__ __forceinline__ int perm32(int rho) { const int n = rho >> 4, i = rho & 15; return 8 * (i >> 2) + 4 * n + (i & 3); }

struct Unit { const char* a; const char* b; long bjump; int orow, ocol, aux; const int* rows; };
struct Geo { unsigned lda, ldb, kstepA, kstepB; int nt, tjump; };

template <bool GATHER = false, class Epi, class Sched>
__device__ __forceinline__ void gemm_phase(LAS unsigned char* lds, const Geo g, const Sched& S, const Epi& E) {
    const int tid = threadIdx.x, wid = __builtin_amdgcn_readfirstlane(tid >> 6), lane = tid & 63, wr = wid >> 2, wc = wid & 3, fr = lane & 15, fq = lane >> 4;
    const int nt = g.nt;
    unsigned voffA[2], voffB[2];
#pragma unroll
    for (int i = 0; i < 2; ++i) { int R, C; stage_rc(tid * 16 + i * 8192, R, C); const int Rb = (R & ~31) + perm32(R & 31);
        voffA[i] = (unsigned)R * g.lda + (unsigned)C * 2u; voffB[i] = (unsigned)Rb * g.ldb + (unsigned)C * 2u; }
    unsigned gA[2][2] = {{0u, 0u}, {0u, 0u}}, ngA[2][2] = {{0u, 0u}, {0u, 0u}};
    auto gather_of = [&](const Unit& u, unsigned (&o)[2][2]) {
#pragma unroll
        for (int i = 0; i < 2; ++i) { int R, C; stage_rc(tid * 16 + i * 8192, R, C);
#pragma unroll
            for (int h = 0; h < 2; ++h) { const int t = u.rows[h * HALF + R]; o[h][i] = (unsigned)(t < 0 ? 0 : t) * g.lda + (unsigned)C * 2u; } } };
    const size_t kA = g.kstepA, kB = g.kstepB;
    const size_t hA = (size_t)HALF * g.lda, hB = (size_t)HALF * g.ldb;
    const unsigned ldsw = (unsigned)wid * 1024u;
    const int aoff = lds_byte(wr * 64 + fr, fq * 8), boff = lds_byte(wc * 32 + fr, fq * 8);
#define PG8_SA(b, h) (((b) * 2 + (h)) * HTB)
#define PG8_SB(b, h) ((4 + (b) * 2 + (h)) * HTB)
#define PG8_STAGE(bufoff, gbase, voff) do { _Pragma("unroll") for (int _i = 0; _i < 2; ++_i) \
        __builtin_amdgcn_global_load_lds((const unsigned*)((const char*)(gbase) + (voff)[_i]), (LAS unsigned*)(lds + (bufoff) + ldsw + _i * 8192), 16, 0, 0); } while (0)
#define PG8_STAGE_A(bufoff, h, gbase, VO) do { if (GATHER) { _Pragma("unroll") for (int _i = 0; _i < 2; ++_i) \
        __builtin_amdgcn_global_load_lds((const unsigned*)((const char*)(gbase) + (VO)[h][_i]), (LAS unsigned*)(lds + (bufoff) + ldsw + _i * 8192), 16, 0, 0); } else PG8_STAGE(bufoff, (gbase) + (h) * hA, voffA); } while (0)
#define PG8_LDA(dst, b, h) do { _Pragma("unroll") for (int m = 0; m < 4; ++m) _Pragma("unroll") for (int k = 0; k < 2; ++k) dst[m][k] = *(const LAS bf16x8*)(lds + PG8_SA(b, h) + aoff + m * 2048 + k * 1024); } while (0)
#define PG8_LDB(dst, b, h) do { _Pragma("unroll") for (int n = 0; n < 2; ++n) _Pragma("unroll") for (int k = 0; k < 2; ++k) dst[n][k] = *(const LAS bf16x8*)(lds + PG8_SB(b, h) + boff + n * 2048 + k * 1024); } while (0)
#define PG8_MMA(ai, bj, At, Bt) do { __builtin_amdgcn_s_setprio(1); _Pragma("unroll") for (int m = 0; m < 4; ++m) _Pragma("unroll") for (int n = 0; n < 2; ++n) _Pragma("unroll") for (int k = 0; k < 2; ++k) \
        acc[ai][bj][m][n] = __builtin_amdgcn_mfma_f32_16x16x32_bf16(Bt[n][k], At[m][k], acc[ai][bj][m][n], 0, 0, 0); __builtin_amdgcn_s_setprio(0); } while (0)
#define PG8_WAIT_V(n) asm volatile("s_waitcnt vmcnt(" #n ")" ::: "memory")
#define PG8_WAIT_L(n) asm volatile("s_waitcnt lgkmcnt(" #n ")" ::: "memory")
#define PG8_BAR __builtin_amdgcn_s_barrier()
#define PG8_SCHED __builtin_amdgcn_sched_barrier(0)
#define PG8_BP(base, jump, t) ((base) + (size_t)(t) * kB + (((t) >= g.tjump) ? (jump) : 0l))
    Unit cur, nxt; int ui = 0;
    if (!S.next(0, cur)) return;
    f32x4 acc[2][2][4][2];
#pragma unroll
    for (int a = 0; a < 2; ++a)
#pragma unroll
        for (int b = 0; b < 2; ++b)
#pragma unroll
            for (int m = 0; m < 4; ++m)
#pragma unroll
                for (int n = 0; n < 2; ++n) acc[a][b][m][n] = (f32x4){0.f, 0.f, 0.f, 0.f};
    bf16x8 At[4][2], B0[2][2], B1[2][2];
    const char* cA = cur.a; const char* cB = cur.b; long cJ = cur.bjump;
    S.a_ready(cur);
    if (GATHER) gather_of(cur, gA);
    PG8_STAGE(PG8_SB(0, 0), cB, voffB); PG8_STAGE(PG8_SB(0, 1), cB + hB, voffB); PG8_STAGE_A(PG8_SA(0, 0), 0, cA, gA); PG8_STAGE_A(PG8_SA(0, 1), 1, cA, gA);
    if (wr == 1) PG8_BAR;
    PG8_WAIT_V(2); PG8_BAR;
    PG8_STAGE(PG8_SB(1, 0), cB + kB, voffB); PG8_STAGE_A(PG8_SA(1, 0), 0, cA + kA, gA); PG8_STAGE(PG8_SB(1, 1), cB + hB + kB, voffB);
    PG8_WAIT_V(6); PG8_BAR;
    for (;;) {
        const bool has_next = S.next(ui + 1, nxt);
        const char* nA = has_next ? nxt.a : cA; const char* nB = has_next ? nxt.b : cB;
        if (GATHER) { if (has_next) gather_of(nxt, ngA); else {
#pragma unroll
            for (int h = 0; h < 2; ++h) { ngA[h][0] = gA[h][0]; ngA[h][1] = gA[h][1]; } } }
        for (int t = 0; t < nt; t += 2) {
            const bool last = (t == nt - 2);
            const char* a1 = cA + (size_t)(t + 1) * kA;
            const char* a2 = last ? nA : cA + (size_t)(t + 2) * kA; const char* b2 = last ? nB : PG8_BP(cB, cJ, t + 2);
            const char* a3 = a2 + kA; const char* b3 = b2 + kB;
            unsigned g2[2][2];
#pragma unroll
            for (int h = 0; h < 2; ++h) { g2[h][0] = last ? ngA[h][0] : gA[h][0]; g2[h][1] = last ? ngA[h][1] : gA[h][1]; }
            if (last && has_next) S.a_ready(nxt);
            PG8_LDB(B0, 0, 0); PG8_LDB(B1, 0, 1); PG8_SCHED; PG8_LDA(At, 0, 0); PG8_STAGE_A(PG8_SA(1, 1), 1, a1, gA);
            PG8_WAIT_V(8); PG8_WAIT_L(0); PG8_BAR; PG8_MMA(0, 0, At, B0); PG8_MMA(0, 1, At, B1); PG8_BAR; PG8_SCHED;
            PG8_LDA(At, 0, 1); PG8_STAGE(PG8_SB(0, 0), b2, voffB); PG8_STAGE(PG8_SB(0, 1), b2 + hB, voffB); PG8_STAGE_A(PG8_SA(0, 0), 0, a2, g2);
            PG8_WAIT_V(8); PG8_WAIT_L(0); PG8_BAR; PG8_MMA(1, 0, At, B0); PG8_MMA(1, 1, At, B1); PG8_BAR; PG8_SCHED;
            PG8_LDB(B0, 1, 0); PG8_LDB(B1, 1, 1); PG8_SCHED; PG8_LDA(At, 1, 0); PG8_STAGE_A(PG8_SA(0, 1), 1, a2, g2);
            PG8_WAIT_V(8); PG8_WAIT_L(0); PG8_BAR; PG8_MMA(0, 0, At, B0); PG8_MMA(0, 1, At, B1); PG8_BAR; PG8_SCHED;
            PG8_LDA(At, 1, 1); PG8_STAGE(PG8_SB(1, 0), b3, voffB); PG8_STAGE(PG8_SB(1, 1), b3 + hB, voffB); PG8_STAGE_A(PG8_SA(1, 0), 0, a3, g2);
            PG8_WAIT_V(8); PG8_WAIT_L(0); PG8_BAR; PG8_MMA(1, 0, At, B0); PG8_MMA(1, 1, At, B1); PG8_BAR; PG8_SCHED;
        }
        if (wr == 0) PG8_BAR;
        E(acc, cur, wr, wc, fr, fq);
        if (!has_next) break;
#pragma unroll
        for (int a = 0; a < 2; ++a)
#pragma unroll
            for (int b = 0; b < 2; ++b)
#pragma unroll
                for (int m = 0; m < 4; ++m)
#pragma unroll
                    for (int n = 0; n < 2; ++n) acc[a][b][m][n] = (f32x4){0.f, 0.f, 0.f, 0.f};
        cur = nxt; cA = nA; cB = nB; cJ = nxt.bjump; ++ui;
        if (GATHER) {
#pragma unroll
            for (int h = 0; h < 2; ++h) { gA[h][0] = ngA[h][0]; gA[h][1] = ngA[h][1]; } }
        if (wr == 1) PG8_BAR;
    }
    PG8_WAIT_V(0);
    PG8_BAR;
#undef PG8_SA
#undef PG8_SB
#undef PG8_STAGE
#undef PG8_STAGE_A
#undef PG8_LDA
#undef PG8_LDB
#undef PG8_MMA
#undef PG8_WAIT_V
#undef PG8_WAIT_L
#undef PG8_BAR
#undef PG8_SCHED
#undef PG8_BP
}
}

#define XB_TMO      128
#define XB_XCNT(j)  (256  + 64 * (j))
#define XB_XSUB(j)  (1280 + 64 * (j))
#define XB_XGEN(j)  (2304 + 64 * (j))
#define XB_TOP      3328
#define XB_TOPGEN   3392
#define XCD_BAR_WORDS 3456
#define XB_SPIN_CAP (1u << 18)
__device__ __forceinline__ unsigned xb_ld(unsigned* p)              { return __hip_atomic_load(p, __ATOMIC_RELAXED, __HIP_MEMORY_SCOPE_AGENT); }
__device__ __forceinline__ unsigned xb_add(unsigned* p, unsigned v) { return __hip_atomic_fetch_add(p, v, __ATOMIC_RELAXED, __HIP_MEMORY_SCOPE_AGENT); }
__device__ __forceinline__ unsigned xb_xcc_id() { return (unsigned)__builtin_amdgcn_s_getreg((3 << 11) | 20) & 0xFu; }
#define XB_SPIN(cond, bar) do { unsigned _sp = 0; while (cond) { __builtin_amdgcn_s_sleep(1); \
    if ((++_sp & 255u) == 0u) { if (xb_ld(&(bar)[XB_TMO])) break; if (_sp > XB_SPIN_CAP) { atomicAdd(&(bar)[XB_TMO], 1u); break; } } } } while (0)
struct XcdBarrier { unsigned* bar; unsigned x; volatile LAS unsigned* st; };
__device__ __forceinline__ XcdBarrier xcd_barrier_post(unsigned* bar, volatile LAS unsigned* st) {
    XcdBarrier b; b.bar = bar; b.x = xb_xcc_id(); b.st = st;
    if (threadIdx.x == 0) (void)xb_add(&bar[XB_XCNT(b.x)], 1u);
    return b;
}
__device__ __forceinline__ void xcd_barrier_complete(unsigned* bar, unsigned x, unsigned& nloc, unsigned& nx) {
    const unsigned G = gridDim.x * gridDim.y * gridDim.z;
    unsigned sum, cnt, mine, sp = 0u;
    for (;;) {
        sum = 0u; cnt = 0u; mine = 0u;
#pragma unroll
        for (unsigned j = 0; j < 16; ++j) { const unsigned c = xb_ld(&bar[XB_XCNT(j)]); sum += c; cnt += (c > 0u) ? 1u : 0u; mine = (j == x) ? c : mine; }
        if (sum == G) break;
        __builtin_amdgcn_s_sleep(1);
        if ((++sp & 255u) == 0u) { if (xb_ld(&bar[XB_TMO])) break; if (sp > XB_SPIN_CAP) { atomicAdd(&bar[XB_TMO], 1u); break; } }
    }
    nloc = mine > 0u ? mine : 1u; nx = cnt > 0u ? cnt : 1u;
}
__device__ __forceinline__ void xcd_barrier(const XcdBarrier& b) {
    asm volatile("s_waitcnt vmcnt(0)" ::: "memory");
    __syncthreads();
    if (threadIdx.x == 0) {
        unsigned* bar = b.bar;
        __builtin_amdgcn_s_waitcnt(0);
        unsigned nloc = b.st[0], nx = b.st[1];
        if (nloc == 0u) { xcd_barrier_complete(bar, b.x, nloc, nx); b.st[0] = nloc; b.st[1] = nx; }
        const unsigned old = xb_add(&bar[XB_XSUB(b.x)], 1u);
        const unsigned gen = old / nloc;
        if (old + 1u == (gen + 1u) * nloc) {
            __builtin_amdgcn_fence(__ATOMIC_RELEASE, "agent");
            asm volatile("s_waitcnt vmcnt(0)" ::: "memory");
            const unsigned og = xb_add(&bar[XB_TOP], 1u);
            const unsigned tg = og / nx;
            if (og + 1u == (tg + 1u) * nx) xb_add(&bar[XB_TOPGEN], 1u);
            else XB_SPIN(xb_ld(&bar[XB_TOPGEN]) == tg, bar);
            __builtin_amdgcn_fence(__ATOMIC_ACQUIRE, "agent");
            xb_add(&bar[XB_XGEN(b.x)], 1u);
            asm volatile("s_waitcnt vmcnt(0)" ::: "memory");
        } else {
            XB_SPIN(xb_ld(&bar[XB_XGEN(b.x)]) == gen, bar);
            __builtin_amdgcn_fence(__ATOMIC_ACQUIRE, "agent");
            asm volatile("s_waitcnt vmcnt(0)" ::: "memory");
        }
    }
    __syncthreads();
}

struct Args { const float* in[20]; float* out; unsigned char* ws; int ph_lo, ph_hi; };

struct Frame {
    LAS unsigned char* lds;
    unsigned char* ws;
    const float* const* in;
    float* out;
    int tid, lane, wave, vcu, G;
};

__device__ __forceinline__ float wave_sum(float v) {
#pragma unroll
    for (int o = 1; o < 64; o <<= 1) v += __shfl_xor(v, o);
    return v;
}

struct TrDesc { const float* W; bf16_t* WT; int N, nvalid, dpitch, rowbase, blk, blkstride, kb, nb; const float* kg; };
__device__ __forceinline__ void tr_load(f32x4 (&v)[8], const TrDesc& d, int lane) {
    const int k0 = 64 * d.kb, n = 32 * d.nb + (lane & 7) * 4;
#pragma unroll
    for (int i = 0; i < 8; ++i) { const int kk = 8 * i + (lane >> 3); const float* p = d.W + (size_t)(k0 + kk) * d.N + n;
        if (n + 3 < d.nvalid) v[i] = *(const f32x4*)p; else { v[i].x = n < d.nvalid ? p[0] : 0.f; v[i].y = n + 1 < d.nvalid ? p[1] : 0.f; v[i].z = n + 2 < d.nvalid ? p[2] : 0.f; v[i].w = 0.f; } }
}
__device__ __forceinline__ void tr_finish(const f32x4 (&v)[8], const TrDesc& d, LAS float* scr, int lane) {
    const int k0 = 64 * d.kb, n0 = 32 * d.nb, c4 = (lane & 7) * 4;
#pragma unroll
    for (int i = 0; i < 8; ++i) { const int kk = 8 * i + (lane >> 3); LAS float* q = scr + kk * 33 + c4; const float gk = d.kg ? d.kg[k0 + kk] : 1.f; q[0] = v[i].x * gk; q[1] = v[i].y * gk; q[2] = v[i].z * gk; q[3] = v[i].w * gk; }
    LDS_WAIT(); asm volatile("" ::: "memory");
    const int c = lane & 7;
#pragma unroll
    for (int j = 0; j < 4; ++j) { const int nl = (lane >> 3) + 8 * j; const int n = n0 + nl; const LAS float* s = scr + (8 * c) * 33 + nl;
        const int drow = d.rowbase + (n / d.blk) * d.blkstride + (n % d.blk);
        u32x4 o; o.x = pk2(s[0 * 33], s[1 * 33]); o.y = pk2(s[2 * 33], s[3 * 33]); o.z = pk2(s[4 * 33], s[5 * 33]); o.w = pk2(s[6 * 33], s[7 * 33]);
        *(u32x4*)(d.WT + (size_t)drow * d.dpitch + k0 + 8 * c) = o; }
    LDS_WAIT(); asm volatile("" ::: "memory");
}

__device__ __forceinline__ void rms_row_to_bf16(const float* xrow, const float* gain, bf16_t* orow, int lane) {
    const f32x4* xr = (const f32x4*)xrow + lane; const f32x4* gr = (const f32x4*)gain + lane;
    f32x4 v[4]; float s = 0.f;
#pragma unroll
    for (int j = 0; j < 4; ++j) { v[j] = xr[64 * j]; s += (v[j].x * v[j].x + v[j].y * v[j].y) + (v[j].z * v[j].z + v[j].w * v[j].w); }
    const float rstd = rsqrtf(wave_sum(s) * (1.f / D) + EPS);
    unsigned long long* o8 = (unsigned long long*)orow + lane;
#pragma unroll
    for (int j = 0; j < 4; ++j) { const f32x4 g = gr[64 * j];
        o8[64 * j] = (unsigned long long)pk2(v[j].x * rstd * g.x, v[j].y * rstd * g.y) | ((unsigned long long)pk2(v[j].z * rstd * g.z, v[j].w * rstd * g.w) << 32); }
}

__device__ __forceinline__ void p0_prologue(Frame& F) {
    LAS float* scr = (LAS float*)(F.lds + F.wave * 16384);
    const int gw = F.vcu * NWAVES + F.wave, NGW = F.G * NWAVES;
    unsigned char* ws = F.ws;
    constexpr int I_WIN = 16 * 88, I_WOUT = 16 * 32, I_CW1 = 32 * 8, I_CW2 = 4 * 2, I_GU = 16 * 16, I_DN = 8 * 32;
    constexpr int NITEMS = I_WIN + I_WOUT + 2 * I_CW1 + 2 * I_CW2 + 32 * I_GU + 16 * I_DN;
    auto describe = [&](int it) -> TrDesc { int r = it < NITEMS ? it : NITEMS - 1;
        if (r < I_WIN) return TrDesc{F.in[3], (bf16_t*)(ws + WS_WIN), NIN, NIN, 1024, 0, 1 << 30, 0, r / 88, r % 88, nullptr}; r -= I_WIN;
        if (r < I_WOUT) return TrDesc{F.in[4], (bf16_t*)(ws + WS_WOUT), 1024, 1024, 1024, 0, 1 << 30, 0, r / 32, r % 32, nullptr}; r -= I_WOUT;
        if (r < 2 * I_CW1) { const int kv = r / I_CW1; r -= kv * I_CW1; return TrDesc{F.in[kv ? 9 : 7], (bf16_t*)(ws + WS_CW1) + (size_t)kv * 256 * 2048, 256, 256, 2048, 0, 1 << 30, 0, r / 8, r % 8, nullptr}; } r -= 2 * I_CW1;
        if (r < 2 * I_CW2) { const int kv = r / I_CW2; r -= kv * I_CW2; return TrDesc{F.in[kv ? 10 : 8], (bf16_t*)(ws + WS_CW2) + (size_t)kv * 64 * 256, 64, 64, 256, 0, 1 << 30, 0, r / 2, r % 2, nullptr}; } r -= 2 * I_CW2;
        if (r < 32 * I_GU) { const int eu = r / I_GU; r -= eu * I_GU; const int e = eu >> 1, up = eu & 1;
            return TrDesc{F.in[up ? 17 : 16] + (size_t)e * 1024 * 512, (bf16_t*)(ws + WS_WGU), 512, 512, 1024, e * 1024 + up * 128, 128, 256, r / 16, r % 16, F.in[11]}; } r -= 32 * I_GU;
        { const int e = r / I_DN; r -= e * I_DN;
            return TrDesc{F.in[18] + (size_t)e * 512 * 1024, (bf16_t*)(ws + WS_WD) + (size_t)e * 1024 * 512, 1024, 1024, 512, 0, 1 << 30, 0, r / 32, r % 32, nullptr}; } };
    { TrDesc d0 = describe(gw); f32x4 v0[8]; if (gw < NITEMS) tr_load(v0, d0, F.lane);
#pragma unroll 1
      for (int it = gw; it < NITEMS; it += NGW) { const TrDesc d1 = describe(it + NGW); f32x4 v1[8]; tr_load(v1, d1, F.lane);
          tr_finish(v0, d0, scr, F.lane); d0 = d1;
#pragma unroll
          for (int i = 0; i < 8; ++i) v0[i] = v1[i]; } }
    { bf16_t* wrh = (bf16_t*)(ws + WS_WRH); bf16_t* wrl = (bf16_t*)(ws + WS_WRL);
      for (int i = blockIdx.x * NTHR + F.tid; i < 32 * 1024; i += F.G * NTHR) { const int c = i >> 10, k = i & 1023;
          float w = 0.f; if (c < 4) w = F.in[12][k * 4 + c]; else if (c < 20) w = F.in[14][k * 16 + (c - 4)];
          const unsigned h = f2bf(w); const float hf = __builtin_bit_cast(float, h << 16); wrh[i] = (bf16_t)h; wrl[i] = (bf16_t)f2bf(w - hf); } }
    if ((int)blockIdx.x < 64) { const int kv = blockIdx.x >> 5, chunk = blockIdx.x & 31, j = F.tid & 255, half = F.tid >> 8; const float* pos = F.in[kv ? 6 : 5]; const float* w1 = F.in[kv ? 9 : 7];
        const int i0 = chunk * 64 + half * 32; float s = 0.f;
#pragma unroll
        for (int k = 0; k < 32; ++k) s += pos[i0 + k] * w1[(size_t)(i0 + k) * 256 + j];
        ((float*)(ws + WS_CB1))[(kv * 64 + chunk * 2 + half) * 256 + j] = s; }
    { const f32x4* gr = (const f32x4*)F.in[2] + F.lane; f32x4 gg[4];
#pragma unroll
      for (int j = 0; j < 4; ++j) gg[j] = gr[64 * j];
      for (int m0 = gw; m0 < M; m0 += 4 * NGW) {
          f32x4 v[4][4];
#pragma unroll
          for (int r = 0; r < 4; ++r) { const int m = m0 + r * NGW < M ? m0 + r * NGW : m0; const f32x4* xr = (const f32x4*)(F.in[0] + (size_t)m * D) + F.lane;
#pragma unroll
              for (int j = 0; j < 4; ++j) v[r][j] = __builtin_nontemporal_load(xr + 64 * j); }
#pragma unroll
          for (int r = 0; r < 4; ++r) { const int m = m0 + r * NGW; float s = 0.f;
#pragma unroll
              for (int j = 0; j < 4; ++j) s += (v[r][j].x * v[r][j].x + v[r][j].y * v[r][j].y) + (v[r][j].z * v[r][j].z + v[r][j].w * v[r][j].w);
              const float rstd = rsqrtf(wave_sum(s) * (1.f / D) + EPS);
              if (m < M) { unsigned long long* o8 = (unsigned long long*)((bf16_t*)(ws + WS_XN) + (size_t)m * D) + F.lane;
#pragma unroll
                  for (int j = 0; j < 4; ++j) o8[64 * j] = (unsigned long long)pk2(v[r][j].x * rstd * gg[j].x, v[r][j].y * rstd * gg[j].y) | ((unsigned long long)pk2(v[r][j].z * rstd * gg[j].z, v[r][j].w * rstd * gg[j].w) << 32); } } } }
}

struct SchedGrid {
    const char* A; const char* B; size_t a_tile, b_tile; int nN, nU, G, c;
    __device__ __forceinline__ void a_ready(const pg8::Unit&) const {}
    __device__ __forceinline__ bool next(int i, pg8::Unit& u) const { const int L = i * G + c; if (L >= nU) return false; const int pm = L / nN, pn = L - pm * nN;
        u.a = A + (size_t)pm * a_tile; u.b = B + (size_t)pn * b_tile; u.bjump = 0; u.orow = pm * 256; u.ocol = pn * 256; u.aux = 0; return true; }
};
struct EpiBf16 {
    bf16_t* O; int ldc;
    __device__ __forceinline__ void operator()(const f32x4 (&acc)[2][2][4][2], const pg8::Unit& u, int wr, int wc, int fr, int fq) const {
#pragma unroll
        for (int ai = 0; ai < 2; ++ai)
#pragma unroll
            for (int m = 0; m < 4; ++m) { bf16_t* rowp = O + (size_t)(u.orow + ai * 128 + wr * 64 + m * 16 + fr) * ldc + u.ocol + wc * 32 + 8 * fq;
#pragma unroll
                for (int bj = 0; bj < 2; ++bj) { const f32x4 v0 = acc[ai][bj][m][0], v1 = acc[ai][bj][m][1];
                    u32x4 w; w.x = pk2(v0[0], v0[1]); w.y = pk2(v0[2], v0[3]); w.z = pk2(v1[0], v1[1]); w.w = pk2(v1[2], v1[3]);
                    *(u32x4*)(rowp + bj * 128) = w; } }
    }
};
struct SchedCmp1 {
    const bf16_t* PROJ; const bf16_t* W1; int G, c;
    __device__ __forceinline__ void a_ready(const pg8::Unit&) const {}
    __device__ __forceinline__ bool next(int i, pg8::Unit& u) const { const int L = i * G + c; if (L >= 32) return false;
        const int kv = L >> 4, kvh = (L >> 3) & 1, b = (L >> 1) & 3, nh = L & 1;
        u.a = (const char*)(PROJ + ((size_t)(b * SEQ + 16 * 256 * nh)) * NP + (kv ? C_VCT : C_KCT) + kvh * 64);
        u.b = (const char*)(W1 + (size_t)kv * 256 * 2048); u.bjump = 0;
        u.orow = (kv * 2 + kvh) * 2048 + b * 512 + nh * 256; u.ocol = 0; u.aux = kv; return true; }
};
struct EpiCmp1 {
    bf16_t* O; LAS const float* cb1;
    __device__ __forceinline__ void operator()(const f32x4 (&acc)[2][2][4][2], const pg8::Unit& u, int wr, int wc, int fr, int fq) const {
        f32x4 bv[2][2];
#pragma unroll
        for (int bj = 0; bj < 2; ++bj)
#pragma unroll
            for (int n = 0; n < 2; ++n) bv[bj][n] = *(LAS const f32x4*)(cb1 + u.aux * 256 + bj * 128 + wc * 32 + 8 * fq + 4 * n);
#pragma unroll
        for (int ai = 0; ai < 2; ++ai)
#pragma unroll
            for (int m = 0; m < 4; ++m) { bf16_t* rowp = O + (size_t)(u.orow + ai * 128 + wr * 64 + m * 16 + fr) * 256 + wc * 32 + 8 * fq;
#pragma unroll
                for (int bj = 0; bj < 2; ++bj) { f32x4 v0 = acc[ai][bj][m][0] + bv[bj][0], v1 = acc[ai][bj][m][1] + bv[bj][1];
#pragma unroll
                    for (int j = 0; j < 4; ++j) { v0[j] = gelu_tanh(v0[j]); v1[j] = gelu_tanh(v1[j]); }
                    u32x4 w; w.x = pk2(v0[0], v0[1]); w.y = pk2(v0[2], v0[3]); w.z = pk2(v1[0], v1[1]); w.w = pk2(v1[2], v1[3]);
                    *(u32x4*)(rowp + bj * 128) = w; } }
    }
};
struct EpiWout {
    const float* X; bf16_t* O;
    __device__ __forceinline__ void operator()(const f32x4 (&acc)[2][2][4][2], const pg8::Unit& u, int wr, int wc, int fr, int fq) const {
#pragma unroll
        for (int ai = 0; ai < 2; ++ai)
#pragma unroll
            for (int m = 0; m < 4; ++m) { const size_t off = (size_t)(u.orow + ai * 128 + wr * 64 + m * 16 + fr) * D + u.ocol + wc * 32 + 8 * fq;
#pragma unroll
                for (int bj = 0; bj < 2; ++bj) { const f32x4 v0 = __builtin_nontemporal_load((const f32x4*)(X + off + bj * 128)) + acc[ai][bj][m][0], v1 = __builtin_nontemporal_load((const f32x4*)(X + off + bj * 128 + 4)) + acc[ai][bj][m][1];
                    u32x4 w; w.x = pk2(v0[0], v0[1]); w.y = pk2(v0[2], v0[3]); w.z = pk2(v1[0], v1[1]); w.w = pk2(v1[2], v1[3]);
                    *(u32x4*)(O + off + bj * 128) = w; } }
    }
};

__device__ __forceinline__ void moe_tables(Frame& F, bool want_pre) {
    LAS int* T = (LAS int*)(F.lds + MISC_OFF);
    const int* hist = (const int*)(F.ws + WS_CTL) + CW_HIST;
    const int tid = F.tid;
    int tot = 0, pre = 0;
    if (tid < 384) { const int c = tid >> 4, part = tid & 15;
        for (int w = part * 16; w < part * 16 + 16; ++w) { const int v = (w < F.G) ? hist[w * NCLS + c] : 0; tot += v; if (want_pre && w < (int)blockIdx.x) pre += v; } }
#pragma unroll
    for (int o = 1; o < 16; o <<= 1) { tot += __shfl_xor(tot, o); pre += __shfl_xor(pre, o); }
    if (tid < 384 && (tid & 15) == 0) { T[tid >> 4] = tot; T[24 + (tid >> 4)] = pre; }
    __syncthreads();
    if (tid == 0) { int p = 0; for (int c = 0; c < NCLS; ++c) { T[48 + c] = p; const int nt = (T[c] + 255) >> 8; for (int k = 0; k < nt; ++k) T[80 + p + k] = c; p += nt; } T[48 + NCLS] = p; }
    __syncthreads();
}
__device__ __forceinline__ void cls_experts(int cls, int& ea, int& eb) { const int gi = cls / 6, pr = cls - gi * 6; const int a = pr < 3 ? 0 : (pr < 5 ? 1 : 2); const int b = pr < 3 ? pr + 1 : (pr < 5 ? pr - 1 : 3); ea = gi * 4 + a; eb = gi * 4 + b; }

struct SchedUp {
    const char* HS; const char* WGU; LAS int* T; int G, c; const int* rowtok;
    __device__ __forceinline__ void a_ready(const pg8::Unit&) const {}
    __device__ __forceinline__ bool next(int i, pg8::Unit& u) const { const int L = i * G + c; const int TT = __builtin_amdgcn_readfirstlane(T[48 + NCLS]); const int rt = L >> 3, pn = L & 7; if (rt >= TT) return false;
        const int cls = __builtin_amdgcn_readfirstlane(T[80 + rt]); int ea, eb; cls_experts(cls, ea, eb); const int e = pn < 4 ? ea : eb;
        u.a = HS; u.rows = rowtok + rt * 256; u.b = WGU + (size_t)(e * 4 + (pn & 3)) * 256 * 2048; u.bjump = 0; u.orow = rt * 256; u.ocol = (pn >> 2) * 512 + (pn & 3) * 128; u.aux = pn >> 2; return true; }
};
struct EpiUp {
    bf16_t* HE; const f32x4* rowc; unsigned* ready;
    __device__ __forceinline__ void operator()(const f32x4 (&acc)[2][2][4][2], const pg8::Unit& u, int wr, int wc, int fr, int fq) const {
        const __amdgpu_buffer_rsrc_t rs = __builtin_amdgcn_make_buffer_rsrc(HE, 0, MAXTILES * 256 * 2048, 0x00020000);
#pragma unroll
        for (int ai = 0; ai < 2; ++ai)
#pragma unroll
            for (int m = 0; m < 4; ++m) { const int row = u.orow + ai * 128 + wr * 64 + m * 16 + fr; const f32x4 rc = rowc[row]; const float cw = (u.aux ? rc.y : rc.x) * rc.z, rsd = rc.z;
                float o[8];
#pragma unroll
                for (int n = 0; n < 2; ++n)
#pragma unroll
                    for (int j = 0; j < 4; ++j) { const float gt = acc[ai][0][m][n][j] * rsd, up = acc[ai][1][m][n][j]; o[n * 4 + j] = gt / (1.f + __expf(-gt)) * up * cw; }
                u32x4 w; w.x = pk2(o[0], o[1]); w.y = pk2(o[2], o[3]); w.z = pk2(o[4], o[5]); w.w = pk2(o[6], o[7]);
                __builtin_amdgcn_raw_buffer_store_b128(w, rs, (unsigned)((row * 1024 + u.ocol + wc * 32 + 8 * fq) * 2), 0, 16); }
        asm volatile("s_waitcnt vmcnt(0)" ::: "memory");
        if (fr + fq == 0) __hip_atomic_fetch_add(ready + 64 * (u.orow >> 8), 1u, __ATOMIC_RELAXED, __HIP_MEMORY_SCOPE_AGENT);
    }
};
struct SchedDown {
    const char* HE; const char* WD; LAS int* T; int G, c; const unsigned* ready;
    __device__ __forceinline__ bool next(int i, pg8::Unit& u) const { const int L = i * G + c; const int TT = __builtin_amdgcn_readfirstlane(T[48 + NCLS]); const int rt = L >> 2, pn = L & 3; if (rt >= TT) return false;
        const int cls = __builtin_amdgcn_readfirstlane(T[80 + rt]); int ea, eb; cls_experts(cls, ea, eb);
        u.a = HE + (size_t)rt * 256 * 2048; u.b = WD + (size_t)ea * 1024 * 1024 + (size_t)pn * 256 * 1024; u.bjump = (long)(eb - ea) * 1024 * 1024 - 8 * 128; u.orow = rt * 256; u.ocol = pn * 256; u.aux = 0; return true; }
    __device__ __forceinline__ void a_ready(const pg8::Unit& u) const {
        if (threadIdx.x < 64) { const unsigned* w = ready + 64 * (u.orow >> 8); unsigned sp = 0;
            while ((unsigned)__builtin_amdgcn_readfirstlane(__hip_atomic_load(w, __ATOMIC_RELAXED, __HIP_MEMORY_SCOPE_AGENT)) < 64u) { if (++sp > (1u << 20)) break; __builtin_amdgcn_s_sleep(2); }
            __builtin_amdgcn_fence(__ATOMIC_ACQUIRE, "agent");
            asm volatile("s_waitcnt vmcnt(0)" ::: "memory"); }
        asm volatile("" ::: "memory"); __builtin_amdgcn_s_barrier(); asm volatile("" ::: "memory");
    }
};
struct EpiDown {
    float* O; const int* rowtok;
    __device__ __forceinline__ void operator()(const f32x4 (&acc)[2][2][4][2], const pg8::Unit& u, int wr, int wc, int fr, int fq) const {
#pragma unroll
        for (int ai = 0; ai < 2; ++ai)
#pragma unroll
            for (int m = 0; m < 4; ++m) { const int tok = rowtok[u.orow + ai * 128 + wr * 64 + m * 16 + fr];
                if (tok >= 0) { float* p = O + (size_t)tok * D + u.ocol + wc * 32 + 8 * fq;
#pragma unroll
                    for (int bj = 0; bj < 2; ++bj)
#pragma unroll
                        for (int n = 0; n < 2; ++n) { f32x4* q = (f32x4*)(p + bj * 128 + 4 * n); *q = *q + acc[ai][bj][m][n]; } } }
    }
};

struct EpiDownNorm {
    float* O; const bf16_t* H; const int* rowtok; const float* gfin; float* xbuf; unsigned* cnt; LAS unsigned char* sc;
    __device__ __forceinline__ void operator()(f32x4 (&acc)[2][2][4][2], const pg8::Unit& u, int wr, int wc, int fr, int fq) const {
        LAS float* P = (LAS float*)sc; LAS float* S = (LAS float*)(sc + 4096); LAS unsigned* flag = (LAS unsigned*)(sc + 5120);
        const int wid = wr * 4 + wc, lane = fq * 16 + fr, rt = u.orow >> 8, pn = u.ocol >> 8;
        int tokv[2][4];
#pragma unroll
        for (int ai = 0; ai < 2; ++ai)
#pragma unroll
            for (int m = 0; m < 4; ++m) { const int rl = ai * 128 + wr * 64 + m * 16 + fr; const int tok = rowtok[u.orow + rl]; tokv[ai][m] = tok; float s = 0.f;
                if (tok >= 0) { const bf16_t* p = H + (size_t)tok * D + u.ocol + wc * 32 + 8 * fq;
#pragma unroll
                    for (int bj = 0; bj < 2; ++bj) { const u32x4 hw = *(const u32x4*)(p + bj * 128);
                        const f32x4 v0 = (f32x4){bf_lo(hw.x), bf_hi(hw.x), bf_lo(hw.y), bf_hi(hw.y)} + acc[ai][bj][m][0], v1 = (f32x4){bf_lo(hw.z), bf_hi(hw.z), bf_lo(hw.w), bf_hi(hw.w)} + acc[ai][bj][m][1];
                        acc[ai][bj][m][0] = v0; acc[ai][bj][m][1] = v1; s += (v0[0] * v0[0] + v0[1] * v0[1]) + (v0[2] * v0[2] + v0[3] * v0[3]) + (v1[0] * v1[0] + v1[1] * v1[1]) + (v1[2] * v1[2] + v1[3] * v1[3]); } }
                s += __shfl_xor(s, 16); s += __shfl_xor(s, 32);
                if (fq == 0) P[rl * 4 + wc] = s; }
        asm volatile("s_waitcnt lgkmcnt(0)" ::: "memory"); __builtin_amdgcn_s_barrier(); asm volatile("" ::: "memory");
        const int row = wid * 32 + (lane & 31);
        if (lane < 32) { const float t = (P[row * 4 + 0] + P[row * 4 + 1]) + (P[row * 4 + 2] + P[row * 4 + 3]);
            __hip_atomic_store(xbuf + ((size_t)(rt * 256 + row) * 4 + pn), t, __ATOMIC_RELAXED, __HIP_MEMORY_SCOPE_AGENT); }
        asm volatile("s_waitcnt vmcnt(0)" ::: "memory");
        if (lane == 0) __hip_atomic_fetch_add(cnt + 64 * rt, 1u, __ATOMIC_RELAXED, __HIP_MEMORY_SCOPE_AGENT);
        if (wid == 0) { unsigned sp = 0; bool dead = false;
            for (;;) { if ((unsigned)__builtin_amdgcn_readfirstlane(__hip_atomic_load(cnt + 64 * rt, __ATOMIC_RELAXED, __HIP_MEMORY_SCOPE_AGENT)) >= 32u) break;
                if (++sp > (1u << 20)) { dead = true; break; } __builtin_amdgcn_s_sleep(2); }
            __builtin_amdgcn_fence(__ATOMIC_ACQUIRE, "agent");
            if (lane == 0) flag[0] = dead ? 1u : 0u; }
        asm volatile("s_waitcnt vmcnt(0) lgkmcnt(0)" ::: "memory"); __builtin_amdgcn_s_barrier(); asm volatile("" ::: "memory");
        if (lane < 32) { const float* sl = xbuf + (size_t)(rt * 256 + row) * 4; float t = 0.f;
#pragma unroll
            for (int k = 0; k < 4; ++k) t += __hip_atomic_load(sl + k, __ATOMIC_RELAXED, __HIP_MEMORY_SCOPE_AGENT);
            S[row] = rsqrtf(t * (1.f / D) + EPS); }
        asm volatile("s_waitcnt vmcnt(0) lgkmcnt(0)" ::: "memory"); __builtin_amdgcn_s_barrier(); asm volatile("" ::: "memory");
        f32x4 gv[2][2];
#pragma unroll
        for (int bj = 0; bj < 2; ++bj)
#pragma unroll
            for (int n = 0; n < 2; ++n) gv[bj][n] = *(const f32x4*)(gfin + u.ocol + wc * 32 + 8 * fq + bj * 128 + 4 * n);
#pragma unroll
        for (int ai = 0; ai < 2; ++ai)
#pragma unroll
            for (int m = 0; m < 4; ++m) { const int tok = tokv[ai][m]; if (tok >= 0) { const float rs = S[ai * 128 + wr * 64 + m * 16 + fr]; float* p = O + (size_t)tok * D + u.ocol + wc * 32 + 8 * fq;
#pragma unroll
                for (int bj = 0; bj < 2; ++bj)
#pragma unroll
                    for (int n = 0; n < 2; ++n) __builtin_nontemporal_store(acc[ai][bj][m][n] * rs * gv[bj][n], (f32x4*)(p + bj * 128 + 4 * n)); } }
        asm volatile("s_waitcnt lgkmcnt(0)" ::: "memory"); __builtin_amdgcn_s_barrier(); asm volatile("" ::: "memory");
    }
};
__device__ __forceinline__ void p1_gates(Frame& F) {
    const bf16_t* XN = (const bf16_t*)(F.ws + WS_XN); const bf16_t* WG = (const bf16_t*)(F.ws + WS_WIN) + (size_t)C_GT * 1024; bf16_t* GT = (bf16_t*)(F.ws + WS_GATES);
    const int gw = F.vcu * NWAVES + F.wave, NGW = F.G * NWAVES, tl = F.lane & 15, kg = F.lane >> 4;
    for (int it = gw; it < M / 16; it += NGW) { const int row0 = it * 16; f32x4 c0 = {0.f, 0.f, 0.f, 0.f}, c1 = c0;
        const bf16_t* ap = XN + (size_t)(row0 + tl) * 1024 + kg * 8; const bf16_t* bp = WG + (size_t)tl * 1024 + kg * 8;
#pragma unroll 8
        for (int ks = 0; ks < 32; ++ks) { const bf16x8 a = *(const bf16x8*)(ap + ks * 32);
            c0 = __builtin_amdgcn_mfma_f32_16x16x32_bf16(a, *(const bf16x8*)(bp + ks * 32), c0, 0, 0, 0); c1 = __builtin_amdgcn_mfma_f32_16x16x32_bf16(a, *(const bf16x8*)(bp + 16 * 1024 + ks * 32), c1, 0, 0, 0); }
#pragma unroll
        for (int r = 0; r < 4; ++r) { GT[(size_t)(row0 + 4 * kg + r) * 32 + tl] = (bf16_t)f2bf(c0[r]); GT[(size_t)(row0 + 4 * kg + r) * 32 + 16 + tl] = (bf16_t)f2bf(c1[r]); } }
}
__device__ __forceinline__ void p3_cmp2(Frame& F, int it0, int it1, int step) {
    const bf16_t* H1 = (const bf16_t*)(F.ws + WS_H1); const bf16_t* W2 = (const bf16_t*)(F.ws + WS_CW2); bf16_t* KC = (bf16_t*)(F.ws + WS_KCMP);
    const int r32 = F.lane & 31, hi = F.lane >> 5;
    for (int it = it0; it < it1; it += step) { const int row0 = it * 32; const int combo = row0 >> 11, kv = combo >> 1, kvh = combo & 1, b = (row0 >> 9) & 3, n0 = row0 & 511;
        f32x16 c0 = {}, c1 = {};
        const bf16_t* ap = H1 + (size_t)(row0 + r32) * 256 + hi * 8; const bf16_t* bp = W2 + (size_t)kv * 64 * 256 + (size_t)r32 * 256 + hi * 8;
#pragma unroll 4
        for (int ks = 0; ks < 16; ++ks) { const bf16x8 a = *(const bf16x8*)(ap + ks * 16); const bf16x8 b0 = *(const bf16x8*)(bp + ks * 16), b1 = *(const bf16x8*)(bp + 32 * 256 + ks * 16);
            c0 = __builtin_amdgcn_mfma_f32_32x32x16_bf16(a, b0, c0, 0, 0, 0); c1 = __builtin_amdgcn_mfma_f32_32x32x16_bf16(a, b1, c1, 0, 0, 0); }
        bf16_t* op = KC + (size_t)kv * (4 * 2 * 512 * 64) + ((size_t)(b * 2 + kvh) * 512 + n0) * 64;
#pragma unroll
        for (int r = 0; r < 16; ++r) { const int row = (r & 3) + 8 * (r >> 2) + 4 * hi; if (n0 + row == 511) { c0[r] = 0.f; c1[r] = 0.f; }
            op[row * 64 + r32] = (bf16_t)f2bf(c0[r]); op[row * 64 + 32 + r32] = (bf16_t)f2bf(c1[r]); }
        if (kv) { bf16_t* vt = (bf16_t*)(F.ws + WS_VCT) + ((size_t)(b * 2 + kvh) * 64 + r32) * 512 + n0 + 4 * hi;
#pragma unroll
            for (int u = 0; u < 4; ++u) { *(u32x2*)(vt + 8 * u) = (u32x2){pk2(c0[4 * u], c0[4 * u + 1]), pk2(c0[4 * u + 2], c0[4 * u + 3])};
                *(u32x2*)(vt + (size_t)32 * 512 + 8 * u) = (u32x2){pk2(c1[4 * u], c1[4 * u + 1]), pk2(c1[4 * u + 2], c1[4 * u + 3])}; } } }
}

__device__ __forceinline__ void load_q64(float (&q)[64], const bf16_t* p) {
#pragma unroll
    for (int c = 0; c < 8; ++c) { const u32x4 v = *(const u32x4*)(p + 8 * c); q[8 * c] = bf_lo(v.x); q[8 * c + 1] = bf_hi(v.x); q[8 * c + 2] = bf_lo(v.y); q[8 * c + 3] = bf_hi(v.y); q[8 * c + 4] = bf_lo(v.z); q[8 * c + 5] = bf_hi(v.z); q[8 * c + 6] = bf_lo(v.w); q[8 * c + 7] = bf_hi(v.w); }
}
__device__ __forceinline__ float dot64(const float (&q)[64], const bf16_t* p) {
    float s0 = 0.f, s1 = 0.f;
#pragma unroll
    for (int c = 0; c < 8; ++c) { const u32x4 v = *(const u32x4*)(p + 8 * c);
        s0 += q[8 * c] * bf_lo(v.x) + q[8 * c + 2] * bf_lo(v.y) + q[8 * c + 4] * bf_lo(v.z) + q[8 * c + 6] * bf_lo(v.w);
        s1 += q[8 * c + 1] * bf_hi(v.x) + q[8 * c + 3] * bf_hi(v.y) + q[8 * c + 5] * bf_hi(v.z) + q[8 * c + 7] * bf_hi(v.w); }
    return s0 + s1;
}
__device__ __forceinline__ void axpy64(float (&o)[64], float p, const bf16_t* vp) {
#pragma unroll
    for (int c = 0; c < 8; ++c) { const u32x4 v = *(const u32x4*)(vp + 8 * c);
        o[8 * c] += p * bf_lo(v.x); o[8 * c + 1] += p * bf_hi(v.x); o[8 * c + 2] += p * bf_lo(v.y); o[8 * c + 3] += p * bf_hi(v.y);
        o[8 * c + 4] += p * bf_lo(v.z); o[8 * c + 5] += p * bf_hi(v.z); o[8 * c + 6] += p * bf_lo(v.w); o[8 * c + 7] += p * bf_hi(v.w); }
}
#ifndef MK_PROBE
#define MK_PROBE 0
#endif
#define MK_PBR 2
constexpr size_t WS_AUX = 460 * MiB;
constexpr float PROBE_K = 64.f;
__device__ __forceinline__ void store64(bf16_t* p, const float (&oi)[64], float sc) {
    float o[64];
#pragma unroll
    for (int d = 0; d < 64; ++d) o[d] = oi[d];
#if (MK_PROBE & 3)
    { float f[64]; load_q64(f, p);
#pragma unroll
      for (int d = 0; d < 64; ++d) { const float nv = o[d] * sc; o[d] = (nv + PROBE_K * (f[d] - nv)) / sc; } }
#endif
#pragma unroll
    for (int c = 0; c < 8; ++c) { u32x4 w; w.x = pk2(o[8 * c] * sc, o[8 * c + 1] * sc); w.y = pk2(o[8 * c + 2] * sc, o[8 * c + 3] * sc); w.z = pk2(o[8 * c + 4] * sc, o[8 * c + 5] * sc); w.w = pk2(o[8 * c + 6] * sc, o[8 * c + 7] * sc); *(u32x4*)(p + 8 * c) = w; }
}

__device__ __forceinline__ void nv_mixer_a(Frame& F) {
    const bf16_t* PROJ = (const bf16_t*)(F.ws + WS_PROJ); bf16_t* OMIX = (bf16_t*)(F.ws + WS_XN); const float* relb = F.in[1];
    for (int idx = blockIdx.x * NTHR + F.tid; idx < 6 * M; idx += F.G * NTHR) {
        const int h = idx / M, row = idx - h * M, b = row >> 13, t = row & (SEQ - 1);
        float q[64], o[64];
        load_q64(q, PROJ + (size_t)row * NP + C_QA + h * 64);
#pragma unroll
        for (int d = 0; d < 64; ++d) o[d] = 0.f;
        float m = -INFINITY, l = 0.f;
        for (int p = 0; p < 3; ++p) { const int dil = p == 0 ? 1 : (p == 1 ? 4 : 16);
            for (int j = 0; j <= 128; ++j) { const int kt = t - dil * j; if (kt < 0) break;
                const bf16_t* kr = PROJ + (size_t)(b * SEQ + kt) * NP;
                const float s = dot64(q, kr + C_KA + h * 64) * 0.125f + relb[t5_bucket(dil * j) * 16 + h];
                if (s > m) { const float c = __expf(m - s); l *= c;
#pragma unroll
                    for (int d = 0; d < 64; ++d) o[d] *= c;
                    m = s; }
                const float pe = __expf(s - m); l += pe; axpy64(o, pe, kr + C_VA + h * 64); } }
        store64(OMIX + (size_t)row * D + h * 64, o, 1.f / l);
    }
}
__device__ __forceinline__ void nv_nsa_a(Frame& F) {
    const bf16_t* PROJ = (const bf16_t*)(F.ws + WS_PROJ); const bf16_t* KCMP = (const bf16_t*)(F.ws + WS_KCMP); const float* relb = F.in[1];
    float* IMP = (float*)(F.ws + WS_IMP); int* SEL = (int*)(F.ws + WS_SEL); f32x2* MD = (f32x2*)(F.ws + WS_MD);
    for (int idx = blockIdx.x * NTHR + F.tid; idx < 2 * M; idx += F.G * NTHR) {
        const int kvh = idx / M, row = idx - kvh * M, b = row >> 13, t = row & (SEQ - 1);
        int nv = t >= 31 ? ((t - 31) >> 4) + 1 : 0; if (nv > NCMP) nv = NCMP;
        const bf16_t* Kc = KCMP + (size_t)(b * 2 + kvh) * 512 * 64;
        float* imp = IMP + ((size_t)row * 2 + kvh) * 128;
        for (int s = 0; s < 128; s += 4) *(f32x4*)(imp + s) = (f32x4){0.f, 0.f, 0.f, 0.f};
        for (int g = 0; g < 5; ++g) { const int hb = kvh * 5 + g;
            float q[64]; load_q64(q, PROJ + (size_t)row * NP + C_QB + hb * 64);
            float m = -INFINITY;
            for (int n = 0; n < nv; ++n) { const float s = dot64(q, Kc + n * 64) * 0.125f + relb[t5_bucket(t - 16 * n - 31) * 16 + 6 + hb]; m = fmaxf(m, s); }
            float den = 0.f;
            for (int n = 0; n < nv; ++n) { const float s = dot64(q, Kc + n * 64) * 0.125f + relb[t5_bucket(t - 16 * n - 31) * 16 + 6 + hb]; den += __expf(s - m); }
            MD[(size_t)row * 10 + hb] = (f32x2){nv > 0 ? m : 0.f, den};
            const float inv = nv > 0 ? 1.f / den : 0.f;
            float acc = 0.f;
            for (int n = 0; n < nv; ++n) { const float s = dot64(q, Kc + n * 64) * 0.125f + relb[t5_bucket(t - 16 * n - 31) * 16 + 6 + hb]; const float p = __expf(s - m) * inv;
                if ((n & 3) < 3) acc += p; else { acc += 0.5f * p; imp[n >> 2] += acc; acc = 0.5f * p; } }
            if (nv > 0) imp[nv >> 2] += acc;
        }
        const int cur = t >> 6; unsigned taken[4] = {0u, 0u, 0u, 0u};
        int* sel = SEL + ((size_t)row * 2 + kvh) * 16;
        for (int k = 0; k < 16; ++k) { float best = -INFINITY; int bi = 0;
            for (int s = 0; s < 128; ++s) { if ((taken[s >> 5] >> (s & 31)) & 1u) continue;
                const bool forced = (s == cur) | (s == cur - 1) | (s == 0);
                const float v = forced ? 1.0e4f : (s <= cur ? imp[s] : -1.f);
                if (v > best) { best = v; bi = s; } }
            taken[bi >> 5] |= 1u << (bi & 31); sel[k] = bi; }
    }
}
__device__ __forceinline__ void nv_nsa_b(Frame& F) {
    const bf16_t* PROJ = (const bf16_t*)(F.ws + WS_PROJ); const bf16_t* KCMP = (const bf16_t*)(F.ws + WS_KCMP); const bf16_t* VCMP = (const bf16_t*)(F.ws + WS_VCMP); const float* relb = F.in[1];
    const int* SEL = (const int*)(F.ws + WS_SEL); const f32x2* MD = (const f32x2*)(F.ws + WS_MD); bf16_t* OMIX = (bf16_t*)(F.ws + WS_XN);
    for (int idx = blockIdx.x * NTHR + F.tid; idx < 10 * M; idx += F.G * NTHR) {
        const int hb = idx / M, row = idx - hb * M, b = row >> 13, t = row & (SEQ - 1), kvh = hb / 5;
        const bf16_t* prow = PROJ + (size_t)row * NP;
        float q[64], o[64]; load_q64(q, prow + C_QB + hb * 64);
#pragma unroll
        for (int d = 0; d < 64; ++d) o[d] = 0.f;
        float g0 = 1.f / (1.f + __expf(-bf2f(((const bf16_t*)(F.ws + WS_GATES))[(size_t)row * 32 + hb * 3 + 0]))), g1 = 1.f / (1.f + __expf(-bf2f(((const bf16_t*)(F.ws + WS_GATES))[(size_t)row * 32 + hb * 3 + 1]))), g2 = 1.f / (1.f + __expf(-bf2f(((const bf16_t*)(F.ws + WS_GATES))[(size_t)row * 32 + hb * 3 + 2])));
#if MK_PROBE == 4
        if (MK_PBR != 0) g0 = 0.f; if (MK_PBR != 1) g1 = 0.f; if (MK_PBR != 2) g2 = 0.f;
#endif
        const float* rb = relb + 6 + hb;
        { int nv = t >= 31 ? ((t - 31) >> 4) + 1 : 0; if (nv > NCMP) nv = NCMP;
          const bf16_t* Kc = KCMP + (size_t)(b * 2 + kvh) * 512 * 64; const bf16_t* Vc = VCMP + (size_t)(b * 2 + kvh) * 512 * 64;
          const f32x2 md = MD[(size_t)row * 10 + hb]; const float w = nv > 0 ? g0 / md.y : 0.f;
          for (int n = 0; n < nv; ++n) { const float s = dot64(q, Kc + n * 64) * 0.125f + rb[t5_bucket(t - 16 * n - 31) * 16]; axpy64(o, __expf(s - md.x) * w, Vc + n * 64); } }
        { const int* sel = SEL + ((size_t)row * 2 + kvh) * 16; const bf16_t* base = PROJ + (size_t)(b * SEQ) * NP + kvh * 64;
          float m = -INFINITY;
          for (int k = 0; k < 16; ++k) { const int p0 = sel[k] * 64; for (int l = 0; l < 64 && p0 + l <= t; ++l) { const int pos = p0 + l; m = fmaxf(m, dot64(q, base + (size_t)pos * NP + C_KS) * 0.125f + rb[t5_bucket(t - pos) * 16]); } }
          float den = 0.f;
          for (int k = 0; k < 16; ++k) { const int p0 = sel[k] * 64; for (int l = 0; l < 64 && p0 + l <= t; ++l) { const int pos = p0 + l; den += __expf(dot64(q, base + (size_t)pos * NP + C_KS) * 0.125f + rb[t5_bucket(t - pos) * 16] - m); } }
          const float w = g1 / den;
          for (int k = 0; k < 16; ++k) { const int p0 = sel[k] * 64; for (int l = 0; l < 64 && p0 + l <= t; ++l) { const int pos = p0 + l; const bf16_t* kr = base + (size_t)pos * NP;
              axpy64(o, __expf(dot64(q, kr + C_KS) * 0.125f + rb[t5_bucket(t - pos) * 16] - m) * w, kr + C_VS); } } }
        { const bf16_t* base = PROJ + (size_t)(b * SEQ) * NP + kvh * 64; const int lo = t - 511 < 0 ? 0 : t - 511;
          float m = -INFINITY;
          for (int pos = lo; pos <= t; ++pos) m = fmaxf(m, dot64(q, base + (size_t)pos * NP + C_KW) * 0.125f + rb[t5_bucket(t - pos) * 16]);
          float den = 0.f;
          for (int pos = lo; pos <= t; ++pos) den += __expf(dot64(q, base + (size_t)pos * NP + C_KW) * 0.125f + rb[t5_bucket(t - pos) * 16] - m);
          const float w = g2 / den;
          for (int pos = lo; pos <= t; ++pos) { const bf16_t* kr = base + (size_t)pos * NP; axpy64(o, __expf(dot64(q, kr + C_KW) * 0.125f + rb[t5_bucket(t - pos) * 16] - m) * w, kr + C_VW); } }
#if MK_PROBE == 4
        { float f[64], fb[64]; bf16_t* p = OMIX + (size_t)row * D + 384 + hb * 64; load_q64(f, p); load_q64(fb, (const bf16_t*)(F.ws + WS_AUX) + (size_t)row * 640 + hb * 64);
#pragma unroll
          for (int d = 0; d < 64; ++d) o[d] = f[d] + PROBE_K * (fb[d] - o[d]);
#pragma unroll
          for (int c = 0; c < 8; ++c) { u32x4 w; w.x = pk2(o[8 * c], o[8 * c + 1]); w.y = pk2(o[8 * c + 2], o[8 * c + 3]); w.z = pk2(o[8 * c + 4], o[8 * c + 5]); w.w = pk2(o[8 * c + 6], o[8 * c + 7]); *(u32x4*)(p + 8 * c) = w; } }
#else
        store64(OMIX + (size_t)row * D + 384 + hb * 64, o, 1.f);
#endif
    }
}

constexpr float LOG2E = 1.4426950408889634f;
constexpr float QSC = 0.125f * LOG2E;
constexpr int ATT_TBN = 0;
constexpr int TBN_SZ = 3616, TBN_PAD = 1088, ATT_BIAS = 3648;
constexpr int TBW_PAD = 64;
constexpr int ATT_TBA = 0;
constexpr int TBA_SZ = 1076, TBA_P16 = 0, TBA_O16 = 16, TBA_P4 = 176, TBA_O4 = 64, TBA_P1 = 436, TBA_O1 = 256;
constexpr int ATT_KVR = 4352;
constexpr int KVR_KROW = 128, KVR_VROW = 136, KVR_VOFF = 64 * KVR_KROW, KVR_SLOT = 64 * KVR_KROW + 64 * KVR_VROW;
constexpr int ATT_TBW = ATT_KVR + 4 * KVR_SLOT, TBW_SZ = 576;
constexpr int ATT_WAVE = ATT_TBW + 5 * TBW_SZ * 2, ATT_WSZ = 8192;
constexpr int ATT_TBWM = ATT_WAVE + 8 * ATT_WSZ, TBWM_LO = 448, TBWM_SZ = 128;
static_assert(6 * TBA_SZ * 4 <= ATT_TBW && ATT_BIAS + 5 * 33 * 4 <= ATT_KVR && ATT_TBWM + 5 * TBWM_SZ * 2 <= LDS_BYTES - 16, "attention LDS map");

typedef __bf16 bf16x2_t __attribute__((ext_vector_type(2)));
__device__ __forceinline__ unsigned cvtpk(float lo, float hi) { f32x2 v = {lo, hi}; bf16x2_t b = __builtin_convertvector(v, bf16x2_t); return __builtin_bit_cast(unsigned, b); }
__device__ __forceinline__ f32x4 mfma16(bf16x8 a, bf16x8 b, f32x4 c) { return __builtin_amdgcn_mfma_f32_16x16x32_bf16(a, b, c, 0, 0, 0); }
__device__ __forceinline__ float ex2(float x) { return __builtin_amdgcn_exp2f(x); }
__device__ __forceinline__ float kgmax(float v) { v = fmaxf(v, __shfl_xor(v, 16)); v = fmaxf(v, __shfl_xor(v, 32)); return v; }
__device__ __forceinline__ float kgsum(float v) { v += __shfl_xor(v, 16); v += __shfl_xor(v, 32); return v; }
__device__ __forceinline__ float dpp_shr(float v, int n) {
    int r = 0;
    if (n == 1) r = __builtin_amdgcn_update_dpp(0, __builtin_bit_cast(int, v), 0x111, 0xf, 0xf, true);
    if (n == 2) r = __builtin_amdgcn_update_dpp(0, __builtin_bit_cast(int, v), 0x112, 0xf, 0xf, true);
    if (n == 4) r = __builtin_amdgcn_update_dpp(0, __builtin_bit_cast(int, v), 0x114, 0xf, 0xf, true);
    return __builtin_bit_cast(float, r);
}
__device__ __forceinline__ float dpp_ror(float v, int n) {
    int r = 0;
    if (n == 1) r = __builtin_amdgcn_update_dpp(0, __builtin_bit_cast(int, v), 0x121, 0xf, 0xf, false);
    if (n == 2) r = __builtin_amdgcn_update_dpp(0, __builtin_bit_cast(int, v), 0x122, 0xf, 0xf, false);
    if (n == 4) r = __builtin_amdgcn_update_dpp(0, __builtin_bit_cast(int, v), 0x124, 0xf, 0xf, false);
    if (n == 8) r = __builtin_amdgcn_update_dpp(0, __builtin_bit_cast(int, v), 0x128, 0xf, 0xf, false);
    return __builtin_bit_cast(float, r);
}
__device__ __forceinline__ float rowmax16(float v) { v = fmaxf(v, dpp_ror(v, 8)); v = fmaxf(v, dpp_ror(v, 4)); v = fmaxf(v, dpp_ror(v, 2)); v = fmaxf(v, dpp_ror(v, 1)); return v; }
__device__ __forceinline__ int dpp_rori(int v, int n) {
    if (n == 1) return __builtin_amdgcn_update_dpp(0, v, 0x121, 0xf, 0xf, false);
    if (n == 2) return __builtin_amdgcn_update_dpp(0, v, 0x122, 0xf, 0xf, false);
    if (n == 4) return __builtin_amdgcn_update_dpp(0, v, 0x124, 0xf, 0xf, false);
    return __builtin_amdgcn_update_dpp(0, v, 0x128, 0xf, 0xf, false);
}
__device__ __forceinline__ int rowmax16i(int v) { v = max(v, dpp_rori(v, 8)); v = max(v, dpp_rori(v, 4)); v = max(v, dpp_rori(v, 2)); v = max(v, dpp_rori(v, 1)); return v; }
__device__ __forceinline__ int rowmin16(int v) { float f = (float)v;
    f = fminf(f, dpp_ror(f, 8)); f = fminf(f, dpp_ror(f, 4)); f = fminf(f, dpp_ror(f, 2)); f = fminf(f, dpp_ror(f, 1)); return (int)f; }
__device__ __forceinline__ float sum5(float v) { const float t1 = v + dpp_shr(v, 1); const float t2 = t1 + dpp_shr(t1, 2); return t2 + dpp_shr(v, 4); }

__device__ __forceinline__ bf16x8 ones8() { const u32x4 w = {0x3f803f80u, 0x3f803f80u, 0x3f803f80u, 0x3f803f80u}; return __builtin_bit_cast(bf16x8, w); }

struct ColState { float m; f32x4 la; f32x4 o[4]; };
__device__ __forceinline__ void cs_init(ColState& s) { s.m = -INFINITY; s.la = (f32x4){0.f, 0.f, 0.f, 0.f};
#pragma unroll
    for (int d = 0; d < 4; ++d) s.o[d] = (f32x4){0.f, 0.f, 0.f, 0.f}; }

constexpr float RESC_THR = 8.f;
template <int NC, class BF>
__device__ __forceinline__ void step32(ColState (&st)[NC], const bf16x8 (&q)[NC][2], const bf16x8 ka0, const bf16x8 ka1, const bf16x8 kb0, const bf16x8 kb1, const bf16x8 (&V)[4], const BF& bias) {
    bf16x8 P[NC];
    const f32x4 z = {0.f, 0.f, 0.f, 0.f};
    const f32x2 qs = {QSC, QSC};
#pragma unroll
    for (int c = 0; c < NC; ++c) {
        f32x4 sA = mfma16(ka0, q[c][0], z); sA = mfma16(ka1, q[c][1], sA);
        f32x4 sB = mfma16(kb0, q[c][0], z); sB = mfma16(kb1, q[c][1], sB);
        f32x2 x0 = (f32x2){sA[0], sA[1]} * qs + (f32x2){bias(c, 0, 0), bias(c, 0, 1)}, x1 = (f32x2){sA[2], sA[3]} * qs + (f32x2){bias(c, 0, 2), bias(c, 0, 3)};
        f32x2 x2 = (f32x2){sB[0], sB[1]} * qs + (f32x2){bias(c, 1, 0), bias(c, 1, 1)}, x3 = (f32x2){sB[2], sB[3]} * qs + (f32x2){bias(c, 1, 2), bias(c, 1, 3)};
        const float mx = fmaxf(fmaxf(fmaxf(fmaxf(x0.x, x0.y), x1.x), fmaxf(fmaxf(x1.y, x2.x), x2.y)), fmaxf(x3.x, x3.y));
        if (__builtin_expect(__any(mx > st[c].m + RESC_THR), 0)) {
            const float mn = fmaxf(st[c].m, kgmax(mx)), mref = (mn == -INFINITY) ? 0.f : mn;
            const float alpha = ex2(st[c].m - mref);
            st[c].la = st[c].la * alpha; st[c].m = mn;
#pragma unroll
            for (int d = 0; d < 4; ++d) st[c].o[d] = st[c].o[d] * alpha;
        }
        const float mref = (st[c].m == -INFINITY) ? 0.f : st[c].m; const f32x2 mm = {mref, mref};
        x0 = x0 - mm; x1 = x1 - mm; x2 = x2 - mm; x3 = x3 - mm;
        const f32x2 p0 = {ex2(x0.x), ex2(x0.y)}, p1 = {ex2(x1.x), ex2(x1.y)}, p2 = {ex2(x2.x), ex2(x2.y)}, p3 = {ex2(x3.x), ex2(x3.y)};
        u32x4 pw = {cvtpk(p0.x, p0.y), cvtpk(p1.x, p1.y), cvtpk(p2.x, p2.y), cvtpk(p3.x, p3.y)};
        P[c] = __builtin_bit_cast(bf16x8, pw);
    }
    __builtin_amdgcn_s_setprio(1);
#pragma unroll
    for (int d = 0; d < 4; ++d)
#pragma unroll
        for (int c = 0; c < NC; ++c) st[c].o[d] = mfma16(V[d], P[c], st[c].o[d]);
#pragma unroll
    for (int c = 0; c < NC; ++c) st[c].la = mfma16(ones8(), P[c], st[c].la);
    __builtin_amdgcn_s_setprio(0);
}
template <class BF>
__device__ __forceinline__ void scores64(f32x2 (&x)[8], const bf16x8 (&q)[2], const bf16x8 (&kf)[4][2], const BF& bias) {
    const f32x4 z = {0.f, 0.f, 0.f, 0.f};
    const f32x2 qs = {QSC, QSC};
#pragma unroll
    for (int t = 0; t < 4; ++t) { f32x4 s = mfma16(kf[t][0], q[0], z); s = mfma16(kf[t][1], q[1], s);
        x[2 * t] = (f32x2){s[0], s[1]} * qs + (f32x2){bias(t, 0), bias(t, 1)}; x[2 * t + 1] = (f32x2){s[2], s[3]} * qs + (f32x2){bias(t, 2), bias(t, 3)}; }
}
template <class VF>
__device__ __forceinline__ void step64_tail(ColState& st, f32x2 (&x)[8], const VF& ldv) {
    float mx = fmaxf(x[0].x, x[0].y);
#pragma unroll
    for (int k = 1; k < 8; ++k) mx = fmaxf(fmaxf(mx, x[k].x), x[k].y);
    const float thr = (st.m == -INFINITY) ? -INFINITY : RESC_THR;
    if (__builtin_expect(__any(mx > thr), 0)) {
        const float mold = (st.m == -INFINITY) ? 0.f : st.m;
        const float mn = fmaxf(st.m, kgmax(mx) + mold), mref = (mn == -INFINITY) ? 0.f : mn;
        const float alpha = ex2(st.m - mref), dm = mref - mold;
        st.la = st.la * alpha; st.m = mn;
#pragma unroll
        for (int d = 0; d < 4; ++d) st.o[d] = st.o[d] * alpha;
#pragma unroll
        for (int k = 0; k < 8; ++k) { x[k].x -= dm; x[k].y -= dm; }
    }
    f32x2 p[8];
#pragma unroll
    for (int k = 0; k < 8; ++k) p[k] = (f32x2){ex2(x[k].x), ex2(x[k].y)};
#pragma unroll
    for (int h = 0; h < 2; ++h) { u32x4 pw = {cvtpk(p[4 * h].x, p[4 * h].y), cvtpk(p[4 * h + 1].x, p[4 * h + 1].y), cvtpk(p[4 * h + 2].x, p[4 * h + 2].y), cvtpk(p[4 * h + 3].x, p[4 * h + 3].y)};
        const bf16x8 P = __builtin_bit_cast(bf16x8, pw);
        bf16x8 V[4]; ldv(h, V);
        __builtin_amdgcn_s_setprio(1);
#pragma unroll
        for (int d = 0; d < 4; ++d) st.o[d] = mfma16(V[d], P, st.o[d]);
        st.la = mfma16(ones8(), P, st.la);
        __builtin_amdgcn_s_setprio(0); }
}
__device__ __forceinline__ void ldv4(bf16x8 (&V)[4], const bf16_t* vA, const bf16_t* vB, const size_t vstep) {
#pragma unroll
    for (int d = 0; d < 4; ++d) { const u32x2 va = *(const u32x2*)(vA + d * vstep), vb = *(const u32x2*)(vB + d * vstep); u32x4 vw = {va.x, va.y, vb.x, vb.y}; V[d] = __builtin_bit_cast(bf16x8, vw); }
}

struct AttnG {
    const bf16_t* PROJ; const bf16_t* KCMP; const bf16_t* VCT; const bf16_t* VTS; const bf16_t* VTW; const bf16_t* VTA1; const bf16_t* VTA4; const bf16_t* VTA16; const bf16_t* KA1; const bf16_t* KA4; const bf16_t* KA16; bf16_t* OMIX;
};

__device__ __forceinline__ void attn_tables_nsa(Frame& F, int kvh) {
    LAS unsigned char* BKT = (LAS unsigned char*)(F.lds + ATT_TBN); LAS float* BIAS = (LAS float*)(F.lds + ATT_BIAS); const float* relb = F.in[1];
    for (int e = F.tid; e < TBN_SZ; e += NTHR) { const int d = e - TBN_PAD; BKT[e] = (unsigned char)(d < 0 ? 32 : t5_bucket(d)); }
    if (F.tid < 5 * 33) { const int g = F.tid / 33, k = F.tid - g * 33; BIAS[F.tid] = k == 32 ? -INFINITY : relb[k * 16 + 6 + kvh * 5 + g] * LOG2E; }
    { LAS unsigned short* TBW = (LAS unsigned short*)(F.lds + ATT_TBW);
      for (int e = F.tid; e < 5 * TBW_SZ; e += NTHR) { const int g = e / TBW_SZ, d = e - g * TBW_SZ - TBW_PAD; TBW[e] = d < 0 ? (unsigned short)0xff80u : (unsigned short)f2bf(relb[t5_bucket(d) * 16 + 6 + kvh * 5 + g] * LOG2E); } }
    { LAS unsigned short* TBWM = (LAS unsigned short*)(F.lds + ATT_TBWM);
      for (int e = F.tid; e < 5 * TBWM_SZ; e += NTHR) { const int g = e / TBWM_SZ, d = e - g * TBWM_SZ + TBWM_LO; TBWM[e] = d > 511 ? (unsigned short)0xff80u : (unsigned short)f2bf(relb[t5_bucket(d) * 16 + 6 + kvh * 5 + g] * LOG2E); } }
    __syncthreads();
}
__device__ __forceinline__ void attn_tables_mixa(Frame& F) {
    LAS float* TBA = (LAS float*)(F.lds + ATT_TBA); const float* relb = F.in[1];
    for (int e = F.tid; e < 6 * TBA_SZ; e += NTHR) { const int h = e / TBA_SZ, k = e - h * TBA_SZ; int j, dil;
        if (k < TBA_P4) { j = k - TBA_P16 - TBA_O16; dil = 16; } else if (k < TBA_P1) { const int e2 = k - TBA_P4, lo = e2 / 65, hi = e2 - lo * 65; j = 4 * hi + lo - TBA_O4; dil = 4; } else { j = k - TBA_P1 - TBA_O1; dil = 1; }
        TBA[e] = (j < 0 || j > 128) ? -INFINITY : relb[t5_bucket(dil * j) * 16 + h] * LOG2E; }
    __syncthreads();
}

__device__ __forceinline__ void vt_item(const bf16_t* src  , int dil, int cls, int m64, bf16_t* dst  , LAS unsigned char* wl, int lane, bool blocked) {
    constexpr int RS = 136;
#pragma unroll
    for (int it = 0; it < 8; ++it) { const int k = it * 8 + (lane >> 3), c = lane & 7; const int t = cls + dil * (64 * m64 + k);
        const u32x4 v = *(const u32x4*)(src + (size_t)t * NP + c * 8);
        *(LAS u32x2*)(wl + k * RS + c * 16) = (u32x2){v.x, v.y}; *(LAS u32x2*)(wl + k * RS + c * 16 + 8) = (u32x2){v.z, v.w}; }
    LDS_WAIT(); asm volatile("" ::: "memory");
    const int pos0 = cls * (SEQ / dil) + 64 * m64;
#pragma unroll
    for (int it = 0; it < 8; ++it) { const int dim = (lane >> 3) + 8 * it, c = lane & 7; unsigned short e[8];
#pragma unroll
        for (int k = 0; k < 8; ++k) e[k] = *(const LAS unsigned short*)(wl + (8 * c + k) * RS + dim * 2);
        u32x4 o = {(unsigned)e[0] | ((unsigned)e[1] << 16), (unsigned)e[2] | ((unsigned)e[3] << 16), (unsigned)e[4] | ((unsigned)e[5] << 16), (unsigned)e[6] | ((unsigned)e[7] << 16)};
        const int pos = pos0 + 8 * c;
        *(u32x4*)(blocked ? dst + (size_t)(pos >> 4) * 1024 + dim * 16 + (pos & 15) : dst + (size_t)dim * SEQ + pos) = o; }
    LDS_WAIT(); asm volatile("" ::: "memory");
}
__device__ __forceinline__ void kt_item(const bf16_t* src  , int dil, int cls, int m64, bf16_t* dst, int lane) {
    const int pos0 = cls * (SEQ / dil) + 64 * m64;
#pragma unroll
    for (int it = 0; it < 8; ++it) { const int k = it * 8 + (lane >> 3), c = lane & 7; const int t = cls + dil * (64 * m64 + k), pos = pos0 + k;
        const u32x4 v = *(const u32x4*)(src + (size_t)t * NP + c * 8);
        *(u32x4*)(dst + (size_t)(pos >> 4) * 1024 + (c >> 2) * 512 + (pos & 15) * 32 + (c & 3) * 8) = v; }
}
__device__ __forceinline__ void vt_phase(Frame& F, int w0, int nw) {
    const bf16_t* PROJ = (const bf16_t*)(F.ws + WS_PROJ); LAS unsigned char* wl = F.lds + F.wave * 16384;
    for (int it = w0; it < 2048 + 2 * 3072; it += nw) {
        if (it < 2048) { const int w = it >> 10, r = it & 1023, bk = r >> 7, m64 = r & 127, b = bk >> 1, kvh = bk & 1;
            vt_item(PROJ + (size_t)b * SEQ * NP + (w ? C_VW : C_VS) + kvh * 64, 1, 0, m64, (bf16_t*)(F.ws + (w ? WS_VTW : WS_VTS)) + (size_t)bk * 64 * SEQ, wl, F.lane, false); }
        else { const int r0 = it - 2048, lay = r0 / 3072, r = r0 - lay * 3072, bh = r >> 7, m = r & 127, b = bh / 6, h = bh - b * 6;
            const int dil = lay == 0 ? 1 : 16; const int per = 128 / dil, cls = m / per, m64 = m - cls * per;
            vt_item(PROJ + (size_t)b * SEQ * NP + C_VA + h * 64, dil, cls, m64, (bf16_t*)(F.ws + (lay == 0 ? WS_VTA1 : WS_VTA16)) + (size_t)bh * 64 * SEQ, wl, F.lane, true);
            kt_item(PROJ + (size_t)b * SEQ * NP + C_KA + h * 64, dil, cls, m64, (bf16_t*)(F.ws + (lay == 0 ? WS_KA1 : WS_KA16)) + (size_t)bh * 64 * SEQ, F.lane); }
    }
}

struct KVF { bf16x8 ka0, ka1, kb0, kb1; bf16x8 V[4]; };
__device__ __forceinline__ void mixa_item(const AttnG& G, LAS const float* TBh, int b, int h, int r16, int i0, int lane_in) {
    int lane = lane_in; asm volatile("" : "+v"(lane));
    const int i = lane & 15, kg = lane >> 4;
    const int tq = r16 + 16 * (i0 + i);
    const bf16_t* Pb = G.PROJ + (size_t)b * SEQ * NP;
    bf16x8 q[1][2];
    { const bf16_t* qp = Pb + (size_t)tq * NP + C_QA + h * 64 + 8 * kg; q[0][0] = *(const bf16x8*)qp; q[0][1] = *(const bf16x8*)(qp + 32); }
    ColState st[1]; cs_init(st[0]);
    const bf16_t* Kb = Pb + C_KA + h * 64 + 8 * kg;
    const size_t khead = (size_t)(b * 6 + h) * 64 * SEQ + (size_t)i * 32 + 8 * kg;
    const size_t vhead = (size_t)(b * 6 + h) * 64 * SEQ + (size_t)i * 16 + 4 * kg;
    const int r4 = r16 & 3, c4 = r16 >> 2;
    const size_t khead4 = (size_t)(b * 6 + h) * 64 * SEQ + (size_t)(r4 + 4 * (i >> 2)) * 512 * 64 + (size_t)(i & 3) * 32 + 8 * kg;
    const size_t vhead4 = (size_t)(b * 6 + h) * 64 * SEQ + (size_t)(r4 + 4 * kg) * 512 * 64 + (size_t)i * 16;
    const int j4 = c4 + 4 * i + 128 - kg + TBA_O4, jt4 = TBA_P4 + (j4 & 3) * 65 + (j4 >> 2);
    auto ks0_of = [&](int s) -> int { return s < 5 ? i0 - 144 + 32 * s : (s < 11 ? 4 * i0 - 128 + 32 * (s - 5) : 16 * i0 - 128 + 32 * (s - 11)); };
    auto jt_of = [&](int s) -> int { return s < 5 ? (i + 144 - 4 * kg + TBA_P16 + TBA_O16) - 32 * s : (s < 11 ? jt4 - 8 * (s - 5) : (r16 + 16 * i + 128 - 4 * kg + TBA_P1 + TBA_O1) - 32 * (s - 11)); };
    auto load = [&](KVF& f, int s) { const int ks0 = ks0_of(s); const int kA = ks0 < 0 ? 0 : ks0, kB = ks0 + 16 < 0 ? 0 : ks0 + 16;
        const bf16_t* ra; const bf16_t* rb; const bf16_t* va; const bf16_t* vb2;
        if (s >= 5 && s < 11) {
            const int pA = kA >> 2, pB = kB >> 2;
            ra = G.KA16 + khead4 + (size_t)(pA >> 4) * 1024 + (pA & 15) * 32; rb = G.KA16 + khead4 + (size_t)(pB >> 4) * 1024 + (pB & 15) * 32;
            va = G.VTA16 + vhead4 + (size_t)(pA >> 4) * 1024 + (pA & 15); vb2 = G.VTA16 + vhead4 + (size_t)(pB >> 4) * 1024 + (pB & 15);
        } else {
            const bf16_t* kb_ = (s < 5 ? G.KA16 + r16 * 512 * 64 : G.KA1) + khead;
            ra = kb_ + (size_t)(kA >> 4) * 1024; rb = kb_ + (size_t)(kB >> 4) * 1024;
            const bf16_t* vb = (s < 5 ? G.VTA16 + r16 * 512 * 64 : G.VTA1) + vhead;
            va = vb + (size_t)(kA >> 4) * 1024; vb2 = vb + (size_t)(kB >> 4) * 1024; }
        f.ka0 = *(const bf16x8*)ra; f.ka1 = *(const bf16x8*)(ra + 512); f.kb0 = *(const bf16x8*)rb; f.kb1 = *(const bf16x8*)(rb + 512);
        ldv4(f.V, va, vb2, (size_t)256); };
    auto comp = [&](const KVF& f, int s) { const int ks0 = ks0_of(s); const int jt = jt_of(s);
        const int jA = ks0 >= 0 ? jt : TBA_P16 + 3, jB = ks0 + 16 >= 0 ? jt - ((s >= 5 && s < 11) ? 4 : 16) : TBA_P16 + 3;
        step32<1>(st, q, f.ka0, f.ka1, f.kb0, f.kb1, f.V, [&](int, int tile, int r) -> float { return TBh[(tile == 0 ? jA : jB) - r]; }); };
    KVF fa, fb, fc;
    load(fa, 0); load(fb, 1);
#pragma unroll 1
    for (int s = 0; s < 21; s += 3) { load(fc, s + 2); comp(fa, s); load(fa, s + 3); comp(fb, s + 1); load(fb, s + 4); comp(fc, s + 2); }
    comp(fa, 21); comp(fb, 22);
    const float inv = 1.f / st[0].la[0];
    bf16_t* op = G.OMIX + (size_t)(b * SEQ + tq) * D + h * 64 + 4 * kg;
#pragma unroll
    for (int d = 0; d < 4; ++d) { const f32x4 o = st[0].o[d] * inv; *(u32x2*)(op + 16 * d) = (u32x2){cvtpk(o[0], o[1]), cvtpk(o[2], o[3])}; }
}

#if MK_PROBE == 4
#define AUX_STORE(BR, J, D, VAL) do { if (MK_PBR == (BR) && cv[J]) { const f32x4 v_ = (VAL); *(u32x2*)(AUXP + (size_t)(b * SEQ + tcol[J]) * 640 + hb * 64 + 4 * kg + 16 * (D)) = (u32x2){cvtpk(v_[0], v_[1]), cvtpk(v_[2], v_[3])}; } } while (0)
#else
#define AUX_STORE(BR, J, D, VAL) do { } while (0)
#endif
__device__ __forceinline__ void nsa_group(Frame& F, const AttnG& G, int b, int kvh, int grp) {
    int lane = F.lane; asm volatile("" : "+v"(lane));
    const int t0 = 64 * grp + 8 * F.wave;
    LAS unsigned char* wl = F.lds + ATT_WAVE + F.wave * ATT_WSZ;
    const int i = lane & 15, kg = lane >> 4, g = i % 5, i5 = i / 5, hb = kvh * 5 + g;
    const int cur = grp, bk = b * 2 + kvh;
    const bf16_t* Pb = G.PROJ + (size_t)b * SEQ * NP; const bf16_t* GTb = (const bf16_t*)(F.ws + WS_GATES) + (size_t)b * SEQ * 32;
#if MK_PROBE == 4
    bf16_t* AUXP = (bf16_t*)((unsigned char*)G.OMIX - WS_XN + WS_AUX);
#endif
    LAS const unsigned char* BKT = (LAS const unsigned char*)(F.lds + ATT_TBN) + TBN_PAD; LAS const float* BIASg = (LAS const float*)(F.lds + ATT_BIAS) + g * 33;
    auto tbg = [&](int d) -> float { return BIASg[BKT[d]]; };
    const float b31 = BIASg[31];
    LAS const unsigned short* TBWg = (LAS const unsigned short*)(F.lds + ATT_TBW) + g * TBW_SZ + TBW_PAD;
    auto tbn = [&](int d) -> float { return __builtin_bit_cast(float, (unsigned)TBWg[d] << 16); };
    int tcol[3]; bool cv[3]; bf16x8 q[3][2];
#pragma unroll
    for (int j = 0; j < 3; ++j) { int tql = 3 * j + i5; cv[j] = (i < 15) && (tql < 8); if (tql > 7) tql = 7; tcol[j] = t0 + tql;
        const bf16_t* qp = Pb + (size_t)tcol[j] * NP + C_QB + hb * 64 + 8 * kg; q[j][0] = *(const bf16x8*)qp; q[j][1] = *(const bf16x8*)(qp + 32); }
    auto gate_of = [&](int j, int k) -> float { return 1.f / (1.f + __expf(-bf2f(GTb[(size_t)tcol[j] * 32 + hb * 3 + k]))); };
    LAS unsigned char* ring = F.lds + ATT_KVR;
    const int sr = F.tid >> 3, scc = F.tid & 7;
    int bc = 0;
#define RING_WRITE(SLOT, KR, VR, WITHV) do { LAS unsigned char* sl_ = ring + (SLOT) * KVR_SLOT; *(LAS u32x4*)(sl_ + sr * 128 + ((scc ^ ((sr >> 1) & 7)) << 4)) = KR; \
        if (WITHV) { *(LAS u32x2*)(sl_ + KVR_VOFF + sr * KVR_VROW + scc * 16) = (u32x2){VR.x, VR.y}; *(LAS u32x2*)(sl_ + KVR_VOFF + sr * KVR_VROW + scc * 16 + 8) = (u32x2){VR.z, VR.w}; } } while (0)
    const int fsw = (i >> 1) & 7;
    const int kofs0 = i * 128 + ((kg ^ fsw) << 4), kofs1 = i * 128 + (((kg + 4) ^ fsw) << 4);
#define RING_K(SL, KF) do { _Pragma("unroll") for (int kt_ = 0; kt_ < 4; ++kt_) { KF[kt_][0] = *(LAS const bf16x8*)((SL) + 2048 * kt_ + kofs0); KF[kt_][1] = *(LAS const bf16x8*)((SL) + 2048 * kt_ + kofs1); } } while (0)
#define RING_K2(SL, HF, KF) do { _Pragma("unroll") for (int kt_ = 0; kt_ < 2; ++kt_) { KF[kt_][0] = *(LAS const bf16x8*)((SL) + 4096 * (HF) + 2048 * kt_ + kofs0); KF[kt_][1] = *(LAS const bf16x8*)((SL) + 4096 * (HF) + 2048 * kt_ + kofs1); } } while (0)
#define RING_V(SL, HF, VV) do { _Pragma("unroll") for (int d_ = 0; d_ < 4; ++d_) { const u32x2 va_ = *(LAS const u32x2*)((SL) + KVR_VOFF + (i + 16 * d_) * KVR_VROW + 64 * (HF) + 8 * kg), vb_ = *(LAS const u32x2*)((SL) + KVR_VOFF + (i + 16 * d_) * KVR_VROW + 64 * (HF) + 32 + 8 * kg); \
        u32x4 vw_ = {va_.x, va_.y, vb_.x, vb_.y}; VV[d_] = __builtin_bit_cast(bf16x8, vw_); } } while (0)
#define RING_BAR() asm volatile("s_waitcnt lgkmcnt(0)\n\ts_barrier" ::: "memory")
    auto ring_run = [&](const int nb, auto ksrc, auto vsrc, const bool withv, auto compute) {
        const int ns = (nb + 1) >> 1;
        u32x4 k0, v0 = {0u, 0u, 0u, 0u}, k1, v1 = v0;
        auto ld = [&](int p) { const int n0 = 2 * p < nb ? 2 * p : nb - 1, n1 = 2 * p + 1 < nb ? 2 * p + 1 : nb - 1;
            k0 = *(const u32x4*)ksrc(n0); k1 = *(const u32x4*)ksrc(n1); if (withv) { v0 = *(const u32x4*)vsrc(n0); v1 = *(const u32x4*)vsrc(n1); } };
        if (nb > 0) { ld(0); const int s0 = 2 * (bc & 1); RING_WRITE(s0, k0, v0, withv); RING_WRITE(s0 + 1, k1, v1, withv); ld(1); }
        RING_BAR();
#pragma unroll 1
        for (int p = 0; p < ns; ++p) {
            const int s0 = 2 * ((bc + p) & 1);
            compute(2 * p, (LAS const unsigned char*)(ring + s0 * KVR_SLOT));
            if (2 * p + 1 < nb) compute(2 * p + 1, (LAS const unsigned char*)(ring + (s0 + 1) * KVR_SLOT));
            if (p + 1 < ns) { const int s1 = 2 - s0; RING_WRITE(s1, k0, v0, withv); RING_WRITE(s1 + 1, k1, v1, withv); }
            RING_BAR();
            ld(p + 2);
        }
        bc += ns;
    };
    f32x4 out[3][4];
    {
        int NVg = (64 * grp + 63 >= 31) ? ((64 * grp + 63 - 31) >> 4) + 1 : 0; if (NVg > NCMP) NVg = NCMP;
        const int ncb = (NVg + 63) >> 6;
        const bf16_t* kcs = G.KCMP + ((size_t)bk * 512 + sr) * 64 + scc * 8;
        const bf16_t* vcs = G.VCT + ((size_t)bk * 64 + sr) * 512 + scc * 8;
        const f32x4 z = {0.f, 0.f, 0.f, 0.f};
        float m1[3] = {-INFINITY, -INFINITY, -INFINITY}, l1[3] = {0.f, 0.f, 0.f};
        ring_run(ncb, [&](int n) { return kcs + (size_t)n * 64 * 64; }, [&](int n) { return vcs + n * 64; }, false, [&](int cb, LAS const unsigned char* sl) {
            const bool cfar = (t0 - 31 - 16 * (64 * cb + 63)) >= 1513;
            bf16x8 kf[4][2]; RING_K(sl, kf);
#pragma unroll
            for (int j = 0; j < 3; ++j) { const float mold = (m1[j] == -INFINITY) ? 0.f : m1[j]; float x[16];
                if (cfar) { const float bm = b31 - mold;
#pragma unroll
                    for (int kt = 0; kt < 4; ++kt) { f32x4 sc = mfma16(kf[kt][0], q[j][0], z); sc = mfma16(kf[kt][1], q[j][1], sc);
#pragma unroll
                        for (int r = 0; r < 4; ++r) x[4 * kt + r] = sc[r] * QSC + bm; }
                } else {
                    LAS const unsigned char* pb1 = BKT + (tcol[j] - 31 - 64 * kg - 1024 * cb - 816);
#pragma unroll
                    for (int kt = 0; kt < 4; ++kt) { f32x4 sc = mfma16(kf[kt][0], q[j][0], z); sc = mfma16(kf[kt][1], q[j][1], sc);
#pragma unroll
                        for (int r = 0; r < 4; ++r) x[4 * kt + r] = (sc[r] * QSC + BIASg[pb1[816 - 256 * kt - 16 * r]]) - mold; }
                }
                float mx = fmaxf(x[0], x[1]);
#pragma unroll
                for (int k = 2; k < 16; ++k) mx = fmaxf(mx, x[k]);
                const float thr = (m1[j] == -INFINITY) ? -INFINITY : RESC_THR;
                if (__builtin_expect(__any(mx > thr), 0)) { const float mn = fmaxf(m1[j], mx + mold), mref = (mn == -INFINITY) ? 0.f : mn, dm = mref - mold;
                    l1[j] *= ex2(m1[j] - mref); m1[j] = mn;
#pragma unroll
                    for (int k = 0; k < 16; ++k) x[k] -= dm; }
                float sm = 0.f;
#pragma unroll
                for (int k = 0; k < 16; ++k) sm += ex2(x[k]);
                l1[j] += sm; }
        });
        float Mr[3], iL[3];
#pragma unroll
        for (int j = 0; j < 3; ++j) { const float Mx = kgmax(m1[j]); const float Mr_ = (Mx == -INFINITY) ? 0.f : Mx; const float L = kgsum(l1[j] * ex2(m1[j] - Mr_));
            Mr[j] = L > 0.f ? Mr_ + __builtin_amdgcn_logf(L) : INFINITY; iL[j] = 1.f; }
        ColState st[3];
#pragma unroll
        for (int j = 0; j < 3; ++j) cs_init(st[j]);
        LAS float* IOWN = (LAS float*)wl; LAS float* ICAR = (LAS float*)(wl + 4096);
        ring_run(ncb, [&](int n) { return kcs + (size_t)n * 64 * 64; }, [&](int n) { return vcs + n * 64; }, true, [&](int cb, LAS const unsigned char* sl) {
            const bool cfar = (t0 - 31 - 16 * (64 * cb + 63)) >= 1513;
#pragma unroll 1
            for (int hf = 0; hf < 2; ++hf) {
                bf16x8 kf2[2][2]; RING_K2(sl, hf, kf2);
                bf16x8 V[4]; RING_V(sl, hf, V);
                const int kt = 4 * cb + 2 * hf;
                bf16x8 P[3];
#pragma unroll
                for (int j = 0; j < 3; ++j) { f32x4 sA = mfma16(kf2[0][0], q[j][0], z); sA = mfma16(kf2[0][1], q[j][1], sA); f32x4 sB = mfma16(kf2[1][0], q[j][0], z); sB = mfma16(kf2[1][1], q[j][1], sB);
                    const int db = tcol[j] - 31 - 64 * kg - 256 * kt; float p[8];
                    if (cfar) { const float bm = b31 - Mr[j];
#pragma unroll
                        for (int r = 0; r < 4; ++r) { p[r] = ex2(sA[r] * QSC + bm); p[4 + r] = ex2(sB[r] * QSC + bm); }
                    } else { LAS const unsigned char* pb2 = BKT + (db - 304);
#pragma unroll
                        for (int r = 0; r < 4; ++r) { p[r] = ex2(sA[r] * QSC + BIASg[pb2[304 - 16 * r]] - Mr[j]); p[4 + r] = ex2(sB[r] * QSC + BIASg[pb2[48 - 16 * r]] - Mr[j]); } }
                    const float ownA = sum5((p[0] + p[1]) + (p[2] + 0.5f * p[3])), carA = sum5(0.5f * p[3]), ownB = sum5((p[4] + p[5]) + (p[6] + 0.5f * p[7])), carB = sum5(0.5f * p[7]);
                    if (cv[j] && g == 4) { const int tql = 3 * j + i5; IOWN[tql * 128 + 4 * kt + kg] = ownA; ICAR[tql * 128 + 4 * kt + kg] = carA; IOWN[tql * 128 + 4 * kt + 4 + kg] = ownB; ICAR[tql * 128 + 4 * kt + 4 + kg] = carB; }
                    u32x4 pw = {cvtpk(p[0], p[1]), cvtpk(p[2], p[3]), cvtpk(p[4], p[5]), cvtpk(p[6], p[7])}; P[j] = __builtin_bit_cast(bf16x8, pw); }
#pragma unroll
                for (int d = 0; d < 4; ++d)
#pragma unroll
                    for (int j = 0; j < 3; ++j) st[j].o[d] = mfma16(V[d], P[j], st[j].o[d]);
            }
        });
#pragma unroll
        for (int j = 0; j < 3; ++j) { const float g0 = gate_of(j, 0);
#pragma unroll
            for (int d = 0; d < 4; ++d) { out[j][d] = st[j].o[d] * g0; AUX_STORE(0, j, d, out[j][d]); } }
    }
    LDS_WAIT(); asm volatile("" ::: "memory");
    unsigned selb[2];
    {
        int l2 = lane; asm volatile("" : "+v"(l2)); const int i = l2 & 15, kg = l2 >> 4;
        LAS const float* IOWN = (LAS const float*)wl; LAS const float* ICAR = (LAS const float*)(wl + 4096);
        const int ncand = cur - 2 > 0 ? cur - 2 : 0, nforced = cur == 0 ? 1 : (cur == 1 ? 2 : 3), nfree = 16 - nforced;
#pragma unroll
        for (int ps = 0; ps < 2; ++ps) { const int tql = ps * 4 + kg; int v[8]; unsigned sb = 0u;
#pragma unroll
            for (int k = 0; k < 8; ++k) { const int s = i + 16 * k; const bool forced = (s == 0) | (s == cur) | (s == cur - 1); const bool cand = (s >= 1) && (s <= cur - 2);
                if (forced && s <= cur) sb |= 1u << k;
                const float imp = cand ? IOWN[tql * 128 + s] + ICAR[tql * 128 + s - 1] : 0.f;
                v[k] = cand ? (int)((__builtin_bit_cast(unsigned, imp) & ~127u) | (unsigned)(127 - s)) : -1; }
            if (ncand <= nfree) {
#pragma unroll
                for (int k = 0; k < 8; ++k) { const int s = i + 16 * k; if ((s >= 1) && (s <= cur - 2)) sb |= 1u << k; }
            } else {
#pragma unroll 1
                for (int rd = 0; rd < nfree; ++rd) {
                    int lm = max(max(max(v[0], v[1]), max(v[2], v[3])), max(max(v[4], v[5]), max(v[6], v[7])));
                    const int rm = rowmax16i(lm);
#pragma unroll
                    for (int k = 0; k < 8; ++k) if (v[k] == rm) { v[k] = -1; sb |= 1u << k; }
                }
            }
            selb[ps] = sb; }
    }
    LDS_WAIT(); asm volatile("" ::: "memory");
    LAS unsigned char* SELB = wl + 6144;
    SELB[(0 * 4 + kg) * 16 + i] = (unsigned char)selb[0]; SELB[(1 * 4 + kg) * 16 + i] = (unsigned char)selb[1];
    LAS unsigned char* FM = wl + 6272;
    { LDS_WAIT(); asm volatile("" ::: "memory");
#pragma unroll
      for (int hh = 0; hh < 2; ++hh) { const int s = lane + 64 * hh; unsigned m = 0u;
#pragma unroll
          for (int tk = 0; tk < 8; ++tk) m |= (((unsigned)SELB[tk * 16 + (s & 15)] >> (s >> 4)) & 1u) << tk;
          FM[s] = (unsigned char)m; }
      LDS_WAIT(); asm volatile("" ::: "memory"); }
#define PARK_OUT() do { _Pragma("unroll") for (int j = 0; j < 3; ++j) _Pragma("unroll") for (int d = 0; d < 4; ++d) \
        *(LAS u32x2*)(wl + ((j * 4 + d) * 64 + lane) * 8) = (u32x2){cvtpk(out[j][d][0], out[j][d][1]), cvtpk(out[j][d][2], out[j][d][3])}; } while (0)
#define UNPARK(J, D) ({ const u32x2 pk_ = *(LAS const u32x2*)(wl + (((J) * 4 + (D)) * 64 + lane) * 8); (f32x4){bf_lo(pk_.x), bf_hi(pk_.x), bf_lo(pk_.y), bf_hi(pk_.y)}; })
    PARK_OUT();
    {
        ColState sw[3];
#pragma unroll
        for (int j = 0; j < 3; ++j) cs_init(sw[j]);
        const bf16_t* kws = Pb + (size_t)sr * NP + C_KW + kvh * 64 + scc * 8; const bf16_t* vws = G.VTW + ((size_t)bk * 64 + sr) * SEQ + scc * 8;
        const int blo = cur - 8 > 0 ? cur - 8 : 0;
        ring_run(cur - blo + 1, [&](int n) { return kws + (size_t)64 * (blo + n) * NP; }, [&](int n) { return vws + 64 * (blo + n); }, true, [&](int n_, LAS const unsigned char* sl) {
            const int blk = blo + n_;
            LAS const unsigned short* tb = (blk == cur - 8) ? (LAS const unsigned short*)(F.lds + ATT_TBWM) + g * TBWM_SZ - TBWM_LO : TBWg;
            const int hf0 = (blk == cur - 8 && F.wave >= 4) ? 1 : 0, hf1 = (blk == cur && F.wave < 4) ? 1 : 2;
#pragma unroll 1
            for (int hf = hf0; hf < hf1; ++hf) {
                bf16x8 kf2[2][2]; RING_K2(sl, hf, kf2);
                bf16x8 V[4]; RING_V(sl, hf, V);
                LAS const volatile unsigned short* pw[3];
#pragma unroll
                for (int j = 0; j < 3; ++j) { pw[j] = tb + (tcol[j] - 64 * blk - 32 * hf - 4 * kg - 19); asm volatile("" : "+v"(pw[j])); }
                step32<3>(sw, q, kf2[0][0], kf2[0][1], kf2[1][0], kf2[1][1], V, [&](int c, int tile, int r) -> float { return __builtin_bit_cast(float, (unsigned)pw[c][19 - 16 * tile - r] << 16); }); }
        });
#pragma unroll
        for (int j = 0; j < 3; ++j) { const float sc = gate_of(j, 2) / sw[j].la[0];
#pragma unroll
            for (int d = 0; d < 4; ++d) { AUX_STORE(2, j, d, sw[j].o[d] * sc); out[j][d] = UNPARK(j, d) + sw[j].o[d] * sc; } }
    }
    LDS_WAIT(); asm volatile("" ::: "memory");
    PARK_OUT();
    {
        ColState ss[3];
#pragma unroll
        for (int j = 0; j < 3; ++j) cs_init(ss[j]);
        const bf16_t* kgs = Pb + (size_t)sr * NP + C_KS + kvh * 64 + scc * 8; const bf16_t* vgs = G.VTS + ((size_t)bk * 64 + sr) * SEQ + scc * 8;
        ring_run(cur + 1, [&](int n) { return kgs + (size_t)64 * n * NP; }, [&](int n) { return vgs + 64 * n; }, true, [&](int s, LAS const unsigned char* sl) {
            const unsigned fm = __builtin_amdgcn_readfirstlane((unsigned)FM[s]);
            if (fm != 0u) {
                const bool far = (t0 - 64 * s - 63) >= 1513;
                bf16x8 kf[4][2]; RING_K(sl, kf);
                auto ldv = [&](int h, bf16x8 (&VV)[4]) { RING_V(sl, h, VV); };
#pragma unroll
                for (int j = 0; j < 3; ++j) if ((fm >> (3 * j)) & 7u) {
                    const bool colok = cv[j] && ((fm >> (3 * j + i5)) & 1u);
                    f32x2 x[8];
                    const float mref = (ss[j].m == -INFINITY) ? 0.f : ss[j].m;
                    if (far) {
                        const float bc_ = colok ? b31 - mref : -INFINITY;
                        scores64(x, q[j], kf, [&](int, int) -> float { return bc_; });
                    } else {
                        LAS const unsigned char* pb = BKT + (colok ? tcol[j] - 64 * s - 4 * kg : -1) - 51;
                        scores64(x, q[j], kf, [&](int tile, int r) -> float { return BIASg[pb[51 - 16 * tile - r]]; });
#pragma unroll
                        for (int k = 0; k < 8; ++k) { x[k].x -= mref; x[k].y -= mref; }
                    }
                    step64_tail(ss[j], x, ldv);
                }
            }
        });
#pragma unroll
        for (int j = 0; j < 3; ++j) { const float sc = gate_of(j, 1) / ss[j].la[0];
#pragma unroll
            for (int d = 0; d < 4; ++d) { AUX_STORE(1, j, d, ss[j].o[d] * sc); out[j][d] = UNPARK(j, d) + ss[j].o[d] * sc; } }
    }
#pragma unroll
    for (int j = 0; j < 3; ++j) if (cv[j]) { bf16_t* op = G.OMIX + (size_t)(b * SEQ + tcol[j]) * D + 384 + hb * 64 + 4 * kg;
#pragma unroll
        for (int d = 0; d < 4; ++d) *(u32x2*)(op + 16 * d) = (u32x2){cvtpk(out[j][d][0], out[j][d][1]), cvtpk(out[j][d][2], out[j][d][3])}; }
    LDS_WAIT(); asm volatile("" ::: "memory");
#undef PARK_OUT
#undef UNPARK
#undef RING_WRITE
#undef RING_BAR
#undef RING_K
#undef RING_K2
#undef RING_V
}

__device__ __forceinline__ bool mixa_dynamic(int G) { return G % 8 == 0 && G > 64; }
__device__ __forceinline__ int mixa_early(int G) { return G > 64 ? (G - 32) * NWAVES * 4 : 0; }
__device__ __forceinline__ void mixa_run(Frame& F, const AttnG& G, const unsigned* stop, unsigned stopn, bool early_static) {
    LAS const float* TBA = (LAS const float*)(F.lds + ATT_TBA); const int NGW = F.G * NWAVES, total = 4 * 6 * 512;
    if (mixa_dynamic(F.G)) {
        unsigned* qh = (unsigned*)(F.ws + WS_CTL) + CW_MIXQ; const int per = NGW / 8, x0 = (int)(blockIdx.x & 7);
        for (int k = 0; k < 8; ++k) { const int x = (x0 + k) & 7;
            for (;;) { int qi = 0;
                if (F.lane == 0) { const bool go = stop == nullptr || __hip_atomic_load(stop, __ATOMIC_RELAXED, __HIP_MEMORY_SCOPE_AGENT) < stopn;
                    qi = go ? (int)__hip_atomic_fetch_add(qh + 64 * x, 1u, __ATOMIC_RELAXED, __HIP_MEMORY_SCOPE_AGENT) : (1 << 28); }
                qi = __builtin_amdgcn_readfirstlane(qi);
                if (qi >= (1 << 28)) return;
                const int it = (qi / per) * NGW + x * per + (qi % per); if (it >= total) break;
                const int bh = it >> 9, tile = it & 511, b = bh / 6, h = bh - b * 6, r16 = tile & 15, i0 = (tile >> 4) * 16;
                mixa_item(G, TBA + h * TBA_SZ, b, h, r16, i0, F.lane); } }
    } else {
        const int n1 = mixa_early(F.G);
        int it, step, end;
        if (early_static) { it = ((int)blockIdx.x - 32) * NWAVES + F.wave; step = (F.G - 32) * NWAVES; end = n1; } else { it = n1 + F.vcu * NWAVES + F.wave; step = NGW; end = total; }
        for (; it < end; it += step) { const int bh = it >> 9, tile = it & 511, b = bh / 6, h = bh - b * 6, r16 = tile & 15, i0 = (tile >> 4) * 16;
            mixa_item(G, TBA + h * TBA_SZ, b, h, r16, i0, F.lane); }
    }
}
__device__ __forceinline__ void mixa_early_phase(Frame& F) {
    AttnG G{(const bf16_t*)(F.ws + WS_PROJ), (const bf16_t*)(F.ws + WS_KCMP), (const bf16_t*)(F.ws + WS_VCT), (const bf16_t*)(F.ws + WS_VTS), (const bf16_t*)(F.ws + WS_VTW),
            (const bf16_t*)(F.ws + WS_VTA1), (const bf16_t*)(F.ws + WS_VTA4), (const bf16_t*)(F.ws + WS_VTA16), (const bf16_t*)(F.ws + WS_KA1), (const bf16_t*)(F.ws + WS_KA4), (const bf16_t*)(F.ws + WS_KA16), (bf16_t*)(F.ws + WS_XN)};
    attn_tables_mixa(F);
    mixa_run(F, G, (const unsigned*)(F.ws + WS_CTL) + CW_CMPDONE, 32u, true);
}
__device__ __forceinline__ void attn_phase(Frame& F) {
    const int kvh = blockIdx.x & 1;
    AttnG G{(const bf16_t*)(F.ws + WS_PROJ), (const bf16_t*)(F.ws + WS_KCMP), (const bf16_t*)(F.ws + WS_VCT), (const bf16_t*)(F.ws + WS_VTS), (const bf16_t*)(F.ws + WS_VTW),
            (const bf16_t*)(F.ws + WS_VTA1), (const bf16_t*)(F.ws + WS_VTA4), (const bf16_t*)(F.ws + WS_VTA16), (const bf16_t*)(F.ws + WS_KA1), (const bf16_t*)(F.ws + WS_KA4), (const bf16_t*)(F.ws + WS_KA16), (bf16_t*)(F.ws + WS_XN)};
    attn_tables_nsa(F, kvh);
    { for (int idx = (int)(blockIdx.x >> 1); idx < 512; idx += (F.G >> 1)) { const int b = idx >> 7; int grp = idx & 127; if (b & 1) grp = 127 - grp;
          nsa_group(F, G, b, kvh, grp); } }
    __syncthreads();
    attn_tables_mixa(F);
    mixa_run(F, G, nullptr, 0u, false);
}

__device__ __forceinline__ void p7_router(Frame& F) {
    const bf16_t* h = (const bf16_t*)(F.ws + WS_HBF); const float* gffn = F.in[11];
    const bf16_t* wrh = (const bf16_t*)(F.ws + WS_WRH); const bf16_t* wrl = (const bf16_t*)(F.ws + WS_WRL);
    constexpr int WROW = 2128, WHALF = 21 * WROW;
    LAS float* LG = (LAS float*)(F.lds + 2 * WHALF + 128) + F.wave * 512;
    LAS int* CLS = (LAS int*)(F.lds + 2 * WHALF + 128 + 8 * 2048);
    for (int c = F.tid; c < 2 * 21 * 128; c += NTHR) { const int hl = c / (21 * 128), r = (c / 128) % 21, ch = c & 127;
        const u32x4 v = r < 20 ? *(const u32x4*)((hl ? wrl : wrh) + (size_t)r * 1024 + ch * 8) : (u32x4){0u, 0u, 0u, 0u};
        *(LAS u32x4*)(F.lds + hl * WHALF + r * WROW + ch * 16) = v; }
    __syncthreads();
    const int lane = F.lane, tl = lane & 15, kg = lane >> 4;
    const int row1 = tl < 4 ? 16 + tl : 20;
    const int tok0 = blockIdx.x * 128 + F.wave * 16;
    if (tok0 < M) {
        f32x4 acc0 = {0.f, 0.f, 0.f, 0.f}, acc1 = {0.f, 0.f, 0.f, 0.f}; float ss = 0.f;
        const bf16_t* hp = h + (size_t)(tok0 + tl) * D + 8 * kg;
#pragma unroll 4
        for (int ks = 0; ks < 32; ++ks) {
            const u32x4 hw = *(const u32x4*)(hp + 32 * ks); const f32x4 a0 = {bf_lo(hw.x), bf_hi(hw.x), bf_lo(hw.y), bf_hi(hw.y)}, a1 = {bf_lo(hw.z), bf_hi(hw.z), bf_lo(hw.w), bf_hi(hw.w)};
            const f32x4 g0 = *(const f32x4*)(gffn + 32 * ks + 8 * kg), g1 = *(const f32x4*)(gffn + 32 * ks + 8 * kg + 4);
            ss += (a0.x * a0.x + a0.y * a0.y) + (a0.z * a0.z + a0.w * a0.w) + (a1.x * a1.x + a1.y * a1.y) + (a1.z * a1.z + a1.w * a1.w);
            float y[8] = {a0.x * g0.x, a0.y * g0.y, a0.z * g0.z, a0.w * g0.w, a1.x * g1.x, a1.y * g1.y, a1.z * g1.z, a1.w * g1.w};
            unsigned hi[8], lo[8];
#pragma unroll
            for (int j = 0; j < 8; ++j) { hi[j] = f2bf(y[j]); lo[j] = f2bf(y[j] - __builtin_bit_cast(float, hi[j] << 16)); }
            u32x4 ah = {hi[0] | (hi[1] << 16), hi[2] | (hi[3] << 16), hi[4] | (hi[5] << 16), hi[6] | (hi[7] << 16)};
            u32x4 al = {lo[0] | (lo[1] << 16), lo[2] | (lo[3] << 16), lo[4] | (lo[5] << 16), lo[6] | (lo[7] << 16)};
            const bf16x8 Ah = __builtin_bit_cast(bf16x8, ah), Al = __builtin_bit_cast(bf16x8, al);
            const int bo = (32 * ks + 8 * kg) * 2;
            const bf16x8 Bh0 = *(LAS const bf16x8*)(F.lds + tl * WROW + bo), Bh1 = *(LAS const bf16x8*)(F.lds + row1 * WROW + bo), Bl0 = *(LAS const bf16x8*)(F.lds + WHALF + tl * WROW + bo), Bl1 = *(LAS const bf16x8*)(F.lds + WHALF + row1 * WROW + bo);
            acc0 = __builtin_amdgcn_mfma_f32_16x16x32_bf16(Ah, Bh0, acc0, 0, 0, 0); acc0 = __builtin_amdgcn_mfma_f32_16x16x32_bf16(Ah, Bl0, acc0, 0, 0, 0); acc0 = __builtin_amdgcn_mfma_f32_16x16x32_bf16(Al, Bh0, acc0, 0, 0, 0);
            acc1 = __builtin_amdgcn_mfma_f32_16x16x32_bf16(Ah, Bh1, acc1, 0, 0, 0); acc1 = __builtin_amdgcn_mfma_f32_16x16x32_bf16(Ah, Bl1, acc1, 0, 0, 0); acc1 = __builtin_amdgcn_mfma_f32_16x16x32_bf16(Al, Bh1, acc1, 0, 0, 0);
        }
        ss += __shfl_xor(ss, 16); ss += __shfl_xor(ss, 32);
        const float rstd = rsqrtf(ss * (1.f / D) + EPS);
#pragma unroll
        for (int r = 0; r < 4; ++r) { LG[(4 * kg + r) * 32 + tl] = acc0[r]; LG[(4 * kg + r) * 32 + 16 + tl] = acc1[r]; }
        LDS_WAIT(); asm volatile("" ::: "memory");
        if (lane < 16) {
            const float* brg = F.in[13]; const float* bre = F.in[15];
            float gl[4]; int gi = 0;
#pragma unroll
            for (int j = 0; j < 4; ++j) gl[j] = LG[lane * 32 + j] * rstd + brg[j];
#pragma unroll
            for (int j = 1; j < 4; ++j) if (gl[j] > gl[gi]) gi = j;
            float gden = 0.f;
#pragma unroll
            for (int j = 0; j < 4; ++j) gden += __expf(gl[j] - gl[gi]);
            const float gprob = 1.f / gden;
            float el[4];
#pragma unroll
            for (int j = 0; j < 4; ++j) el[j] = LG[lane * 32 + 4 + gi * 4 + j] * rstd + bre[gi * 4 + j];
            int i0 = 0;
#pragma unroll
            for (int j = 1; j < 4; ++j) if (el[j] > el[i0]) i0 = j;
            int i1 = (i0 == 0) ? 1 : 0;
#pragma unroll
            for (int j = 0; j < 4; ++j) if (j != i0 && j != i1 && el[j] > el[i1]) i1 = j;
            const float p0 = 1.f / (1.f + __expf(el[i1] - el[i0])), p1 = 1.f - p0;
            const int a = i0 < i1 ? i0 : i1, bb = i0 < i1 ? i1 : i0;
            const int pair = (a == 0 ? 0 : (a == 1 ? 3 : 5)) + (bb - a - 1);
            const int cls = gi * 6 + pair;
            const float ca = gprob * (i0 == a ? p0 : p1), cb = gprob * (i0 == a ? p1 : p0);
            f32x4 ri; ri.x = __builtin_bit_cast(float, cls); ri.y = rstd; ri.z = ca; ri.w = cb;
            *(f32x4*)(F.ws + WS_RINFO + (size_t)(tok0 + lane) * 16) = ri;
            CLS[F.wave * 16 + lane] = cls;
        }
    }
    __syncthreads();
    if (F.tid < NCLS) { int n = 0; if ((int)blockIdx.x * 128 < M) for (int i = 0; i < 128; ++i) n += (CLS[i] == F.tid); ((int*)(F.ws + WS_CTL) + CW_HIST)[blockIdx.x * NCLS + F.tid] = n; }
    __syncthreads();
}
__device__ __forceinline__ void p8_scatter(Frame& F) {
    moe_tables(F, true);
    LAS int* T = (LAS int*)(F.lds + MISC_OFF);
    LAS int* CLS = (LAS int*)(F.lds + 32768); LAS int* DST = (LAS int*)(F.lds + 32768 + 1024);
    int* rowtok = (int*)(F.ws + WS_ROWTOK); f32x4* rowc = (f32x4*)(F.ws + WS_ROWC);
    const int tok0 = blockIdx.x * 128;
    f32x4 ri = {0.f, 0.f, 0.f, 0.f};
    if (F.tid < 128) { ri = *(const f32x4*)(F.ws + WS_RINFO + (size_t)(tok0 + F.tid) * 16); CLS[F.tid] = __builtin_bit_cast(int, ri.x); }
    __syncthreads();
    if (F.tid < 128) { const int c = CLS[F.tid]; int rank = 0; for (int j = 0; j < F.tid; ++j) rank += (CLS[j] == c);
        const int dst = 256 * T[48 + c] + T[24 + c] + rank; DST[F.tid] = dst; rowtok[dst] = tok0 + F.tid; rowc[dst] = (f32x4){ri.z, ri.w, ri.y, 0.f}; }
    if ((int)blockIdx.x < NCLS) { const int c = blockIdx.x; const int lo = 256 * T[48 + c] + T[c], hi = 256 * T[48 + c + 1]; for (int r = lo + F.tid; r < hi; r += NTHR) { rowtok[r] = -1; rowc[r] = (f32x4){0.f, 0.f, 0.f, 0.f}; } }
}
__device__ __forceinline__ void p11_final(Frame& F) {
    const int gw = F.vcu * NWAVES + F.wave, NGW = F.G * NWAVES; const f32x4* gr = (const f32x4*)F.in[19] + F.lane; f32x4 gg[4];
#pragma unroll
    for (int j = 0; j < 4; ++j) gg[j] = gr[64 * j];
    for (int m0 = gw; m0 < M; m0 += 4 * NGW) {
        f32x4 v[4][4];
#pragma unroll
        for (int r = 0; r < 4; ++r) { const int m = m0 + r * NGW < M ? m0 + r * NGW : m0; const f32x4* xr = (const f32x4*)(F.out + (size_t)m * D) + F.lane;
#pragma unroll
            for (int j = 0; j < 4; ++j) v[r][j] = xr[64 * j]; }
#pragma unroll
        for (int r = 0; r < 4; ++r) { const int m = m0 + r * NGW; float s = 0.f;
#pragma unroll
            for (int j = 0; j < 4; ++j) s += (v[r][j].x * v[r][j].x + v[r][j].y * v[r][j].y) + (v[r][j].z * v[r][j].z + v[r][j].w * v[r][j].w);
            const float rstd = rsqrtf(wave_sum(s) * (1.f / D) + EPS);
            if (m < M) { f32x4* xr = (f32x4*)(F.out + (size_t)m * D) + F.lane;
#pragma unroll
                for (int j = 0; j < 4; ++j) xr[64 * j] = v[r][j] * rstd * gg[j]; } } }
}

constexpr int N_PHASES = 13;
__global__ void __launch_bounds__(NTHR, 2) __attribute__((target("no-packed-fp32-ops"))) mk_fwd(Args args) {
    extern __shared__ __attribute__((aligned(16))) unsigned char lds_raw[];
    Frame F;
    F.lds = (LAS unsigned char*)lds_raw; F.ws = args.ws; F.in = args.in; F.out = args.out;
    F.tid = threadIdx.x; F.lane = F.tid & 63; F.wave = __builtin_amdgcn_readfirstlane(F.tid >> 6);
    F.G = gridDim.x; { const int bx = blockIdx.x; F.vcu = (F.G % 8 == 0) ? (bx % 8) * (F.G / 8) + bx / 8 : bx; }
    volatile LAS unsigned* XBW = (volatile LAS unsigned*)(F.lds + LDS_BYTES - 16);
    if (F.tid < 4) XBW[F.tid] = 0u;
    __syncthreads();
    unsigned* ctl = (unsigned*)(F.ws + WS_CTL);
    const int lo = args.ph_lo, hi = args.ph_hi;
    XcdBarrier bar; bar.bar = ctl + CW_BAR; bar.x = 0; bar.st = XBW;
    if (hi - lo > 1) bar = xcd_barrier_post(ctl + CW_BAR, XBW);
#define IN(k) (lo <= (k) && (k) < hi)
#define SEAM(k) do { if (IN(k) && IN((k) + 1)) xcd_barrier(bar); } while (0)
    unsigned char* ws = F.ws;

    if (IN(0)) { p0_prologue(F); } SEAM(0);
    if (IN(1)) {
        SchedGrid S{(const char*)(ws + WS_XN), (const char*)(ws + WS_WIN), (size_t)256 * 2048, (size_t)256 * 2048, 10, (M / 256) * 10, F.G, F.vcu};
        EpiBf16 E{(bf16_t*)(ws + WS_PROJ), NP};
        pg8::gemm_phase(F.lds, pg8::Geo{2048u, 2048u, 128u, 128u, 16, 1 << 30}, S, E);
        p1_gates(F);
    } SEAM(1);
    if (IN(2)) {
        vt_phase(F, (int)blockIdx.x * NWAVES + F.wave, F.G * NWAVES);
        if (hi - lo > 1) xcd_barrier(bar);
        if (F.G <= 64 || (int)blockIdx.x < 32) {
        { LAS float* cbl = (LAS float*)(F.lds + MISC_OFF + 4096);
          const int kv = F.tid >> 8, j = F.tid & 255; const float* pp = (const float*)(ws + WS_CB1) + (size_t)kv * 64 * 256 + j; float s = 0.f;
#pragma unroll 16
          for (int c = 0; c < 64; ++c) s += pp[c * 256];
          cbl[F.tid] = s; __syncthreads(); }
        SchedCmp1 S{(const bf16_t*)(ws + WS_PROJ), (const bf16_t*)(ws + WS_CW1), F.G, (int)blockIdx.x};
        EpiCmp1 E{(bf16_t*)(ws + WS_H1), (LAS const float*)(F.lds + MISC_OFF + 4096)};
        pg8::gemm_phase(F.lds, pg8::Geo{16u * NP * 2u, 4096u, NP * 2u, 128u, 32, 1 << 30}, S, E);
        asm volatile("s_waitcnt vmcnt(0)" ::: "memory"); __syncthreads();
        for (int L = (int)blockIdx.x; L < 32; L += F.G) { const int kv = L >> 4, kvh = (L >> 3) & 1, b = (L >> 1) & 3, nh = L & 1; const int orow = (kv * 2 + kvh) * 2048 + b * 512 + nh * 256;
            p3_cmp2(F, (orow >> 5) + F.wave, (orow >> 5) + 8, 8); }
        if (F.tid == 0) __hip_atomic_fetch_add((unsigned*)(ws + WS_CTL) + CW_CMPDONE, 1u, __ATOMIC_RELAXED, __HIP_MEMORY_SCOPE_AGENT);
        } else mixa_early_phase(F);
    } SEAM(2);
    if (IN(4)) { attn_phase(F); } SEAM(4);
#if MK_PROBE
    if (IN(5)) { if (MK_PROBE & 1) nv_mixer_a(F); if (MK_PROBE & 6) nv_nsa_a(F); } SEAM(5);
    if (IN(6)) { if (MK_PROBE & 6) nv_nsa_b(F); } SEAM(6);
#endif
    if (IN(7)) {
        SchedGrid S{(const char*)(ws + WS_XN), (const char*)(ws + WS_WOUT), (size_t)256 * 2048, (size_t)256 * 2048, 4, (M / 256) * 4, F.G, F.vcu};
        EpiWout E{F.in[0], (bf16_t*)(ws + WS_HBF)};
        pg8::gemm_phase(F.lds, pg8::Geo{2048u, 2048u, 128u, 128u, 16, 1 << 30}, S, E);
    } SEAM(7);
    if (IN(8)) { p7_router(F); } SEAM(8);
    if (IN(9)) { p8_scatter(F); } SEAM(9);
    if (IN(10)) {
        moe_tables(F, false);
        LAS int* T = (LAS int*)(F.lds + MISC_OFF); unsigned* ready = (unsigned*)(ws + WS_CTL) + CW_READY;
        { SchedUp S{(const char*)(ws + WS_HBF), (const char*)(ws + WS_WGU), T, F.G, F.vcu, (const int*)(ws + WS_ROWTOK)};
          EpiUp E{(bf16_t*)(ws + WS_PROJ), (const f32x4*)(ws + WS_ROWC), ready};
          pg8::gemm_phase<true>(F.lds, pg8::Geo{2048u, 2048u, 128u, 128u, 16, 1 << 30}, S, E); }
        __syncthreads();
        { const int nup = __builtin_amdgcn_readfirstlane(T[48 + NCLS]) * 8; int c = (F.vcu - nup) % F.G; if (c < 0) c += F.G;
          SchedDown S{(const char*)(ws + WS_PROJ), (const char*)(ws + WS_WD), T, F.G, c, ready};
          EpiDownNorm E{F.out, (const bf16_t*)(ws + WS_HBF), (const int*)(ws + WS_ROWTOK), F.in[19], (float*)(ws + WS_XBUF), (unsigned*)(ws + WS_CTL) + CW_PANEL, F.lds + MISC_OFF + 8192};
          pg8::gemm_phase(F.lds, pg8::Geo{2048u, 1024u, 128u, 128u, 16, 8}, S, E); }
    }
#undef IN
#undef SEAM
}

extern "C" void kernel_launch(void* const* d_in, const int* in_sizes, int n_in, void* d_out, int out_size, void* d_ws, size_t ws_size, hipStream_t stream) {
    static int grid = 0;
    if (grid == 0) {
        if (n_in != 20 || in_sizes[0] != M * D || out_size != M * D || ws_size < WS_END) { fprintf(stderr, "kernel_launch: unexpected shapes (n_in %d, in0 %d, out %d, ws %zu); nothing launched\n", n_in, n_in > 0 ? in_sizes[0] : -1, out_size, ws_size); grid = -1; return; }
        int dev = 0, cus = 0, per_cu = 0;
        if (hipGetDevice(&dev) != hipSuccess || hipDeviceGetAttribute(&cus, hipDeviceAttributeMultiprocessorCount, dev) != hipSuccess) { grid = -1; return; }
        if (hipFuncSetAttribute((const void*)mk_fwd, hipFuncAttributeMaxDynamicSharedMemorySize, LDS_BYTES) != hipSuccess) { fprintf(stderr, "kernel_launch: hipFuncSetAttribute failed\n"); grid = -1; return; }
        if (hipOccupancyMaxActiveBlocksPerMultiprocessor(&per_cu, (const void*)mk_fwd, NTHR, LDS_BYTES) != hipSuccess || per_cu < 1) fprintf(stderr, "kernel_launch: occupancy query reports %d\n", per_cu);
        (void)hipGetLastError();
        grid = cus;
        if (grid > 256) grid = 256;
    }
    if (grid < 0) return;
    (void)hipMemsetAsync((char*)d_ws + WS_CTL, 0, CTL_ZERO_BYTES, stream);
    Args a{};
    for (int i = 0; i < 20; ++i) a.in[i] = (const float*)d_in[i];
    a.out = (float*)d_out; a.ws = (unsigned char*)d_ws;
#if MK_N_LAUNCHES == 1
    a.ph_lo = 0; a.ph_hi = N_PHASES;
    hipLaunchKernelGGL(mk_fwd, dim3(grid), dim3(NTHR), LDS_BYTES, stream, a);
#else
    for (int p = 0; p < N_PHASES; ++p) { a.ph_lo = p; a.ph_hi = p + 1; hipLaunchKernelGGL(mk_fwd, dim3(grid), dim3(NTHR), LDS_BYTES, stream, a); }
#endif
}
```

```cpp
#include <hip/hip_runtime.h>
#include <cstdio>
#include <cstdint>

#ifndef MK_N_LAUNCHES
#define MK_N_LAUNCHES 1
#endif

typedef unsigned short bf16_t;
typedef short bf16x8 __attribute__((ext_vector_type(8)));
typedef float f32x4 __attribute__((ext_vector_type(4)));
typedef float f32x2 __attribute__((ext_vector_type(2)));
typedef float f32x16 __attribute__((ext_vector_type(16)));
typedef unsigned u32x4 __attribute__((ext_vector_type(4)));
typedef unsigned u32x2 __attribute__((ext_vector_type(2)));
#define LAS __attribute__((address_space(3)))
#define GAS __attribute__((address_space(1)))

constexpr int BATCH = 4, SEQ = 8192, M = BATCH * SEQ, D = 1024, NIN = 2590, NP = 2816;
constexpr int C_QA = 0, C_KA = 384, C_VA = 768, C_QB = 1152, C_KCT = 1792, C_VCT = 1920, C_KS = 2048, C_VS = 2176, C_KW = 2304, C_VW = 2432, C_GT = 2560;
constexpr int NCMP = 511;
constexpr float EPS = 1e-6f;
constexpr int NCLS = 24, MAXTILES = 152;
constexpr int NWAVES = 8, NTHR = 512;

constexpr size_t MiB = 1u << 20;
constexpr size_t WS_CTL = 0, CTL_ZERO_BYTES = 1 * MiB;
constexpr size_t WS_WIN = 2 * MiB;
constexpr size_t WS_WOUT = 8 * MiB;
constexpr size_t WS_CW1 = 10 * MiB;
constexpr size_t WS_CW2 = 12 * MiB;
constexpr size_t WS_CB1 = 12 * MiB + 256 * 1024;
constexpr size_t WS_WRH = 12 * MiB + 512 * 1024;
constexpr size_t WS_WRL = 12 * MiB + 640 * 1024;
constexpr size_t WS_RINFO = 13 * MiB;
constexpr size_t WS_ROWTOK = 13 * MiB + 512 * 1024;
constexpr size_t WS_ROWC = 14 * MiB;
constexpr size_t WS_WGU = 16 * MiB;
constexpr size_t WS_WD = 48 * MiB;
constexpr size_t WS_XN = 64 * MiB;
constexpr size_t WS_PROJ = 144 * MiB;
constexpr size_t WS_H1 = 322 * MiB;
constexpr size_t WS_KCMP = 326 * MiB;
constexpr size_t WS_VCMP = 326 * MiB + 512 * 1024;
constexpr size_t WS_IMP = 328 * MiB;
constexpr size_t WS_SEL = 360 * MiB;
constexpr size_t WS_MD = 364 * MiB;
constexpr size_t WS_VTS = 368 * MiB;
constexpr size_t WS_VTW = 376 * MiB;
constexpr size_t WS_VTA1 = 384 * MiB;
constexpr size_t WS_VTA4 = 408 * MiB;
constexpr size_t WS_VTA16 = 432 * MiB;
constexpr size_t WS_VCT = 456 * MiB;
constexpr size_t WS_KA1 = 328 * MiB;
constexpr size_t WS_ML = 457 * MiB;
constexpr size_t WS_KA4 = 457 * MiB;
constexpr size_t WS_KA16 = 481 * MiB;
constexpr size_t WS_CPART = 384 * MiB;
constexpr size_t WS_HBF = 224 * MiB;
constexpr size_t WS_GATES = 505 * MiB;
constexpr size_t WS_END = 507 * MiB;

constexpr int CW_BAR = 4096;
constexpr int CW_HIST = 65536;
constexpr int CW_READY = 196608;
constexpr int CW_CMPDONE = 213760;
constexpr int CW_CPART = 216320;
constexpr int CW_CVTQ = 215552;
constexpr int CW_MIXQ2 = 214528;
constexpr int CW_MIXQ = 212992;
constexpr int CW_PANEL = 131072;
constexpr size_t WS_XBUF = 15 * MiB;

constexpr int RING_BYTES = 131072;
constexpr int MISC_OFF = RING_BYTES;
constexpr int LDS_BYTES = 163840;

__device__ __forceinline__ unsigned f2bf(float f) { unsigned u = __builtin_bit_cast(unsigned, f); return (u + 0x7fffu + ((u >> 16) & 1u)) >> 16; }
__device__ __forceinline__ unsigned pk2(float lo, float hi) { return f2bf(lo) | (f2bf(hi) << 16); }
__device__ __forceinline__ float bf_lo(unsigned w) { return __builtin_bit_cast(float, w << 16); }
__device__ __forceinline__ float bf_hi(unsigned w) { return __builtin_bit_cast(float, w & 0xffff0000u); }
__device__ __forceinline__ float bf2f(bf16_t h) { return __builtin_bit_cast(float, (unsigned)h << 16); }
#define LDS_WAIT() asm volatile("s_waitcnt lgkmcnt(0)" ::: "memory")
#define VM_WAIT() asm volatile("s_waitcnt vmcnt(0)" ::: "memory")

__device__ __forceinline__ int t5_bucket(int dist) {
    if (dist < 16) return dist < 0 ? 0 : dist;
    int b = 16;
    b += dist >= 22; b += dist >= 30; b += dist >= 40; b += dist >= 54; b += dist >= 73; b += dist >= 99; b += dist >= 134; b += dist >= 182;
    b += dist >= 246; b += dist >= 332; b += dist >= 450; b += dist >= 609; b += dist >= 825; b += dist >= 1117; b += dist >= 1513;
    return b;
}
__device__ __forceinline__ float gelu_tanh(float x) {
    const float u = 0.7978845608028654f * (x + 0.044715f * x * x * x);
    const float e = __expf(2.f * u);
    const float th = 1.f - 2.f / (e + 1.f);
    return 0.5f * x * (1.f + th);
}

namespace pg8 {
constexpr int BM = 256, BK = 64, HALF = 128, HTB = HALF * BK * 2;
__host__ __device__ __forceinline__ int lds_byte(int r, int c) { const int st = (r >> 4) * 2 + (c >> 5), rr = r & 15, cc = c & 31, ob = rr * 64 + cc * 2; return st * 1024 + (ob ^ (((ob >> 9) & 1) << 5)); }
__host__ __device__ __forceinline__ void stage_rc(int b, int& R, int& C) { const int st = b / 1024, sb = b % 1024, swz = sb ^ (((sb >> 9) & 1) << 5); R = (st >> 1) * 16 + swz / 64; C = (st & 1) * 32 + (swz % 64) / 2; }
__host__ __device__ __forceinline__ int perm32(int rho) { const int n = rho >> 4, i = rho & 15; return 8 * (i >> 2) + 4 * n + (i & 3); }

struct Unit { const char* a; const char* b; long bjump; int orow, ocol, aux; const int* rows; };
struct Geo { unsigned lda, ldb, kstepA, kstepB; int nt, tjump; };

template <bool GATHER = false, class Epi, class Sched>
__device__ __forceinline__ void gemm_phase(LAS unsigned char* lds, const Geo g, const Sched& S, const Epi& E) {
    const int tid = threadIdx.x, wid = __builtin_amdgcn_readfirstlane(tid >> 6), lane = tid & 63, wr = wid >> 2, wc = wid & 3, fr = lane & 15, fq = lane >> 4;
    const int nt = g.nt;
    unsigned voffA[2], voffB[2];
#pragma unroll
    for (int i = 0; i < 2; ++i) { int R, C; stage_rc(tid * 16 + i * 8192, R, C); const int Rb = (R & ~31) + perm32(R & 31);
        voffA[i] = (unsigned)R * g.lda + (unsigned)C * 2u; voffB[i] = (unsigned)Rb * g.ldb + (unsigned)C * 2u; }
    unsigned gA[2][2] = {{0u, 0u}, {0u, 0u}}, ngA[2][2] = {{0u, 0u}, {0u, 0u}};
    auto gather_of = [&](const Unit& u, unsigned (&o)[2][2]) {
#pragma unroll
        for (int i = 0; i < 2; ++i) { int R, C; stage_rc(tid * 16 + i * 8192, R, C);
#pragma unroll
            for (int h = 0; h < 2; ++h) { const int t = u.rows[h * HALF + R]; o[h][i] = (unsigned)(t < 0 ? 0 : t) * g.lda + (unsigned)C * 2u; } } };
    const size_t kA = g.kstepA, kB = g.kstepB;
    const size_t hA = (size_t)HALF * g.lda, hB = (size_t)HALF * g.ldb;
    const unsigned ldsw = (unsigned)wid * 1024u;
    const int aoff = lds_byte(wr * 64 + fr, fq * 8), boff = lds_byte(wc * 32 + fr, fq * 8);
#define PG8_SA(b, h) (((b) * 2 + (h)) * HTB)
#define PG8_SB(b, h) ((4 + (b) * 2 + (h)) * HTB)
#define PG8_STAGE(bufoff, gbase, voff) do { _Pragma("unroll") for (int _i = 0; _i < 2; ++_i) \
        __builtin_amdgcn_global_load_lds((const unsigned*)((const char*)(gbase) + (voff)[_i]), (LAS unsigned*)(lds + (bufoff) + ldsw + _i * 8192), 16, 0, 0); } while (0)
#define PG8_STAGE_A(bufoff, h, gbase, VO) do { if (GATHER) { _Pragma("unroll") for (int _i = 0; _i < 2; ++_i) \
        __builtin_amdgcn_global_load_lds((const unsigned*)((const char*)(gbase) + (VO)[h][_i]), (LAS unsigned*)(lds + (bufoff) + ldsw + _i * 8192), 16, 0, 0); } else PG8_STAGE(bufoff, (gbase) + (h) * hA, voffA); } while (0)
#define PG8_LDA(dst, b, h) do { _Pragma("unroll") for (int m = 0; m < 4; ++m) _Pragma("unroll") for (int k = 0; k < 2; ++k) dst[m][k] = *(const LAS bf16x8*)(lds + PG8_SA(b, h) + aoff + m * 2048 + k * 1024); } while (0)
#define PG8_LDB(dst, b, h) do { _Pragma("unroll") for (int n = 0; n < 2; ++n) _Pragma("unroll") for (int k = 0; k < 2; ++k) dst[n][k] = *(const LAS bf16x8*)(lds + PG8_SB(b, h) + boff + n * 2048 + k * 1024); } while (0)
#define PG8_MMA(ai, bj, At, Bt) do { __builtin_amdgcn_s_setprio(1); _Pragma("unroll") for (int m = 0; m < 4; ++m) _Pragma("unroll") for (int n = 0; n < 2; ++n) _Pragma("unroll") for (int k = 0; k < 2; ++k) \
        acc[ai][bj][m][n] = __builtin_amdgcn_mfma_f32_16x16x32_bf16(Bt[n][k], At[m][k], acc[ai][bj][m][n], 0, 0, 0); __builtin_amdgcn_s_setprio(0); } while (0)
#define PG8_WAIT_V(n) asm volatile("s_waitcnt vmcnt(" #n ")" ::: "memory")
#define PG8_WAIT_L(n) asm volatile("s_waitcnt lgkmcnt(" #n ")" ::: "memory")
#define PG8_BAR __builtin_amdgcn_s_barrier()
#define PG8_SCHED __builtin_amdgcn_sched_barrier(0)
#define PG8_BP(base, jump, t) ((base) + (size_t)(t) * kB + (((t) >= g.tjump) ? (jump) : 0l))
    Unit cur, nxt; int ui = 0;
    if (!S.next(0, cur)) return;
    f32x4 acc[2][2][4][2];
#pragma unroll
    for (int a = 0; a < 2; ++a)
#pragma unroll
        for (int b = 0; b < 2; ++b)
#pragma unroll
            for (int m = 0; m < 4; ++m)
#pragma unroll
                for (int n = 0; n < 2; ++n) acc[a][b][m][n] = (f32x4){0.f, 0.f, 0.f, 0.f};
    bf16x8 At[4][2], B0[2][2], B1[2][2];
    const char* cA = cur.a; const char* cB = cur.b; long cJ = cur.bjump;
    S.a_ready(cur);
    if (GATHER) gather_of(cur, gA);
    PG8_STAGE(PG8_SB(0, 0), cB, voffB); PG8_STAGE(PG8_SB(0, 1), cB + hB, voffB); PG8_STAGE_A(PG8_SA(0, 0), 0, cA, gA); PG8_STAGE_A(PG8_SA(0, 1), 1, cA, gA);
    if (wr == 1) PG8_BAR;
    PG8_WAIT_V(2); PG8_BAR;
    PG8_STAGE(PG8_SB(1, 0), cB + kB, voffB); PG8_STAGE_A(PG8_SA(1, 0), 0, cA + kA, gA); PG8_STAGE(PG8_SB(1, 1), cB + hB + kB, voffB);
    PG8_WAIT_V(6); PG8_BAR;
    for (;;) {
        const bool has_next = S.next(ui + 1, nxt);
        const char* nA = has_next ? nxt.a : cA; const char* nB = has_next ? nxt.b : cB;
        if (GATHER) { if (has_next) gather_of(nxt, ngA); else {
#pragma unroll
            for (int h = 0; h < 2; ++h) { ngA[h][0] = gA[h][0]; ngA[h][1] = gA[h][1]; } } }
        for (int t = 0; t < nt; t += 2) {
            const bool last = (t == nt - 2);
            const char* a1 = cA + (size_t)(t + 1) * kA;
            const char* a2 = last ? nA : cA + (size_t)(t + 2) * kA; const char* b2 = last ? nB : PG8_BP(cB, cJ, t + 2);
            const char* a3 = a2 + kA; const char* b3 = b2 + kB;
            unsigned g2[2][2];
#pragma unroll
            for (int h = 0; h < 2; ++h) { g2[h][0] = last ? ngA[h][0] : gA[h][0]; g2[h][1] = last ? ngA[h][1] : gA[h][1]; }
            if (last && has_next) S.a_ready(nxt);
            PG8_LDB(B0, 0, 0); PG8_LDB(B1, 0, 1); PG8_SCHED; PG8_LDA(At, 0, 0); PG8_STAGE_A(PG8_SA(1, 1), 1, a1, gA);
            PG8_WAIT_V(8); PG8_WAIT_L(0); PG8_BAR; PG8_MMA(0, 0, At, B0); PG8_MMA(0, 1, At, B1); PG8_BAR; PG8_SCHED;
            PG8_LDA(At, 0, 1); PG8_STAGE(PG8_SB(0, 0), b2, voffB); PG8_STAGE(PG8_SB(0, 1), b2 + hB, voffB); PG8_STAGE_A(PG8_SA(0, 0), 0, a2, g2);
            PG8_WAIT_V(8); PG8_WAIT_L(0); PG8_BAR; PG8_MMA(1, 0, At, B0); PG8_MMA(1, 1, At, B1); PG8_BAR; PG8_SCHED;
            PG8_LDB(B0, 1, 0); PG8_LDB(B1, 1, 1); PG8_SCHED; PG8_LDA(At, 1, 0); PG8_STAGE_A(PG8_SA(0, 1), 1, a2, g2);
            PG8_WAIT_V(8); PG8_WAIT_L(0); PG8_BAR; PG8_MMA(0, 0, At, B0); PG8_MMA(0, 1, At, B1); PG8_BAR; PG8_SCHED;
            PG8_LDA(At, 1, 1); PG8_STAGE(PG8_SB(1, 0), b3, voffB); PG8_STAGE(PG8_SB(1, 1), b3 + hB, voffB); PG8_STAGE_A(PG8_SA(1, 0), 0, a3, g2);
            PG8_WAIT_V(8); PG8_WAIT_L(0); PG8_BAR; PG8_MMA(1, 0, At, B0); PG8_MMA(1, 1, At, B1); PG8_BAR; PG8_SCHED;
        }
        if (wr == 0) PG8_BAR;
        E(acc, cur, wr, wc, fr, fq);
        if (!has_next) break;
#pragma unroll
        for (int a = 0; a < 2; ++a)
#pragma unroll
            for (int b = 0; b < 2; ++b)
#pragma unroll
                for (int m = 0; m < 4; ++m)
#pragma unroll
                    for (int n = 0; n < 2; ++n) acc[a][b][m][n] = (f32x4){0.f, 0.f, 0.f, 0.f};
        cur = nxt; cA = nA; cB = nB; cJ = nxt.bjump; ++ui;
        if (GATHER) {
#pragma unroll
            for (int h = 0; h < 2; ++h) { gA[h][0] = ngA[h][0]; gA[h][1] = ngA[h][1]; } }
        if (wr == 1) PG8_BAR;
    }
    PG8_WAIT_V(0);
    PG8_BAR;
#undef PG8_SA
#undef PG8_SB
#undef PG8_STAGE
#undef PG8_STAGE_A
#undef PG8_LDA
#undef PG8_LDB
#undef PG8_MMA
#undef PG8_WAIT_V
#undef PG8_WAIT_L
#undef PG8_BAR
#undef PG8_SCHED
#undef PG8_BP
}
}

#define XB_TMO      128
#define XB_XCNT(j)  (256  + 64 * (j))
#define XB_XSUB(j)  (1280 + 64 * (j))
#define XB_XGEN(j)  (2304 + 64 * (j))
#define XB_TOP      3328
#define XB_TOPGEN   3392
#define XCD_BAR_WORDS 3456
#define XB_SPIN_CAP (1u << 18)
__device__ __forceinline__ unsigned xb_ld(unsigned* p)              { return __hip_atomic_load(p, __ATOMIC_RELAXED, __HIP_MEMORY_SCOPE_AGENT); }
__device__ __forceinline__ unsigned xb_add(unsigned* p, unsigned v) { return __hip_atomic_fetch_add(p, v, __ATOMIC_RELAXED, __HIP_MEMORY_SCOPE_AGENT); }
__device__ __forceinline__ unsigned xb_xcc_id() { return (unsigned)__builtin_amdgcn_s_getreg((3 << 11) | 20) & 0xFu; }
#define XB_SPIN(cond, bar) do { unsigned _sp = 0; while (cond) { __builtin_amdgcn_s_sleep(1); \
    if ((++_sp & 255u) == 0u) { if (xb_ld(&(bar)[XB_TMO])) break; if (_sp > XB_SPIN_CAP) { atomicAdd(&(bar)[XB_TMO], 1u); break; } } } } while (0)
struct XcdBarrier { unsigned* bar; unsigned x; volatile LAS unsigned* st; };
__device__ __forceinline__ XcdBarrier xcd_barrier_post(unsigned* bar, volatile LAS unsigned* st) {
    XcdBarrier b; b.bar = bar; b.x = xb_xcc_id(); b.st = st;
    if (threadIdx.x == 0) (void)xb_add(&bar[XB_XCNT(b.x)], 1u);
    return b;
}
__device__ __forceinline__ void xcd_barrier_complete(unsigned* bar, unsigned x, unsigned& nloc, unsigned& nx) {
    const unsigned G = gridDim.x * gridDim.y * gridDim.z;
    unsigned sum, cnt, mine, sp = 0u;
    for (;;) {
        sum = 0u; cnt = 0u; mine = 0u;
#pragma unroll
        for (unsigned j = 0; j < 16; ++j) { const unsigned c = xb_ld(&bar[XB_XCNT(j)]); sum += c; cnt += (c > 0u) ? 1u : 0u; mine = (j == x) ? c : mine; }
        if (sum == G) break;
        __builtin_amdgcn_s_sleep(1);
        if ((++sp & 255u) == 0u) { if (xb_ld(&bar[XB_TMO])) break; if (sp > XB_SPIN_CAP) { atomicAdd(&bar[XB_TMO], 1u); break; } }
    }
    nloc = mine > 0u ? mine : 1u; nx = cnt > 0u ? cnt : 1u;
}
__device__ __forceinline__ void xcd_barrier(const XcdBarrier& b) {
    asm volatile("s_waitcnt vmcnt(0)" ::: "memory");
    __syncthreads();
    if (threadIdx.x == 0) {
        unsigned* bar = b.bar;
        __builtin_amdgcn_s_waitcnt(0);
        unsigned nloc = b.st[0], nx = b.st[1];
        if (nloc == 0u) { xcd_barrier_complete(bar, b.x, nloc, nx); b.st[0] = nloc; b.st[1] = nx; }
        const unsigned old = xb_add(&bar[XB_XSUB(b.x)], 1u);
        const unsigned gen = old / nloc;
        if (old + 1u == (gen + 1u) * nloc) {
            __builtin_amdgcn_fence(__ATOMIC_RELEASE, "agent");
            asm volatile("s_waitcnt vmcnt(0)" ::: "memory");
            const unsigned og = xb_add(&bar[XB_TOP], 1u);
            const unsigned tg = og / nx;
            if (og + 1u == (tg + 1u) * nx) xb_add(&bar[XB_TOPGEN], 1u);
            else XB_SPIN(xb_ld(&bar[XB_TOPGEN]) == tg, bar);
            __builtin_amdgcn_fence(__ATOMIC_ACQUIRE, "agent");
            xb_add(&bar[XB_XGEN(b.x)], 1u);
            asm volatile("s_waitcnt vmcnt(0)" ::: "memory");
        } else {
            XB_SPIN(xb_ld(&bar[XB_XGEN(b.x)]) == gen, bar);
            __builtin_amdgcn_fence(__ATOMIC_ACQUIRE, "agent");
            asm volatile("s_waitcnt vmcnt(0)" ::: "memory");
        }
    }
    __syncthreads();
}

struct Args { const float* in[20]; float* out; unsigned char* ws; int ph_lo, ph_hi; };

struct Frame {
    LAS unsigned char* lds;
    unsigned char* ws;
    const float* const* in;
    float* out;
    int tid, lane, wave, vcu, G;
};

__device__ __forceinline__ float wave_sum(float v) {
#pragma unroll
    for (int o = 1; o < 64; o <<= 1) v += __shfl_xor(v, o);
    return v;
}

struct TrDesc { const float* W; bf16_t* WT; int N, nvalid, dpitch, rowbase, blk, blkstride, kb, nb; const float* kg; };
__device__ __forceinline__ void tr_load(f32x4 (&v)[8], const TrDesc& d, int lane) {
    const int k0 = 64 * d.kb, n = 32 * d.nb + (lane & 7) * 4;
#pragma unroll
    for (int i = 0; i < 8; ++i) { const int kk = 8 * i + (lane >> 3); const float* p = d.W + (size_t)(k0 + kk) * d.N + n;
        if (n + 3 < d.nvalid) v[i] = *(const f32x4*)p; else { v[i].x = n < d.nvalid ? p[0] : 0.f; v[i].y = n + 1 < d.nvalid ? p[1] : 0.f; v[i].z = n + 2 < d.nvalid ? p[2] : 0.f; v[i].w = 0.f; } }
}
__device__ __forceinline__ void tr_finish(const f32x4 (&v)[8], const TrDesc& d, LAS float* scr, int lane) {
    const int k0 = 64 * d.kb, n0 = 32 * d.nb, c4 = (lane & 7) * 4;
#pragma unroll
    for (int i = 0; i < 8; ++i) { const int kk = 8 * i + (lane >> 3); LAS float* q = scr + kk * 33 + c4; const float gk = d.kg ? d.kg[k0 + kk] : 1.f; q[0] = v[i].x * gk; q[1] = v[i].y * gk; q[2] = v[i].z * gk; q[3] = v[i].w * gk; }
    LDS_WAIT(); asm volatile("" ::: "memory");
    const int c = lane & 7;
#pragma unroll
    for (int j = 0; j < 4; ++j) { const int nl = (lane >> 3) + 8 * j; const int n = n0 + nl; const LAS float* s = scr + (8 * c) * 33 + nl;
        const int drow = d.rowbase + (n / d.blk) * d.blkstride + (n % d.blk);
        u32x4 o; o.x = pk2(s[0 * 33], s[1 * 33]); o.y = pk2(s[2 * 33], s[3 * 33]); o.z = pk2(s[4 * 33], s[5 * 33]); o.w = pk2(s[6 * 33], s[7 * 33]);
        *(u32x4*)(d.WT + (size_t)drow * d.dpitch + k0 + 8 * c) = o; }
    LDS_WAIT(); asm volatile("" ::: "memory");
}

__device__ __forceinline__ void rms_row_to_bf16(const float* xrow, const float* gain, bf16_t* orow, int lane) {
    const f32x4* xr = (const f32x4*)xrow + lane; const f32x4* gr = (const f32x4*)gain + lane;
    f32x4 v[4]; float s = 0.f;
#pragma unroll
    for (int j = 0; j < 4; ++j) { v[j] = xr[64 * j]; s += (v[j].x * v[j].x + v[j].y * v[j].y) + (v[j].z * v[j].z + v[j].w * v[j].w); }
    const float rstd = rsqrtf(wave_sum(s) * (1.f / D) + EPS);
    unsigned long long* o8 = (unsigned long long*)orow + lane;
#pragma unroll
    for (int j = 0; j < 4; ++j) { const f32x4 g = gr[64 * j];
        o8[64 * j] = (unsigned long long)pk2(v[j].x * rstd * g.x, v[j].y * rstd * g.y) | ((unsigned long long)pk2(v[j].z * rstd * g.z, v[j].w * rstd * g.w) << 32); }
}

constexpr int MOE_I_GU = 16 * 16, MOE_I_DN = 8 * 32, MOE_ITEMS = 32 * MOE_I_GU + 16 * MOE_I_DN, MOE_PER_Q = MOE_ITEMS / 8;
__device__ __forceinline__ bool moe_cvt_late(int G) { return false; }
__device__ __forceinline__ bool moe_cvt_late_unused(int G) { return G % 8 == 0 && G > 64; }
__device__ __forceinline__ TrDesc moe_trdesc(const Frame& F, int r) {
    unsigned char* ws = F.ws;
    if (r < 32 * MOE_I_GU) { const int eu = r / MOE_I_GU; r -= eu * MOE_I_GU; const int e = eu >> 1, up = eu & 1;
        return TrDesc{F.in[up ? 17 : 16] + (size_t)e * 1024 * 512, (bf16_t*)(ws + WS_WGU), 512, 512, 1024, e * 1024 + up * 128, 128, 256, r / 16, r % 16, F.in[11]}; }
    r -= 32 * MOE_I_GU;
    const int e = r / MOE_I_DN; r -= e * MOE_I_DN;
    return TrDesc{F.in[18] + (size_t)e * 512 * 1024, (bf16_t*)(ws + WS_WD) + (size_t)e * 1024 * 512, 1024, 1024, 512, 0, 1 << 30, 0, r / 32, r % 32, nullptr};
}
__device__ __forceinline__ void p0_prologue(Frame& F) {
    LAS float* scr = (LAS float*)(F.lds + F.wave * 16384);
    const int gw = F.vcu * NWAVES + F.wave, NGW = F.G * NWAVES;
    unsigned char* ws = F.ws;
    constexpr int I_WIN = 16 * 88, I_WOUT = 16 * 32, I_CW1 = 32 * 8, I_CW2 = 4 * 2, I_GU = 16 * 16, I_DN = 8 * 32;
    const int NITEMS = I_WIN + I_WOUT + 2 * I_CW1 + 2 * I_CW2 + (moe_cvt_late(F.G) ? 0 : 32 * I_GU + 16 * I_DN);
    auto describe = [&](int it) -> TrDesc { int r = it < NITEMS ? it : NITEMS - 1;
        if (r < I_WIN) return TrDesc{F.in[3], (bf16_t*)(ws + WS_WIN), NIN, NIN, 1024, 0, 1 << 30, 0, r / 88, r % 88, nullptr}; r -= I_WIN;
        if (r < I_WOUT) return TrDesc{F.in[4], (bf16_t*)(ws + WS_WOUT), 1024, 1024, 1024, 0, 1 << 30, 0, r / 32, r % 32, nullptr}; r -= I_WOUT;
        if (r < 2 * I_CW1) { const int kv = r / I_CW1; r -= kv * I_CW1; return TrDesc{F.in[kv ? 9 : 7], (bf16_t*)(ws + WS_CW1) + (size_t)kv * 256 * 2048, 256, 256, 2048, 0, 1 << 30, 0, r / 8, r % 8, nullptr}; } r -= 2 * I_CW1;
        if (r < 2 * I_CW2) { const int kv = r / I_CW2; r -= kv * I_CW2; return TrDesc{F.in[kv ? 10 : 8], (bf16_t*)(ws + WS_CW2) + (size_t)kv * 64 * 256, 64, 64, 256, 0, 1 << 30, 0, r / 2, r % 2, nullptr}; } r -= 2 * I_CW2;
        if (r < 32 * I_GU) { const int eu = r / I_GU; r -= eu * I_GU; const int e = eu >> 1, up = eu & 1;
            return TrDesc{F.in[up ? 17 : 16] + (size_t)e * 1024 * 512, (bf16_t*)(ws + WS_WGU), 512, 512, 1024, e * 1024 + up * 128, 128, 256, r / 16, r % 16, F.in[11]}; } r -= 32 * I_GU;
        { const int e = r / I_DN; r -= e * I_DN;
            return TrDesc{F.in[18] + (size_t)e * 512 * 1024, (bf16_t*)(ws + WS_WD) + (size_t)e * 1024 * 512, 1024, 1024, 512, 0, 1 << 30, 0, r / 32, r % 32, nullptr}; } };
    { TrDesc d0 = describe(gw); f32x4 v0[8]; if (gw < NITEMS) tr_load(v0, d0, F.lane);
#pragma unroll 1
      for (int it = gw; it < NITEMS; it += NGW) { const TrDesc d1 = describe(it + NGW); f32x4 v1[8]; tr_load(v1, d1, F.lane);
          tr_finish(v0, d0, scr, F.lane); d0 = d1;
#pragma unroll
          for (int i = 0; i < 8; ++i) v0[i] = v1[i]; } }
    { bf16_t* wrh = (bf16_t*)(ws + WS_WRH); bf16_t* wrl = (bf16_t*)(ws + WS_WRL);
      for (int i = blockIdx.x * NTHR + F.tid; i < 32 * 1024; i += F.G * NTHR) { const int c = i >> 10, k = i & 1023;
          float w = 0.f; if (c < 4) w = F.in[12][k * 4 + c]; else if (c < 20) w = F.in[14][k * 16 + (c - 4)];
          const unsigned h = f2bf(w); const float hf = __builtin_bit_cast(float, h << 16); wrh[i] = (bf16_t)h; wrl[i] = (bf16_t)f2bf(w - hf); } }
    if ((int)blockIdx.x < 64) { const int kv = blockIdx.x >> 5, chunk = blockIdx.x & 31, j = F.tid & 255, half = F.tid >> 8; const float* pos = F.in[kv ? 6 : 5]; const float* w1 = F.in[kv ? 9 : 7];
        const int i0 = chunk * 64 + half * 32; float s = 0.f;
#pragma unroll
        for (int k = 0; k < 32; ++k) s += pos[i0 + k] * w1[(size_t)(i0 + k) * 256 + j];
        ((float*)(ws + WS_CB1))[(kv * 64 + chunk * 2 + half) * 256 + j] = s; }
    { const f32x4* gr = (const f32x4*)F.in[2] + F.lane; f32x4 gg[4];
#pragma unroll
      for (int j = 0; j < 4; ++j) gg[j] = gr[64 * j];
      for (int m0 = gw; m0 < M; m0 += 4 * NGW) {
          f32x4 v[4][4];
#pragma unroll
          for (int r = 0; r < 4; ++r) { const int m = m0 + r * NGW < M ? m0 + r * NGW : m0; const f32x4* xr = (const f32x4*)(F.in[0] + (size_t)m * D) + F.lane;
#pragma unroll
              for (int j = 0; j < 4; ++j) v[r][j] = __builtin_nontemporal_load(xr + 64 * j); }
#pragma unroll
          for (int r = 0; r < 4; ++r) { const int m = m0 + r * NGW; float s = 0.f;
#pragma unroll
              for (int j = 0; j < 4; ++j) s += (v[r][j].x * v[r][j].x + v[r][j].y * v[r][j].y) + (v[r][j].z * v[r][j].z + v[r][j].w * v[r][j].w);
              const float rstd = rsqrtf(wave_sum(s) * (1.f / D) + EPS);
              if (m < M) { unsigned long long* o8 = (unsigned long long*)((bf16_t*)(ws + WS_XN) + (size_t)m * D) + F.lane;
#pragma unroll
                  for (int j = 0; j < 4; ++j) o8[64 * j] = (unsigned long long)pk2(v[r][j].x * rstd * gg[j].x, v[r][j].y * rstd * gg[j].y) | ((unsigned long long)pk2(v[r][j].z * rstd * gg[j].z, v[r][j].w * rstd * gg[j].w) << 32); } } } }
}

struct SchedGrid {
    const char* A; const char* B; size_t a_tile, b_tile; int nN, nU, G, c;
    __device__ __forceinline__ void a_ready(const pg8::Unit&) const {}
    __device__ __forceinline__ bool next(int i, pg8::Unit& u) const { const int L = i * G + c; if (L >= nU) return false; const int pm = L / nN, pn = L - pm * nN;
        u.a = A + (size_t)pm * a_tile; u.b = B + (size_t)pn * b_tile; u.bjump = 0; u.orow = pm * 256; u.ocol = pn * 256; u.aux = 0; return true; }
};
struct EpiBf16 {
    bf16_t* O; int ldc;
    __device__ __forceinline__ void operator()(const f32x4 (&acc)[2][2][4][2], const pg8::Unit& u, int wr, int wc, int fr, int fq) const {
#pragma unroll
        for (int ai = 0; ai < 2; ++ai)
#pragma unroll
            for (int m = 0; m < 4; ++m) { bf16_t* rowp = O + (size_t)(u.orow + ai * 128 + wr * 64 + m * 16 + fr) * ldc + u.ocol + wc * 32 + 8 * fq;
#pragma unroll
                for (int bj = 0; bj < 2; ++bj) { const f32x4 v0 = acc[ai][bj][m][0], v1 = acc[ai][bj][m][1];
                    u32x4 w; w.x = pk2(v0[0], v0[1]); w.y = pk2(v0[2], v0[3]); w.z = pk2(v1[0], v1[1]); w.w = pk2(v1[2], v1[3]);
                    *(u32x4*)(rowp + bj * 128) = w; } }
    }
};
struct SchedCmp1 {
    const bf16_t* PROJ; const bf16_t* W1; int G, c;
    __device__ __forceinline__ void a_ready(const pg8::Unit&) const {}
    __device__ __forceinline__ bool next(int i, pg8::Unit& u) const { const int L = i * G + c; if (L >= 32) return false;
        const int kv = L >> 4, kvh = (L >> 3) & 1, b = (L >> 1) & 3, nh = L & 1;
        u.a = (const char*)(PROJ + ((size_t)(b * SEQ + 16 * 256 * nh)) * NP + (kv ? C_VCT : C_KCT) + kvh * 64);
        u.b = (const char*)(W1 + (size_t)kv * 256 * 2048); u.bjump = 0;
        u.orow = (kv * 2 + kvh) * 2048 + b * 512 + nh * 256; u.ocol = 0; u.aux = kv; return true; }
};
struct SchedCmp1K {
    const bf16_t* PROJ; const bf16_t* W1; int c;
    __device__ __forceinline__ void a_ready(const pg8::Unit&) const {}
    __device__ __forceinline__ bool next(int i, pg8::Unit& u) const { if (i > 0 || c >= 64) return false; const int L = c >> 1, hf = c & 1;
        const int kv = L >> 4, kvh = (L >> 3) & 1, b = (L >> 1) & 3, nh = L & 1;
        u.a = (const char*)(PROJ + ((size_t)(b * SEQ + 16 * 256 * nh + 16 * hf)) * NP + (kv ? C_VCT : C_KCT) + kvh * 64);
        u.b = (const char*)(W1 + (size_t)kv * 256 * 2048 + hf * 16 * 64); u.bjump = 0;
        u.orow = (kv * 2 + kvh) * 2048 + b * 512 + nh * 256; u.ocol = 0; u.aux = kv | (L << 1); return true; }
};
struct EpiCmpPart {
    float* P; unsigned* cnt;
    __device__ __forceinline__ void operator()(const f32x4 (&acc)[2][2][4][2], const pg8::Unit& u, int wr, int wc, int fr, int fq) const {
        const int L = u.aux >> 1; const __amdgpu_buffer_rsrc_t rs = __builtin_amdgcn_make_buffer_rsrc(P, 0, 32 * 16 * 2 * 512 * 16, 0x00020000);
#pragma unroll
        for (int ai = 0; ai < 2; ++ai)
#pragma unroll
            for (int bj = 0; bj < 2; ++bj)
#pragma unroll
                for (int m = 0; m < 4; ++m)
#pragma unroll
                    for (int n = 0; n < 2; ++n) { const int slot = ((ai * 2 + bj) * 4 + m) * 2 + n;
                        __builtin_amdgcn_raw_buffer_store_b128(__builtin_bit_cast(u32x4, acc[ai][bj][m][n]), rs, (unsigned)(((L * 32 + slot) * 512 + (int)threadIdx.x) * 16), 0, 16); }
        asm volatile("s_waitcnt vmcnt(0)" ::: "memory");
        if (fr + fq == 0) __hip_atomic_fetch_add(cnt + 64 * L, 1u, __ATOMIC_RELAXED, __HIP_MEMORY_SCOPE_AGENT);
    }
};
struct EpiCmp1K {
    bf16_t* O; LAS const float* cb1; const float* P; const unsigned* cnt;
    __device__ __forceinline__ void operator()(const f32x4 (&acc)[2][2][4][2], const pg8::Unit& u, int wr, int wc, int fr, int fq) const {
        const int L = u.aux >> 1, kv = u.aux & 1;
        { const unsigned* w = cnt + 64 * L; unsigned sp = 0;
          while ((unsigned)__builtin_amdgcn_readfirstlane(__hip_atomic_load(w, __ATOMIC_RELAXED, __HIP_MEMORY_SCOPE_AGENT)) < (unsigned)NWAVES) { if (++sp > (1u << 20)) break; __builtin_amdgcn_s_sleep(2); }
          __builtin_amdgcn_fence(__ATOMIC_ACQUIRE, "agent"); }
        const f32x4* pp = (const f32x4*)P + (size_t)L * 32 * 512 + threadIdx.x;
        f32x4 bv[2][2];
#pragma unroll
        for (int bj = 0; bj < 2; ++bj)
#pragma unroll
            for (int n = 0; n < 2; ++n) bv[bj][n] = *(LAS const f32x4*)(cb1 + kv * 256 + bj * 128 + wc * 32 + 8 * fq + 4 * n);
#pragma unroll
        for (int ai = 0; ai < 2; ++ai)
#pragma unroll
            for (int m = 0; m < 4; ++m) { bf16_t* rowp = O + (size_t)(u.orow + ai * 128 + wr * 64 + m * 16 + fr) * 256 + wc * 32 + 8 * fq;
#pragma unroll
                for (int bj = 0; bj < 2; ++bj) { const int slot = ((ai * 2 + bj) * 4 + m) * 2;
                    f32x4 v0 = acc[ai][bj][m][0] + pp[(size_t)slot * 512] + bv[bj][0], v1 = acc[ai][bj][m][1] + pp[(size_t)(slot + 1) * 512] + bv[bj][1];
#pragma unroll
                    for (int j = 0; j < 4; ++j) { v0[j] = gelu_tanh(v0[j]); v1[j] = gelu_tanh(v1[j]); }
                    u32x4 w; w.x = pk2(v0[0], v0[1]); w.y = pk2(v0[2], v0[3]); w.z = pk2(v1[0], v1[1]); w.w = pk2(v1[2], v1[3]);
                    *(u32x4*)(rowp + bj * 128) = w; } }
    }
};
struct EpiCmp1 {
    bf16_t* O; LAS const float* cb1;
    __device__ __forceinline__ void operator()(const f32x4 (&acc)[2][2][4][2], const pg8::Unit& u, int wr, int wc, int fr, int fq) const {
        f32x4 bv[2][2];
#pragma unroll
        for (int bj = 0; bj < 2; ++bj)
#pragma unroll
            for (int n = 0; n < 2; ++n) bv[bj][n] = *(LAS const f32x4*)(cb1 + u.aux * 256 + bj * 128 + wc * 32 + 8 * fq + 4 * n);
#pragma unroll
        for (int ai = 0; ai < 2; ++ai)
#pragma unroll
            for (int m = 0; m < 4; ++m) { bf16_t* rowp = O + (size_t)(u.orow + ai * 128 + wr * 64 + m * 16 + fr) * 256 + wc * 32 + 8 * fq;
#pragma unroll
                for (int bj = 0; bj < 2; ++bj) { f32x4 v0 = acc[ai][bj][m][0] + bv[bj][0], v1 = acc[ai][bj][m][1] + bv[bj][1];
#pragma unroll
                    for (int j = 0; j < 4; ++j) { v0[j] = gelu_tanh(v0[j]); v1[j] = gelu_tanh(v1[j]); }
                    u32x4 w; w.x = pk2(v0[0], v0[1]); w.y = pk2(v0[2], v0[3]); w.z = pk2(v1[0], v1[1]); w.w = pk2(v1[2], v1[3]);
                    *(u32x4*)(rowp + bj * 128) = w; } }
    }
};
struct EpiWout {
    const float* X; bf16_t* O;
    __device__ __forceinline__ void operator()(const f32x4 (&acc)[2][2][4][2], const pg8::Unit& u, int wr, int wc, int fr, int fq) const {
#pragma unroll
        for (int ai = 0; ai < 2; ++ai)
#pragma unroll
            for (int m = 0; m < 4; ++m) { const size_t off = (size_t)(u.orow + ai * 128 + wr * 64 + m * 16 + fr) * D + u.ocol + wc * 32 + 8 * fq;
#pragma unroll
                for (int bj = 0; bj < 2; ++bj) { const f32x4 v0 = __builtin_nontemporal_load((const f32x4*)(X + off + bj * 128)) + acc[ai][bj][m][0], v1 = __builtin_nontemporal_load((const f32x4*)(X + off + bj * 128 + 4)) + acc[ai][bj][m][1];
                    u32x4 w; w.x = pk2(v0[0], v0[1]); w.y = pk2(v0[2], v0[3]); w.z = pk2(v1[0], v1[1]); w.w = pk2(v1[2], v1[3]);
                    *(u32x4*)(O + off + bj * 128) = w; } }
    }
};

__device__ __forceinline__ void moe_tables(Frame& F, bool want_pre) {
    LAS int* T = (LAS int*)(F.lds + MISC_OFF);
    const int* hist = (const int*)(F.ws + WS_CTL) + CW_HIST;
    const int tid = F.tid;
    int tot = 0, pre = 0;
    if (tid < 384) { const int c = tid >> 4, part = tid & 15;
        for (int w = part * 16; w < part * 16 + 16; ++w) { const int v = (w < F.G) ? hist[w * NCLS + c] : 0; tot += v; if (want_pre && w < (int)blockIdx.x) pre += v; } }
#pragma unroll
    for (int o = 1; o < 16; o <<= 1) { tot += __shfl_xor(tot, o); pre += __shfl_xor(pre, o); }
    if (tid < 384 && (tid & 15) == 0) { T[tid >> 4] = tot; T[24 + (tid >> 4)] = pre; }
    __syncthreads();
    if (tid == 0) { int p = 0; for (int c = 0; c < NCLS; ++c) { T[48 + c] = p; const int nt = (T[c] + 255) >> 8; for (int k = 0; k < nt; ++k) T[80 + p + k] = c; p += nt; } T[48 + NCLS] = p; }
    __syncthreads();
}
__device__ __forceinline__ void cls_experts(int cls, int& ea, int& eb) { const int gi = cls / 6, pr = cls - gi * 6; const int a = pr < 3 ? 0 : (pr < 5 ? 1 : 2); const int b = pr < 3 ? pr + 1 : (pr < 5 ? pr - 1 : 3); ea = gi * 4 + a; eb = gi * 4 + b; }

struct SchedUp {
    const char* HS; const char* WGU; LAS int* T; int G, c; const int* rowtok;
    __device__ __forceinline__ void a_ready(const pg8::Unit&) const {}
    __device__ __forceinline__ bool next(int i, pg8::Unit& u) const { const int L = i * G + c; const int TT = __builtin_amdgcn_readfirstlane(T[48 + NCLS]); const int rt = L >> 3, pn = L & 7; if (rt >= TT) return false;
        const int cls = __builtin_amdgcn_readfirstlane(T[80 + rt]); int ea, eb; cls_experts(cls, ea, eb); const int e = pn < 4 ? ea : eb;
        u.a = HS; u.rows = rowtok + rt * 256; u.b = WGU + (size_t)(e * 4 + (pn & 3)) * 256 * 2048; u.bjump = 0; u.orow = rt * 256; u.ocol = (pn >> 2) * 512 + (pn & 3) * 128; u.aux = pn >> 2; return true; }
};
struct EpiUp {
    bf16_t* HE; const f32x4* rowc; unsigned* ready;
    __device__ __forceinline__ void operator()(const f32x4 (&acc)[2][2][4][2], const pg8::Unit& u, int wr, int wc, int fr, int fq) const {
        const __amdgpu_buffer_rsrc_t rs = __builtin_amdgcn_make_buffer_rsrc(HE, 0, MAXTILES * 256 * 2048, 0x00020000);
#pragma unroll
        for (int ai = 0; ai < 2; ++ai)
#pragma unroll
            for (int m = 0; m < 4; ++m) { const int row = u.orow + ai * 128 + wr * 64 + m * 16 + fr; const f32x4 rc = rowc[row]; const float cw = (u.aux ? rc.y : rc.x) * rc.z, rsd = rc.z;
                float o[8];
#pragma unroll
                for (int n = 0; n < 2; ++n)
#pragma unroll
                    for (int j = 0; j < 4; ++j) { const float gt = acc[ai][0][m][n][j] * rsd, up = acc[ai][1][m][n][j]; o[n * 4 + j] = gt / (1.f + __expf(-gt)) * up * cw; }
                u32x4 w; w.x = pk2(o[0], o[1]); w.y = pk2(o[2], o[3]); w.z = pk2(o[4], o[5]); w.w = pk2(o[6], o[7]);
                __builtin_amdgcn_raw_buffer_store_b128(w, rs, (unsigned)((row * 1024 + u.ocol + wc * 32 + 8 * fq) * 2), 0, 16); }
        asm volatile("s_waitcnt vmcnt(0)" ::: "memory");
        if (fr + fq == 0) __hip_atomic_fetch_add(ready + 64 * (u.orow >> 8), 1u, __ATOMIC_RELAXED, __HIP_MEMORY_SCOPE_AGENT);
    }
};
struct SchedDown {
    const char* HE; const char* WD; LAS int* T; int G, c; const unsigned* ready;
    __device__ __forceinline__ bool next(int i, pg8::Unit& u) const { const int L = i * G + c; const int TT = __builtin_amdgcn_readfirstlane(T[48 + NCLS]); const int rt = L >> 2, pn = L & 3; if (rt >= TT) return false;
        const int cls = __builtin_amdgcn_readfirstlane(T[80 + rt]); int ea, eb; cls_experts(cls, ea, eb);
        u.a = HE + (size_t)rt * 256 * 2048; u.b = WD + (size_t)ea * 1024 * 1024 + (size_t)pn * 256 * 1024; u.bjump = (long)(eb - ea) * 1024 * 1024 - 8 * 128; u.orow = rt * 256; u.ocol = pn * 256; u.aux = 0; return true; }
    __device__ __forceinline__ void a_ready(const pg8::Unit& u) const {
        if (threadIdx.x < 64) { const unsigned* w = ready + 64 * (u.orow >> 8); unsigned sp = 0;
            while ((unsigned)__builtin_amdgcn_readfirstlane(__hip_atomic_load(w, __ATOMIC_RELAXED, __HIP_MEMORY_SCOPE_AGENT)) < 64u) { if (++sp > (1u << 20)) break; __builtin_amdgcn_s_sleep(2); }
            __builtin_amdgcn_fence(__ATOMIC_ACQUIRE, "agent");
            asm volatile("s_waitcnt vmcnt(0)" ::: "memory"); }
        asm volatile("" ::: "memory"); __builtin_amdgcn_s_barrier(); asm volatile("" ::: "memory");
    }
};
struct EpiDown {
    float* O; const int* rowtok;
    __device__ __forceinline__ void operator()(const f32x4 (&acc)[2][2][4][2], const pg8::Unit& u, int wr, int wc, int fr, int fq) const {
#pragma unroll
        for (int ai = 0; ai < 2; ++ai)
#pragma unroll
            for (int m = 0; m < 4; ++m) { const int tok = rowtok[u.orow + ai * 128 + wr * 64 + m * 16 + fr];
                if (tok >= 0) { float* p = O + (size_t)tok * D + u.ocol + wc * 32 + 8 * fq;
#pragma unroll
                    for (int bj = 0; bj < 2; ++bj)
#pragma unroll
                        for (int n = 0; n < 2; ++n) { f32x4* q = (f32x4*)(p + bj * 128 + 4 * n); *q = *q + acc[ai][bj][m][n]; } } }
    }
};

struct EpiDownNorm {
    float* O; const bf16_t* H; const int* rowtok; const float* gfin; float* xbuf; unsigned* cnt; LAS unsigned char* sc;
    __device__ __forceinline__ void operator()(f32x4 (&acc)[2][2][4][2], const pg8::Unit& u, int wr, int wc, int fr, int fq) const {
        LAS float* P = (LAS float*)sc; LAS float* S = (LAS float*)(sc + 4096); LAS unsigned* flag = (LAS unsigned*)(sc + 5120);
        const int wid = wr * 4 + wc, lane = fq * 16 + fr, rt = u.orow >> 8, pn = u.ocol >> 8;
        int tokv[2][4];
#pragma unroll
        for (int ai = 0; ai < 2; ++ai)
#pragma unroll
            for (int m = 0; m < 4; ++m) { const int rl = ai * 128 + wr * 64 + m * 16 + fr; const int tok = rowtok[u.orow + rl]; tokv[ai][m] = tok; float s = 0.f;
                if (tok >= 0) { const bf16_t* p = H + (size_t)tok * D + u.ocol + wc * 32 + 8 * fq;
#pragma unroll
                    for (int bj = 0; bj < 2; ++bj) { const u32x4 hw = *(const u32x4*)(p + bj * 128);
                        const f32x4 v0 = (f32x4){bf_lo(hw.x), bf_hi(hw.x), bf_lo(hw.y), bf_hi(hw.y)} + acc[ai][bj][m][0], v1 = (f32x4){bf_lo(hw.z), bf_hi(hw.z), bf_lo(hw.w), bf_hi(hw.w)} + acc[ai][bj][m][1];
                        acc[ai][bj][m][0] = v0; acc[ai][bj][m][1] = v1; s += (v0[0] * v0[0] + v0[1] * v0[1]) + (v0[2] * v0[2] + v0[3] * v0[3]) + (v1[0] * v1[0] + v1[1] * v1[1]) + (v1[2] * v1[2] + v1[3] * v1[3]); } }
                s += __shfl_xor(s, 16); s += __shfl_xor(s, 32);
                if (fq == 0) P[rl * 4 + wc] = s; }
        asm volatile("s_waitcnt lgkmcnt(0)" ::: "memory"); __builtin_amdgcn_s_barrier(); asm volatile("" ::: "memory");
        const int row = wid * 32 + (lane & 31);
        if (lane < 32) { const float t = (P[row * 4 + 0] + P[row * 4 + 1]) + (P[row * 4 + 2] + P[row * 4 + 3]);
            __hip_atomic_store(xbuf + ((size_t)(rt * 256 + row) * 4 + pn), t, __ATOMIC_RELAXED, __HIP_MEMORY_SCOPE_AGENT); }
        asm volatile("s_waitcnt vmcnt(0)" ::: "memory");
        if (lane == 0) __hip_atomic_fetch_add(cnt + 64 * rt, 1u, __ATOMIC_RELAXED, __HIP_MEMORY_SCOPE_AGENT);
        if (wid == 0) { unsigned sp = 0; bool dead = false;
            for (;;) { if ((unsigned)__builtin_amdgcn_readfirstlane(__hip_atomic_load(cnt + 64 * rt, __ATOMIC_RELAXED, __HIP_MEMORY_SCOPE_AGENT)) >= 32u) break;
                if (++sp > (1u << 20)) { dead = true; break; } __builtin_amdgcn_s_sleep(2); }
            __builtin_amdgcn_fence(__ATOMIC_ACQUIRE, "agent");
            if (lane == 0) flag[0] = dead ? 1u : 0u; }
        asm volatile("s_waitcnt vmcnt(0) lgkmcnt(0)" ::: "memory"); __builtin_amdgcn_s_barrier(); asm volatile("" ::: "memory");
        if (lane < 32) { const float* sl = xbuf + (size_t)(rt * 256 + row) * 4; float t = 0.f;
#pragma unroll
            for (int k = 0; k < 4; ++k) t += __hip_atomic_load(sl + k, __ATOMIC_RELAXED, __HIP_MEMORY_SCOPE_AGENT);
            S[row] = rsqrtf(t * (1.f / D) + EPS); }
        asm volatile("s_waitcnt vmcnt(0) lgkmcnt(0)" ::: "memory"); __builtin_amdgcn_s_barrier(); asm volatile("" ::: "memory");
        f32x4 gv[2][2];
#pragma unroll
        for (int bj = 0; bj < 2; ++bj)
#pragma unroll
            for (int n = 0; n < 2; ++n) gv[bj][n] = *(const f32x4*)(gfin + u.ocol + wc * 32 + 8 * fq + bj * 128 + 4 * n);
#pragma unroll
        for (int ai = 0; ai < 2; ++ai)
#pragma unroll
            for (int m = 0; m < 4; ++m) { const int tok = tokv[ai][m]; if (tok >= 0) { const float rs = S[ai * 128 + wr * 64 + m * 16 + fr]; float* p = O + (size_t)tok * D + u.ocol + wc * 32 + 8 * fq;
#pragma unroll
                for (int bj = 0; bj < 2; ++bj)
#pragma unroll
                    for (int n = 0; n < 2; ++n) __builtin_nontemporal_store(acc[ai][bj][m][n] * rs * gv[bj][n], (f32x4*)(p + bj * 128 + 4 * n)); } }
        asm volatile("s_waitcnt lgkmcnt(0)" ::: "memory"); __builtin_amdgcn_s_barrier(); asm volatile("" ::: "memory");
    }
};
__device__ __forceinline__ void p1_gates(Frame& F) {
    const bf16_t* XN = (const bf16_t*)(F.ws + WS_XN); const bf16_t* WG = (const bf16_t*)(F.ws + WS_WIN) + (size_t)C_GT * 1024; bf16_t* GT = (bf16_t*)(F.ws + WS_GATES);
    const int gw = F.vcu * NWAVES + F.wave, NGW = F.G * NWAVES, tl = F.lane & 15, kg = F.lane >> 4;
    for (int it = gw; it < M / 16; it += NGW) { const int row0 = it * 16; f32x4 c0 = {0.f, 0.f, 0.f, 0.f}, c1 = c0;
        const bf16_t* ap = XN + (size_t)(row0 + tl) * 1024 + kg * 8; const bf16_t* bp = WG + (size_t)tl * 1024 + kg * 8;
#pragma unroll 8
        for (int ks = 0; ks < 32; ++ks) { const bf16x8 a = *(const bf16x8*)(ap + ks * 32);
            c0 = __builtin_amdgcn_mfma_f32_16x16x32_bf16(a, *(const bf16x8*)(bp + ks * 32), c0, 0, 0, 0); c1 = __builtin_amdgcn_mfma_f32_16x16x32_bf16(a, *(const bf16x8*)(bp + 16 * 1024 + ks * 32), c1, 0, 0, 0); }
#pragma unroll
        for (int r = 0; r < 4; ++r) { GT[(size_t)(row0 + 4 * kg + r) * 32 + tl] = (bf16_t)f2bf(c0[r]); GT[(size_t)(row0 + 4 * kg + r) * 32 + 16 + tl] = (bf16_t)f2bf(c1[r]); } }
}
__device__ __forceinline__ void p3_cmp2(Frame& F, int it0, int it1, int step) {
    const bf16_t* H1 = (const bf16_t*)(F.ws + WS_H1); const bf16_t* W2 = (const bf16_t*)(F.ws + WS_CW2); bf16_t* KC = (bf16_t*)(F.ws + WS_KCMP);
    const int r32 = F.lane & 31, hi = F.lane >> 5;
    for (int it = it0; it < it1; it += step) { const int row0 = it * 32; const int combo = row0 >> 11, kv = combo >> 1, kvh = combo & 1, b = (row0 >> 9) & 3, n0 = row0 & 511;
        f32x16 c0 = {}, c1 = {};
        const bf16_t* ap = H1 + (size_t)(row0 + r32) * 256 + hi * 8; const bf16_t* bp = W2 + (size_t)kv * 64 * 256 + (size_t)r32 * 256 + hi * 8;
#pragma unroll 4
        for (int ks = 0; ks < 16; ++ks) { const bf16x8 a = *(const bf16x8*)(ap + ks * 16); const bf16x8 b0 = *(const bf16x8*)(bp + ks * 16), b1 = *(const bf16x8*)(bp + 32 * 256 + ks * 16);
            c0 = __builtin_amdgcn_mfma_f32_32x32x16_bf16(a, b0, c0, 0, 0, 0); c1 = __builtin_amdgcn_mfma_f32_32x32x16_bf16(a, b1, c1, 0, 0, 0); }
        bf16_t* op = KC + (size_t)kv * (4 * 2 * 512 * 64) + ((size_t)(b * 2 + kvh) * 512 + n0) * 64;
#pragma unroll
        for (int r = 0; r < 16; ++r) { const int row = (r & 3) + 8 * (r >> 2) + 4 * hi; if (n0 + row == 511) { c0[r] = 0.f; c1[r] = 0.f; }
            op[row * 64 + r32] = (bf16_t)f2bf(c0[r]); op[row * 64 + 32 + r32] = (bf16_t)f2bf(c1[r]); }
        if (kv) { bf16_t* vt = (bf16_t*)(F.ws + WS_VCT) + ((size_t)(b * 2 + kvh) * 64 + r32) * 512 + n0 + 4 * hi;
#pragma unroll
            for (int u = 0; u < 4; ++u) { *(u32x2*)(vt + 8 * u) = (u32x2){pk2(c0[4 * u], c0[4 * u + 1]), pk2(c0[4 * u + 2], c0[4 * u + 3])};
                *(u32x2*)(vt + (size_t)32 * 512 + 8 * u) = (u32x2){pk2(c1[4 * u], c1[4 * u + 1]), pk2(c1[4 * u + 2], c1[4 * u + 3])}; } } }
}

__device__ __forceinline__ void load_q64(float (&q)[64], const bf16_t* p) {
#pragma unroll
    for (int c = 0; c < 8; ++c) { const u32x4 v = *(const u32x4*)(p + 8 * c); q[8 * c] = bf_lo(v.x); q[8 * c + 1] = bf_hi(v.x); q[8 * c + 2] = bf_lo(v.y); q[8 * c + 3] = bf_hi(v.y); q[8 * c + 4] = bf_lo(v.z); q[8 * c + 5] = bf_hi(v.z); q[8 * c + 6] = bf_lo(v.w); q[8 * c + 7] = bf_hi(v.w); }
}
__device__ __forceinline__ float dot64(const float (&q)[64], const bf16_t* p) {
    float s0 = 0.f, s1 = 0.f;
#pragma unroll
    for (int c = 0; c < 8; ++c) { const u32x4 v = *(const u32x4*)(p + 8 * c);
        s0 += q[8 * c] * bf_lo(v.x) + q[8 * c + 2] * bf_lo(v.y) + q[8 * c + 4] * bf_lo(v.z) + q[8 * c + 6] * bf_lo(v.w);
        s1 += q[8 * c + 1] * bf_hi(v.x) + q[8 * c + 3] * bf_hi(v.y) + q[8 * c + 5] * bf_hi(v.z) + q[8 * c + 7] * bf_hi(v.w); }
    return s0 + s1;
}
__device__ __forceinline__ void axpy64(float (&o)[64], float p, const bf16_t* vp) {
#pragma unroll
    for (int c = 0; c < 8; ++c) { const u32x4 v = *(const u32x4*)(vp + 8 * c);
        o[8 * c] += p * bf_lo(v.x); o[8 * c + 1] += p * bf_hi(v.x); o[8 * c + 2] += p * bf_lo(v.y); o[8 * c + 3] += p * bf_hi(v.y);
        o[8 * c + 4] += p * bf_lo(v.z); o[8 * c + 5] += p * bf_hi(v.z); o[8 * c + 6] += p * bf_lo(v.w); o[8 * c + 7] += p * bf_hi(v.w); }
}
#ifndef MK_PROBE
#define MK_PROBE 0
#endif
#define MK_PBR 2
constexpr size_t WS_AUX = 460 * MiB;
constexpr float PROBE_K = 64.f;
__device__ __forceinline__ void store64(bf16_t* p, const float (&oi)[64], float sc) {
    float o[64];
#pragma unroll
    for (int d = 0; d < 64; ++d) o[d] = oi[d];
#if (MK_PROBE & 3)
    { float f[64]; load_q64(f, p);
#pragma unroll
      for (int d = 0; d < 64; ++d) { const float nv = o[d] * sc; o[d] = (nv + PROBE_K * (f[d] - nv)) / sc; } }
#endif
#pragma unroll
    for (int c = 0; c < 8; ++c) { u32x4 w; w.x = pk2(o[8 * c] * sc, o[8 * c + 1] * sc); w.y = pk2(o[8 * c + 2] * sc, o[8 * c + 3] * sc); w.z = pk2(o[8 * c + 4] * sc, o[8 * c + 5] * sc); w.w = pk2(o[8 * c + 6] * sc, o[8 * c + 7] * sc); *(u32x4*)(p + 8 * c) = w; }
}

__device__ __forceinline__ void nv_mixer_a(Frame& F) {
    const bf16_t* PROJ = (const bf16_t*)(F.ws + WS_PROJ); bf16_t* OMIX = (bf16_t*)(F.ws + WS_XN); const float* relb = F.in[1];
    for (int idx = blockIdx.x * NTHR + F.tid; idx < 6 * M; idx += F.G * NTHR) {
        const int h = idx / M, row = idx - h * M, b = row >> 13, t = row & (SEQ - 1);
        float q[64], o[64];
        load_q64(q, PROJ + (size_t)row * NP + C_QA + h * 64);
#pragma unroll
        for (int d = 0; d < 64; ++d) o[d] = 0.f;
        float m = -INFINITY, l = 0.f;
        for (int p = 0; p < 3; ++p) { const int dil = p == 0 ? 1 : (p == 1 ? 4 : 16);
            for (int j = 0; j <= 128; ++j) { const int kt = t - dil * j; if (kt < 0) break;
                const bf16_t* kr = PROJ + (size_t)(b * SEQ + kt) * NP;
                const float s = dot64(q, kr + C_KA + h * 64) * 0.125f + relb[t5_bucket(dil * j) * 16 + h];
                if (s > m) { const float c = __expf(m - s); l *= c;
#pragma unroll
                    for (int d = 0; d < 64; ++d) o[d] *= c;
                    m = s; }
                const float pe = __expf(s - m); l += pe; axpy64(o, pe, kr + C_VA + h * 64); } }
        store64(OMIX + (size_t)row * D + h * 64, o, 1.f / l);
    }
}
__device__ __forceinline__ void nv_nsa_a(Frame& F) {
    const bf16_t* PROJ = (const bf16_t*)(F.ws + WS_PROJ); const bf16_t* KCMP = (const bf16_t*)(F.ws + WS_KCMP); const float* relb = F.in[1];
    float* IMP = (float*)(F.ws + WS_IMP); int* SEL = (int*)(F.ws + WS_SEL); f32x2* MD = (f32x2*)(F.ws + WS_MD);
    for (int idx = blockIdx.x * NTHR + F.tid; idx < 2 * M; idx += F.G * NTHR) {
        const int kvh = idx / M, row = idx - kvh * M, b = row >> 13, t = row & (SEQ - 1);
        int nv = t >= 31 ? ((t - 31) >> 4) + 1 : 0; if (nv > NCMP) nv = NCMP;
        const bf16_t* Kc = KCMP + (size_t)(b * 2 + kvh) * 512 * 64;
        float* imp = IMP + ((size_t)row * 2 + kvh) * 128;
        for (int s = 0; s < 128; s += 4) *(f32x4*)(imp + s) = (f32x4){0.f, 0.f, 0.f, 0.f};
        for (int g = 0; g < 5; ++g) { const int hb = kvh * 5 + g;
            float q[64]; load_q64(q, PROJ + (size_t)row * NP + C_QB + hb * 64);
            float m = -INFINITY;
            for (int n = 0; n < nv; ++n) { const float s = dot64(q, Kc + n * 64) * 0.125f + relb[t5_bucket(t - 16 * n - 31) * 16 + 6 + hb]; m = fmaxf(m, s); }
            float den = 0.f;
            for (int n = 0; n < nv; ++n) { const float s = dot64(q, Kc + n * 64) * 0.125f + relb[t5_bucket(t - 16 * n - 31) * 16 + 6 + hb]; den += __expf(s - m); }
            MD[(size_t)row * 10 + hb] = (f32x2){nv > 0 ? m : 0.f, den};
            const float inv = nv > 0 ? 1.f / den : 0.f;
            float acc = 0.f;
            for (int n = 0; n < nv; ++n) { const float s = dot64(q, Kc + n * 64) * 0.125f + relb[t5_bucket(t - 16 * n - 31) * 16 + 6 + hb]; const float p = __expf(s - m) * inv;
                if ((n & 3) < 3) acc += p; else { acc += 0.5f * p; imp[n >> 2] += acc; acc = 0.5f * p; } }
            if (nv > 0) imp[nv >> 2] += acc;
        }
        const int cur = t >> 6; unsigned taken[4] = {0u, 0u, 0u, 0u};
        int* sel = SEL + ((size_t)row * 2 + kvh) * 16;
        for (int k = 0; k < 16; ++k) { float best = -INFINITY; int bi = 0;
            for (int s = 0; s < 128; ++s) { if ((taken[s >> 5] >> (s & 31)) & 1u) continue;
                const bool forced = (s == cur) | (s == cur - 1) | (s == 0);
                const float v = forced ? 1.0e4f : (s <= cur ? imp[s] : -1.f);
                if (v > best) { best = v; bi = s; } }
            taken[bi >> 5] |= 1u << (bi & 31); sel[k] = bi; }
    }
}
__device__ __forceinline__ void nv_nsa_b(Frame& F) {
    const bf16_t* PROJ = (const bf16_t*)(F.ws + WS_PROJ); const bf16_t* KCMP = (const bf16_t*)(F.ws + WS_KCMP); const bf16_t* VCMP = (const bf16_t*)(F.ws + WS_VCMP); const float* relb = F.in[1];
    const int* SEL = (const int*)(F.ws + WS_SEL); const f32x2* MD = (const f32x2*)(F.ws + WS_MD); bf16_t* OMIX = (bf16_t*)(F.ws + WS_XN);
    for (int idx = blockIdx.x * NTHR + F.tid; idx < 10 * M; idx += F.G * NTHR) {
        const int hb = idx / M, row = idx - hb * M, b = row >> 13, t = row & (SEQ - 1), kvh = hb / 5;
        const bf16_t* prow = PROJ + (size_t)row * NP;
        float q[64], o[64]; load_q64(q, prow + C_QB + hb * 64);
#pragma unroll
        for (int d = 0; d < 64; ++d) o[d] = 0.f;
        float g0 = 1.f / (1.f + __expf(-bf2f(((const bf16_t*)(F.ws + WS_GATES))[(size_t)row * 32 + hb * 3 + 0]))), g1 = 1.f / (1.f + __expf(-bf2f(((const bf16_t*)(F.ws + WS_GATES))[(size_t)row * 32 + hb * 3 + 1]))), g2 = 1.f / (1.f + __expf(-bf2f(((const bf16_t*)(F.ws + WS_GATES))[(size_t)row * 32 + hb * 3 + 2])));
#if MK_PROBE == 4
        if (MK_PBR != 0) g0 = 0.f; if (MK_PBR != 1) g1 = 0.f; if (MK_PBR != 2) g2 = 0.f;
#endif
        const float* rb = relb + 6 + hb;
        { int nv = t >= 31 ? ((t - 31) >> 4) + 1 : 0; if (nv > NCMP) nv = NCMP;
          const bf16_t* Kc = KCMP + (size_t)(b * 2 + kvh) * 512 * 64; const bf16_t* Vc = VCMP + (size_t)(b * 2 + kvh) * 512 * 64;
          const f32x2 md = MD[(size_t)row * 10 + hb]; const float w = nv > 0 ? g0 / md.y : 0.f;
          for (int n = 0; n < nv; ++n) { const float s = dot64(q, Kc + n * 64) * 0.125f + rb[t5_bucket(t - 16 * n - 31) * 16]; axpy64(o, __expf(s - md.x) * w, Vc + n * 64); } }
        { const int* sel = SEL + ((size_t)row * 2 + kvh) * 16; const bf16_t* base = PROJ + (size_t)(b * SEQ) * NP + kvh * 64;
          float m = -INFINITY;
          for (int k = 0; k < 16; ++k) { const int p0 = sel[k] * 64; for (int l = 0; l < 64 && p0 + l <= t; ++l) { const int pos = p0 + l; m = fmaxf(m, dot64(q, base + (size_t)pos * NP + C_KS) * 0.125f + rb[t5_bucket(t - pos) * 16]); } }
          float den = 0.f;
          for (int k = 0; k < 16; ++k) { const int p0 = sel[k] * 64; for (int l = 0; l < 64 && p0 + l <= t; ++l) { const int pos = p0 + l; den += __expf(dot64(q, base + (size_t)pos * NP + C_KS) * 0.125f + rb[t5_bucket(t - pos) * 16] - m); } }
          const float w = g1 / den;
          for (int k = 0; k < 16; ++k) { const int p0 = sel[k] * 64; for (int l = 0; l < 64 && p0 + l <= t; ++l) { const int pos = p0 + l; const bf16_t* kr = base + (size_t)pos * NP;
              axpy64(o, __expf(dot64(q, kr + C_KS) * 0.125f + rb[t5_bucket(t - pos) * 16] - m) * w, kr + C_VS); } } }
        { const bf16_t* base = PROJ + (size_t)(b * SEQ) * NP + kvh * 64; const int lo = t - 511 < 0 ? 0 : t - 511;
          float m = -INFINITY;
          for (int pos = lo; pos <= t; ++pos) m = fmaxf(m, dot64(q, base + (size_t)pos * NP + C_KW) * 0.125f + rb[t5_bucket(t - pos) * 16]);
          float den = 0.f;
          for (int pos = lo; pos <= t; ++pos) den += __expf(dot64(q, base + (size_t)pos * NP + C_KW) * 0.125f + rb[t5_bucket(t - pos) * 16] - m);
          const float w = g2 / den;
          for (int pos = lo; pos <= t; ++pos) { const bf16_t* kr = base + (size_t)pos * NP; axpy64(o, __expf(dot64(q, kr + C_KW) * 0.125f + rb[t5_bucket(t - pos) * 16] - m) * w, kr + C_VW); } }
#if MK_PROBE == 4
        { float f[64], fb[64]; bf16_t* p = OMIX + (size_t)row * D + 384 + hb * 64; load_q64(f, p); load_q64(fb, (const bf16_t*)(F.ws + WS_AUX) + (size_t)row * 640 + hb * 64);
#pragma unroll
          for (int d = 0; d < 64; ++d) o[d] = f[d] + PROBE_K * (fb[d] - o[d]);
#pragma unroll
          for (int c = 0; c < 8; ++c) { u32x4 w; w.x = pk2(o[8 * c], o[8 * c + 1]); w.y = pk2(o[8 * c + 2], o[8 * c + 3]); w.z = pk2(o[8 * c + 4], o[8 * c + 5]); w.w = pk2(o[8 * c + 6], o[8 * c + 7]); *(u32x4*)(p + 8 * c) = w; } }
#else
        store64(OMIX + (size_t)row * D + 384 + hb * 64, o, 1.f);
#endif
    }
}

constexpr float LOG2E = 1.4426950408889634f;
constexpr float QSC = 0.125f * LOG2E;
constexpr int ATT_TBN = 0;
constexpr int TBN_SZ = 3616, TBN_PAD = 1088, ATT_BIAS = 3648;
constexpr int TBW_PAD = 64;
constexpr int ATT_TBA = 0;
constexpr int TBA_SZ = 1088, TBA_P16 = 0, TBA_O16 = 32, TBA_P4 = 192, TBA_O4 = 64, TBA_P1 = 448, TBA_O1 = 256;
constexpr int ATT_KVR = 4352;
constexpr int KVR_KROW = 128, KVR_VROW = 128, KVR_VOFF = 64 * KVR_KROW, KVR_SLOT = 64 * KVR_KROW + 64 * KVR_VROW;
constexpr int ATT_TBW = ATT_KVR + 4 * KVR_SLOT, TBW_SZ = 576;
constexpr int ATT_WAVE = ATT_TBW + 5 * TBW_SZ * 4, ATT_WSZ = 8192;
constexpr int ATT_TBWM = ATT_WAVE + 8 * ATT_WSZ, TBWM_LO = 448, TBWM_SZ = 128;
static_assert(6 * TBA_SZ * 4 <= ATT_TBW && ATT_BIAS + 5 * 33 * 4 <= ATT_KVR && ATT_TBWM + 5 * TBWM_SZ * 4 <= LDS_BYTES - 16, "attention LDS map");

typedef __bf16 bf16x2_t __attribute__((ext_vector_type(2)));
__device__ __forceinline__ unsigned cvtpk(float lo, float hi) { f32x2 v = {lo, hi}; bf16x2_t b = __builtin_convertvector(v, bf16x2_t); return __builtin_bit_cast(unsigned, b); }
__device__ __forceinline__ f32x4 mfma16(bf16x8 a, bf16x8 b, f32x4 c) { return __builtin_amdgcn_mfma_f32_16x16x32_bf16(a, b, c, 0, 0, 0); }
__device__ __forceinline__ float ex2(float x) { return __builtin_amdgcn_exp2f(x); }
__device__ __forceinline__ float kgmax(float v) { v = fmaxf(v, __shfl_xor(v, 16)); v = fmaxf(v, __shfl_xor(v, 32)); return v; }
__device__ __forceinline__ float kgsum(float v) { v += __shfl_xor(v, 16); v += __shfl_xor(v, 32); return v; }
__device__ __forceinline__ float dpp_shr(float v, int n) {
    int r = 0;
    if (n == 1) r = __builtin_amdgcn_update_dpp(0, __builtin_bit_cast(int, v), 0x111, 0xf, 0xf, true);
    if (n == 2) r = __builtin_amdgcn_update_dpp(0, __builtin_bit_cast(int, v), 0x112, 0xf, 0xf, true);
    if (n == 4) r = __builtin_amdgcn_update_dpp(0, __builtin_bit_cast(int, v), 0x114, 0xf, 0xf, true);
    return __builtin_bit_cast(float, r);
}
__device__ __forceinline__ float dpp_ror(float v, int n) {
    int r = 0;
    if (n == 1) r = __builtin_amdgcn_update_dpp(0, __builtin_bit_cast(int, v), 0x121, 0xf, 0xf, false);
    if (n == 2) r = __builtin_amdgcn_update_dpp(0, __builtin_bit_cast(int, v), 0x122, 0xf, 0xf, false);
    if (n == 4) r = __builtin_amdgcn_update_dpp(0, __builtin_bit_cast(int, v), 0x124, 0xf, 0xf, false);
    if (n == 8) r = __builtin_amdgcn_update_dpp(0, __builtin_bit_cast(int, v), 0x128, 0xf, 0xf, false);
    return __builtin_bit_cast(float, r);
}
__device__ __forceinline__ float rowmax16(float v) { v = fmaxf(v, dpp_ror(v, 8)); v = fmaxf(v, dpp_ror(v, 4)); v = fmaxf(v, dpp_ror(v, 2)); v = fmaxf(v, dpp_ror(v, 1)); return v; }
__device__ __forceinline__ int dpp_rori(int v, int n) {
    if (n == 1) return __builtin_amdgcn_update_dpp(0, v, 0x121, 0xf, 0xf, false);
    if (n == 2) return __builtin_amdgcn_update_dpp(0, v, 0x122, 0xf, 0xf, false);
    if (n == 4) return __builtin_amdgcn_update_dpp(0, v, 0x124, 0xf, 0xf, false);
    return __builtin_amdgcn_update_dpp(0, v, 0x128, 0xf, 0xf, false);
}
__device__ __forceinline__ int rowmax16i(int v) { v = max(v, dpp_rori(v, 8)); v = max(v, dpp_rori(v, 4)); v = max(v, dpp_rori(v, 2)); v = max(v, dpp_rori(v, 1)); return v; }
__device__ __forceinline__ int rowmin16(int v) { float f = (float)v;
    f = fminf(f, dpp_ror(f, 8)); f = fminf(f, dpp_ror(f, 4)); f = fminf(f, dpp_ror(f, 2)); f = fminf(f, dpp_ror(f, 1)); return (int)f; }
__device__ __forceinline__ float sum5(float v) { const float t1 = v + dpp_shr(v, 1); const float t2 = t1 + dpp_shr(t1, 2); return t2 + dpp_shr(v, 4); }

__device__ __forceinline__ bf16x8 ones8() { const u32x4 w = {0x3f803f80u, 0x3f803f80u, 0x3f803f80u, 0x3f803f80u}; return __builtin_bit_cast(bf16x8, w); }

__device__ __forceinline__ bf16x8 q_scaled(bf16x8 v) { const u32x4 w = __builtin_bit_cast(u32x4, v); u32x4 r;
#pragma unroll
    for (int k = 0; k < 4; ++k) r[k] = cvtpk(bf_lo(w[k]) * QSC, bf_hi(w[k]) * QSC);
    return __builtin_bit_cast(bf16x8, r); }
__device__ __forceinline__ f32x4 splat4(float v) { return (f32x4){v, v, v, v}; }
struct ColState { float m; f32x4 la; f32x4 o[4]; };
__device__ __forceinline__ void cs_init(ColState& s) { s.m = -INFINITY; s.la = (f32x4){0.f, 0.f, 0.f, 0.f};
#pragma unroll
    for (int d = 0; d < 4; ++d) s.o[d] = (f32x4){0.f, 0.f, 0.f, 0.f}; }

constexpr float RESC_THR = 8.f;
template <int NC, class BF>
__device__ __forceinline__ void step32(ColState (&st)[NC], const bf16x8 (&q)[NC][2], const bf16x8 ka0, const bf16x8 ka1, const bf16x8 kb0, const bf16x8 kb1, const bf16x8 (&V)[4], const BF& bias) {
    bf16x8 P[NC];
#pragma unroll
    for (int c = 0; c < NC; ++c) {
        const f32x4 bA = {bias(c, 0, 0), bias(c, 0, 1), bias(c, 0, 2), bias(c, 0, 3)}, bB = {bias(c, 1, 0), bias(c, 1, 1), bias(c, 1, 2), bias(c, 1, 3)};
        f32x4 sA = mfma16(ka0, q[c][0], bA); sA = mfma16(ka1, q[c][1], sA);
        f32x4 sB = mfma16(kb0, q[c][0], bB); sB = mfma16(kb1, q[c][1], sB);
        f32x2 x0 = (f32x2){sA[0], sA[1]}, x1 = (f32x2){sA[2], sA[3]};
        f32x2 x2 = (f32x2){sB[0], sB[1]}, x3 = (f32x2){sB[2], sB[3]};
        const float mx = fmaxf(fmaxf(fmaxf(fmaxf(x0.x, x0.y), x1.x), fmaxf(fmaxf(x1.y, x2.x), x2.y)), fmaxf(x3.x, x3.y));
        if (__builtin_expect(__any(mx > st[c].m + RESC_THR), 0)) {
            const float mn = fmaxf(st[c].m, kgmax(mx)), mref = (mn == -INFINITY) ? 0.f : mn;
            const float alpha = ex2(st[c].m - mref);
            st[c].la = st[c].la * alpha; st[c].m = mn;
#pragma unroll
            for (int d = 0; d < 4; ++d) st[c].o[d] = st[c].o[d] * alpha;
        }
        const float mref = (st[c].m == -INFINITY) ? 0.f : st[c].m; const f32x2 mm = {mref, mref};
        x0 = x0 - mm; x1 = x1 - mm; x2 = x2 - mm; x3 = x3 - mm;
        const f32x2 p0 = {ex2(x0.x), ex2(x0.y)}, p1 = {ex2(x1.x), ex2(x1.y)}, p2 = {ex2(x2.x), ex2(x2.y)}, p3 = {ex2(x3.x), ex2(x3.y)};
        u32x4 pw = {cvtpk(p0.x, p0.y), cvtpk(p1.x, p1.y), cvtpk(p2.x, p2.y), cvtpk(p3.x, p3.y)};
        P[c] = __builtin_bit_cast(bf16x8, pw);
    }
    __builtin_amdgcn_s_setprio(1);
#pragma unroll
    for (int d = 0; d < 4; ++d)
#pragma unroll
        for (int c = 0; c < NC; ++c) st[c].o[d] = mfma16(V[d], P[c], st[c].o[d]);
#pragma unroll
    for (int c = 0; c < NC; ++c) st[c].la = mfma16(ones8(), P[c], st[c].la);
    __builtin_amdgcn_s_setprio(0);
}
template <bool ADDB, class BF>
__device__ __forceinline__ void scores64(f32x2 (&x)[8], const bf16x8 (&q)[2], const bf16x8 (&kf)[4][2], const float c0, const BF& bias) {
    const f32x4 c4 = splat4(c0);
#pragma unroll
    for (int t = 0; t < 4; ++t) { f32x4 s = mfma16(kf[t][0], q[0], c4); s = mfma16(kf[t][1], q[1], s);
        if (ADDB) { x[2 * t] = (f32x2){s[0] + bias(t, 0), s[1] + bias(t, 1)}; x[2 * t + 1] = (f32x2){s[2] + bias(t, 2), s[3] + bias(t, 3)}; }
        else { x[2 * t] = (f32x2){s[0], s[1]}; x[2 * t + 1] = (f32x2){s[2], s[3]}; } }
}
template <class VF>
__device__ __forceinline__ void step64_tail(ColState& st, f32x2 (&x)[8], const VF& ldv) {
    bf16x8 V0[4]; ldv(0, V0);
    __builtin_amdgcn_sched_barrier(0);
    float mx = fmaxf(x[0].x, x[0].y);
#pragma unroll
    for (int k = 1; k < 8; ++k) mx = fmaxf(fmaxf(mx, x[k].x), x[k].y);
    const float thr = (st.m == -INFINITY) ? -INFINITY : RESC_THR;
    if (__builtin_expect(__any(mx > thr), 0)) {
        const float mold = (st.m == -INFINITY) ? 0.f : st.m;
        const float mn = fmaxf(st.m, kgmax(mx) + mold), mref = (mn == -INFINITY) ? 0.f : mn;
        const float alpha = ex2(st.m - mref), dm = mref - mold;
        st.la = st.la * alpha; st.m = mn;
#pragma unroll
        for (int d = 0; d < 4; ++d) st.o[d] = st.o[d] * alpha;
#pragma unroll
        for (int k = 0; k < 8; ++k) { x[k].x -= dm; x[k].y -= dm; }
    }
    bf16x8 P0, P1;
    { u32x4 pw = {cvtpk(ex2(x[0].x), ex2(x[0].y)), cvtpk(ex2(x[1].x), ex2(x[1].y)), cvtpk(ex2(x[2].x), ex2(x[2].y)), cvtpk(ex2(x[3].x), ex2(x[3].y))}; P0 = __builtin_bit_cast(bf16x8, pw); }
    bf16x8 V1[4]; ldv(1, V1);
    __builtin_amdgcn_sched_barrier(0);
    __builtin_amdgcn_s_setprio(1);
#pragma unroll
    for (int d = 0; d < 4; ++d) st.o[d] = mfma16(V0[d], P0, st.o[d]);
    st.la = mfma16(ones8(), P0, st.la);
    { u32x4 pw = {cvtpk(ex2(x[4].x), ex2(x[4].y)), cvtpk(ex2(x[5].x), ex2(x[5].y)), cvtpk(ex2(x[6].x), ex2(x[6].y)), cvtpk(ex2(x[7].x), ex2(x[7].y))}; P1 = __builtin_bit_cast(bf16x8, pw); }
#pragma unroll
    for (int d = 0; d < 4; ++d) st.o[d] = mfma16(V1[d], P1, st.o[d]);
    st.la = mfma16(ones8(), P1, st.la);
    __builtin_amdgcn_s_setprio(0);
}
__device__ __forceinline__ void ldv4(bf16x8 (&V)[4], const bf16_t* vA, const bf16_t* vB, const size_t vstep) {
#pragma unroll
    for (int d = 0; d < 4; ++d) { const u32x2 va = *(const u32x2*)(vA + d * vstep), vb = *(const u32x2*)(vB + d * vstep); u32x4 vw = {va.x, va.y, vb.x, vb.y}; V[d] = __builtin_bit_cast(bf16x8, vw); }
}

struct AttnG {
    const bf16_t* PROJ; const bf16_t* KCMP; const bf16_t* VCT; const bf16_t* VTS; const bf16_t* VTW; const bf16_t* VTA1; const bf16_t* VTA4; const bf16_t* VTA16; const bf16_t* KA1; const bf16_t* KA4; const bf16_t* KA16; bf16_t* OMIX;
};

__device__ __forceinline__ void attn_tables_nsa(Frame& F, int kvh) {
    LAS unsigned char* BKT = (LAS unsigned char*)(F.lds + ATT_TBN); LAS float* BIAS = (LAS float*)(F.lds + ATT_BIAS); const float* relb = F.in[1];
    for (int e = F.tid; e < TBN_SZ; e += NTHR) { const int d = e - TBN_PAD; BKT[e] = (unsigned char)(d < 0 ? 32 : t5_bucket(d)); }
    if (F.tid < 5 * 33) { const int g = F.tid / 33, k = F.tid - g * 33; BIAS[F.tid] = k == 32 ? -INFINITY : relb[k * 16 + 6 + kvh * 5 + g] * LOG2E; }
    { LAS float* TBW = (LAS float*)(F.lds + ATT_TBW);
      for (int e = F.tid; e < 5 * TBW_SZ; e += NTHR) { const int g = e / TBW_SZ, d = e - g * TBW_SZ - TBW_PAD; TBW[e] = d < 0 ? -INFINITY : bf2f((bf16_t)f2bf(relb[t5_bucket(d) * 16 + 6 + kvh * 5 + g] * LOG2E)); } }
    { LAS float* TBWM = (LAS float*)(F.lds + ATT_TBWM);
      for (int e = F.tid; e < 5 * TBWM_SZ; e += NTHR) { const int g = e / TBWM_SZ, d = e - g * TBWM_SZ + TBWM_LO; TBWM[e] = d > 511 ? -INFINITY : bf2f((bf16_t)f2bf(relb[t5_bucket(d) * 16 + 6 + kvh * 5 + g] * LOG2E)); } }
    __syncthreads();
}
__device__ __forceinline__ void attn_tables_mixa(Frame& F) {
    LAS float* TBA = (LAS float*)(F.lds + ATT_TBA); const float* relb = F.in[1];
    for (int e = F.tid; e < 6 * TBA_SZ; e += NTHR) { const int h = e / TBA_SZ, k = e - h * TBA_SZ; int j, dil;
        if (k < TBA_P4) { j = k - TBA_P16 - TBA_O16; dil = 16; } else if (k < TBA_P1) { j = k - TBA_P4 - TBA_O4; dil = 4; } else { j = k - TBA_P1 - TBA_O1; dil = 1; }
        TBA[e] = (j < 0 || j > 128) ? -INFINITY : relb[t5_bucket(dil * j) * 16 + h] * LOG2E; }
    __syncthreads();
}

__device__ __forceinline__ void vt_item(const bf16_t* src  , int dil, int cls, int m64, bf16_t* dst  , LAS unsigned char* wl, int lane, bool blocked) {
    constexpr int RS = 136;
#pragma unroll
    for (int it = 0; it < 8; ++it) { const int k = it * 8 + (lane >> 3), c = lane & 7; const int t = cls + dil * (64 * m64 + k);
        const u32x4 v = *(const u32x4*)(src + (size_t)t * NP + c * 8);
        *(LAS u32x2*)(wl + k * RS + c * 16) = (u32x2){v.x, v.y}; *(LAS u32x2*)(wl + k * RS + c * 16 + 8) = (u32x2){v.z, v.w}; }
    LDS_WAIT(); asm volatile("" ::: "memory");
    const int pos0 = cls * (SEQ / dil) + 64 * m64;
#pragma unroll
    for (int it = 0; it < 8; ++it) { const int dim = (lane >> 3) + 8 * it, c = lane & 7; unsigned short e[8];
#pragma unroll
        for (int k = 0; k < 8; ++k) { const int kk = blocked ? 8 * c + k : 32 * (c >> 2) + 4 * (c & 3) + (k & 3) + 16 * (k >> 2);
            e[k] = *(const LAS unsigned short*)(wl + kk * RS + dim * 2); }
        u32x4 o = {(unsigned)e[0] | ((unsigned)e[1] << 16), (unsigned)e[2] | ((unsigned)e[3] << 16), (unsigned)e[4] | ((unsigned)e[5] << 16), (unsigned)e[6] | ((unsigned)e[7] << 16)};
        const int pos = pos0 + 8 * c;
        *(u32x4*)(blocked ? dst + (size_t)(pos >> 4) * 1024 + dim * 16 + (pos & 15) : dst + (size_t)dim * SEQ + pos) = o; }
    LDS_WAIT(); asm volatile("" ::: "memory");
}
__device__ __forceinline__ void kt_item(const bf16_t* src  , int dil, int cls, int m64, bf16_t* dst, int lane) {
    const int pos0 = cls * (SEQ / dil) + 64 * m64;
#pragma unroll
    for (int it = 0; it < 8; ++it) { const int k = it * 8 + (lane >> 3), c = lane & 7; const int t = cls + dil * (64 * m64 + k), pos = pos0 + k;
        const u32x4 v = *(const u32x4*)(src + (size_t)t * NP + c * 8);
        *(u32x4*)(dst + (size_t)(pos >> 4) * 1024 + (c >> 2) * 512 + (pos & 15) * 32 + (c & 3) * 8) = v; }
}
__device__ __forceinline__ void vt_phase(Frame& F, int w0, int nw) {
    const bf16_t* PROJ = (const bf16_t*)(F.ws + WS_PROJ); LAS unsigned char* wl = F.lds + F.wave * 16384;
    for (int it = w0; it < 2048; it += nw) {
        if (it < 2048) { const int w = it >> 10, r = it & 1023, bk = r >> 7, m64 = r & 127, b = bk >> 1, kvh = bk & 1;
            vt_item(PROJ + (size_t)b * SEQ * NP + (w ? C_VW : C_VS) + kvh * 64, 1, 0, m64, (bf16_t*)(F.ws + (w ? WS_VTW : WS_VTS)) + (size_t)bk * 64 * SEQ, wl, F.lane, false); }
        else { const int r0 = it - 2048, lay = r0 / 3072, r = r0 - lay * 3072, bh = r >> 7, m = r & 127, b = bh / 6, h = bh - b * 6;
            const int dil = lay == 0 ? 1 : 16; const int per = 128 / dil, cls = m / per, m64 = m - cls * per;
            vt_item(PROJ + (size_t)b * SEQ * NP + C_VA + h * 64, dil, cls, m64, (bf16_t*)(F.ws + (lay == 0 ? WS_VTA1 : WS_VTA16)) + (size_t)bh * 64 * SEQ, wl, F.lane, true);
            kt_item(PROJ + (size_t)b * SEQ * NP + C_KA + h * 64, dil, cls, m64, (bf16_t*)(F.ws + (lay == 0 ? WS_KA1 : WS_KA16)) + (size_t)bh * 64 * SEQ, F.lane); }
    }
}

constexpr int MIXL = 26624, MIXL_WAVE = 16384, MIXL_SET = 8192;
typedef short s16x4 __attribute__((ext_vector_type(4)));
template <int MODE>
__device__ __forceinline__ void mixa_item(const AttnG& G, f32x2* ML, LAS const float* TBh, LAS unsigned char* wset, int b, int h, int r16, int i0, int lane_in) {
    int lane = lane_in; asm volatile("" : "+v"(lane));
    const int i = lane & 15, kg = lane >> 4;
    constexpr int NS = MODE == 0 ? 23 : (MODE == 1 ? 13 : 5);
    constexpr int NC = MODE == 0 ? 1 : 2;
    const bf16_t* Pb = G.PROJ + (size_t)b * SEQ * NP;
    int tq[NC]; bf16x8 q[NC][2]; bf16_t* op[NC]; f32x2 mlB[NC]; u32x2 ob[NC][4]; ColState st[NC];
#pragma unroll
    for (int c = 0; c < NC; ++c) { tq[c] = MODE == 2 ? i0 + 16 * c + i : r16 + 16 * (i0 + 16 * c + i);
        const bf16_t* qp = Pb + (size_t)tq[c] * NP + C_QA + h * 64 + 8 * kg; q[c][0] = q_scaled(*(const bf16x8*)qp); q[c][1] = q_scaled(*(const bf16x8*)(qp + 32));
        op[c] = G.OMIX + (size_t)(b * SEQ + tq[c]) * D + h * 64 + 4 * kg;
        mlB[c] = (f32x2){0.f, 0.f};
#pragma unroll
        for (int d = 0; d < 4; ++d) ob[c][d] = (u32x2){0u, 0u};
        if (MODE == 2) { mlB[c] = ML[(size_t)(b * SEQ + tq[c]) * 6 + h];
#pragma unroll
            for (int d = 0; d < 4; ++d) ob[c][d] = *(const u32x2*)(op[c] + 16 * d); }
        cs_init(st[c]); }
    const int r4 = r16 & 3, c4 = r16 >> 2;
    const int rr0 = lane >> 3, pc = lane & 7;
    const unsigned kcb0 = (unsigned)(C_KA + h * 64 + ((pc ^ ((rr0 >> 1) & 7)) << 3)) * 2u, kcb1 = (unsigned)(C_KA + h * 64 + ((pc ^ (((rr0 + 8) >> 1) & 7)) << 3)) * 2u;
    const unsigned vcb0 = (unsigned)(C_VA + h * 64 + ((pc ^ (2 * ((rr0 >> 1) & 3))) << 3)) * 2u, vcb1 = (unsigned)(C_VA + h * 64 + ((pc ^ (2 * (((rr0 + 8) >> 1) & 3))) << 3)) * 2u;
    const char* Pbc = (const char*)Pb;
    const int fk = (i >> 1) & 7;
    const int kof0 = i * 128 + ((kg ^ fk) << 4), kof1 = i * 128 + (((kg + 4) ^ fk) << 4);
    const int vrow = 4 * kg + (i >> 2), fv = 2 * ((vrow >> 1) & 3);
    int vof[4];
#pragma unroll
    for (int d = 0; d < 4; ++d) vof[d] = vrow * 128 + (((2 * d + ((i & 3) >> 1)) ^ fv) << 4) + 8 * (i & 1);
    auto ks0_of = [&](int s) -> int { if (MODE == 2) return i0 - 128 + 32 * s; if (MODE == 1) return s < 5 ? i0 - 128 + 32 * s : 4 * i0 - 128 + 32 * (s - 5); return s < 5 ? i0 - 144 + 32 * s : (s < 11 ? 4 * i0 - 128 + 32 * (s - 5) : 16 * i0 - 128 + 32 * (s - 11)); };
    auto jt_of = [&](int s) -> int { if (MODE == 2) return (i + 128 - 4 * kg + TBA_P1 + TBA_O1) - 32 * s;
        if (MODE == 1) return s < 5 ? (i + 128 - 4 * kg + TBA_P16 + TBA_O16) - 32 * s : (c4 + 4 * i + 128 - 4 * kg + TBA_P4 + TBA_O4) - 32 * (s - 5);
        return s < 5 ? (i + 144 - 4 * kg + TBA_P16 + TBA_O16) - 32 * s : (s < 11 ? (c4 + 4 * i + 128 - 4 * kg + TBA_P4 + TBA_O4) - 32 * (s - 5) : (r16 + 16 * i + 128 - 4 * kg + TBA_P1 + TBA_O1) - 32 * (s - 11)); };
    auto dma = [&](int s) { const int ks0 = ks0_of(s); const int kA = ks0 < 0 ? 0 : ks0, kB = ks0 + 16 < 0 ? 0 : ks0 + 16;
        const int dil = MODE == 2 ? 1 : (s < 5 ? 16 : ((MODE == 1 || s < 11) ? 4 : 1)), off = MODE == 2 ? 0 : (s < 5 ? r16 : ((MODE == 1 || s < 11) ? r4 : 0));
        LAS unsigned char* set = wset + (s & 1) * MIXL_SET;
        const unsigned rowbytes = NP * 2u;
        const unsigned tA0 = (unsigned)(off + dil * (kA + rr0)) * rowbytes, tA1 = tA0 + (unsigned)(dil * 8) * rowbytes, tB0 = (unsigned)(off + dil * (kB + rr0)) * rowbytes, tB1 = tB0 + (unsigned)(dil * 8) * rowbytes;
        __builtin_amdgcn_global_load_lds((const unsigned*)(Pbc + tA0 + kcb0), (LAS unsigned*)(set + 0), 16, 0, 0);
        __builtin_amdgcn_global_load_lds((const unsigned*)(Pbc + tA1 + kcb1), (LAS unsigned*)(set + 1024), 16, 0, 0);
        __builtin_amdgcn_global_load_lds((const unsigned*)(Pbc + tB0 + kcb0), (LAS unsigned*)(set + 2048), 16, 0, 0);
        __builtin_amdgcn_global_load_lds((const unsigned*)(Pbc + tB1 + kcb1), (LAS unsigned*)(set + 3072), 16, 0, 0);
        __builtin_amdgcn_global_load_lds((const unsigned*)(Pbc + tA0 + vcb0), (LAS unsigned*)(set + 4096), 16, 0, 0);
        __builtin_amdgcn_global_load_lds((const unsigned*)(Pbc + tA1 + vcb1), (LAS unsigned*)(set + 5120), 16, 0, 0);
        __builtin_amdgcn_global_load_lds((const unsigned*)(Pbc + tB0 + vcb0), (LAS unsigned*)(set + 6144), 16, 0, 0);
        __builtin_amdgcn_global_load_lds((const unsigned*)(Pbc + tB1 + vcb1), (LAS unsigned*)(set + 7168), 16, 0, 0); };
    auto comp = [&](int s) { const int ks0 = ks0_of(s); const int jt = jt_of(s);
        LAS const unsigned char* set = wset + (s & 1) * MIXL_SET;
        const bf16x8 ka0 = *(LAS const bf16x8*)(set + kof0), ka1 = *(LAS const bf16x8*)(set + kof1), kb0 = *(LAS const bf16x8*)(set + 2048 + kof0), kb1 = *(LAS const bf16x8*)(set + 2048 + kof1);
        bf16x8 V[4];
#pragma unroll
        for (int d = 0; d < 4; ++d) { const s16x4 va = __builtin_amdgcn_ds_read_tr16_b64_v4i16((LAS s16x4*)(set + 4096 + vof[d])), vb = __builtin_amdgcn_ds_read_tr16_b64_v4i16((LAS s16x4*)(set + 6144 + vof[d]));
            V[d] = (bf16x8){va.x, va.y, va.z, va.w, vb.x, vb.y, vb.z, vb.w}; }
        const int cst = MODE == 2 ? 16 : (s < 5 ? 16 : 64);
        const int jA = ks0 >= 0 ? jt : TBA_P16 + 3, jB = ks0 + 16 >= 0 ? jt - 16 : TBA_P16 + 3, cA = ks0 >= 0 ? cst : 0, cB = ks0 + 16 >= 0 ? cst : 0;
        f32x4 bA[NC], bB[NC];
#pragma unroll
        for (int c = 0; c < NC; ++c)
#pragma unroll
            for (int r = 0; r < 4; ++r) { bA[c][r] = TBh[jA + c * cA - r]; bB[c][r] = TBh[jB + c * cB - r]; }
        if (MODE != 0) { asm volatile("s_waitcnt lgkmcnt(0)" ::: "memory");
            if (s + 2 < NS) dma(s + 2); }
        if (MODE == 1 && s >= 5 && (s < 7 || s >= 11)) {
            if (s < 7) step32<1>(*reinterpret_cast<ColState (*)[1]>(&st[0]), *reinterpret_cast<const bf16x8 (*)[1][2]>(&q[0]), ka0, ka1, kb0, kb1, V, [&](int, int tile, int r) -> float { return tile == 0 ? bA[0][r] : bB[0][r]; });
            else step32<1>(*reinterpret_cast<ColState (*)[1]>(&st[NC - 1]), *reinterpret_cast<const bf16x8 (*)[1][2]>(&q[NC - 1]), ka0, ka1, kb0, kb1, V, [&](int, int tile, int r) -> float { return tile == 0 ? bA[NC - 1][r] : bB[NC - 1][r]; });
        } else step32<NC>(st, q, ka0, ka1, kb0, kb1, V, [&](int c, int tile, int r) -> float { return tile == 0 ? bA[c][r] : bB[c][r]; }); };
    asm volatile("s_waitcnt vmcnt(0)" ::: "memory");
    dma(0); if (MODE != 0) dma(1);
#pragma unroll (MODE == 0 ? 1 : NS)
    for (int s = 0; s < NS; ++s) {
        if (MODE == 0) { if (s + 1 < NS) { dma(s + 1); asm volatile("s_waitcnt vmcnt(8)" ::: "memory"); } else asm volatile("s_waitcnt vmcnt(0)" ::: "memory"); }
        else { if (s + 1 < NS) asm volatile("s_waitcnt vmcnt(8)" ::: "memory"); else asm volatile("s_waitcnt vmcnt(0)" ::: "memory"); }
        comp(s);
        asm volatile("s_waitcnt lgkmcnt(0)" ::: "memory");
    }
#pragma unroll
    for (int c = 0; c < NC; ++c) {
    if (MODE != 2) { const float l = st[c].la[0], inv = 1.f / l;
#pragma unroll
        for (int d = 0; d < 4; ++d) { const f32x4 o = st[c].o[d] * inv; *(u32x2*)(op[c] + 16 * d) = (u32x2){cvtpk(o[0], o[1]), cvtpk(o[2], o[3])}; }
        if (MODE == 1 && kg == 0) ML[(size_t)(b * SEQ + tq[c]) * 6 + h] = (f32x2){st[c].m, l};
    } else {
        const float mA = st[c].m, mB = mlB[c].x, Mx = fmaxf(mA, mB);
        const float wA = ex2(mA - Mx), wB = mlB[c].y * ex2(mB - Mx), inv = 1.f / (st[c].la[0] * wA + wB);
        const float sA = wA * inv, sB = wB * inv;
#pragma unroll
        for (int d = 0; d < 4; ++d) { const f32x4 pb = {bf_lo(ob[c][d].x), bf_hi(ob[c][d].x), bf_lo(ob[c][d].y), bf_hi(ob[c][d].y)}; const f32x4 o = st[c].o[d] * sA + pb * sB;
            *(u32x2*)(op[c] + 16 * d) = (u32x2){cvtpk(o[0], o[1]), cvtpk(o[2], o[3])}; } } }
}

#if MK_PROBE == 4
#define AUX_STORE(BR, J, D, VAL) do { if (MK_PBR == (BR) && cv[J]) { const f32x4 v_ = (VAL); *(u32x2*)(AUXP + (size_t)(b * SEQ + tcol[J]) * 640 + hb * 64 + 4 * kg + 16 * (D)) = (u32x2){cvtpk(v_[0], v_[1]), cvtpk(v_[2], v_[3])}; } } while (0)
#else
#define AUX_STORE(BR, J, D, VAL) do { } while (0)
#endif
__device__ __forceinline__ void nsa_group(Frame& F, const AttnG& G, int b, int kvh, int grp) {
    int lane = F.lane; asm volatile("" : "+v"(lane));
    const int t0 = 64 * grp + 8 * F.wave;
    LAS unsigned char* wl = F.lds + ATT_WAVE + F.wave * ATT_WSZ;
    const int i = lane & 15, kg = lane >> 4, g = i % 5, i5 = i / 5, hb = kvh * 5 + g;
    const int cur = grp, bk = b * 2 + kvh;
    const bf16_t* Pb = G.PROJ + (size_t)b * SEQ * NP; const bf16_t* GTb = (const bf16_t*)(F.ws + WS_GATES) + (size_t)b * SEQ * 32;
#if MK_PROBE == 4
    bf16_t* AUXP = (bf16_t*)((unsigned char*)G.OMIX - WS_XN + WS_AUX);
#endif
    LAS const unsigned char* BKT = (LAS const unsigned char*)(F.lds + ATT_TBN) + TBN_PAD; LAS const float* BIASg = (LAS const float*)(F.lds + ATT_BIAS) + g * 33;
    auto tbg = [&](int d) -> float { return BIASg[BKT[d]]; };
    const float b31 = BIASg[31];
    LAS const float* TBWg = (LAS const float*)(F.lds + ATT_TBW) + g * TBW_SZ + TBW_PAD;
    auto tbn = [&](int d) -> float { return TBWg[d]; };
    int tcol[3]; bool cv[3]; bf16x8 q[3][2];
#pragma unroll
    for (int j = 0; j < 3; ++j) { int tql = 3 * j + i5; cv[j] = (i < 15) && (tql < 8); if (tql > 7) tql = 7; tcol[j] = t0 + tql;
        const bf16_t* qp = Pb + (size_t)tcol[j] * NP + C_QB + hb * 64 + 8 * kg; q[j][0] = q_scaled(*(const bf16x8*)qp); q[j][1] = q_scaled(*(const bf16x8*)(qp + 32)); }
    unsigned graw[3][2];
#pragma unroll
    for (int j = 0; j < 3; ++j) { const bf16_t* gp = GTb + (size_t)tcol[j] * 32 + hb * 3; graw[j][0] = (unsigned)gp[0] | ((unsigned)gp[1] << 16); graw[j][1] = (unsigned)gp[2]; }
    auto gate_of = [&](int j, int k) -> float { const float gl = k == 0 ? bf_lo(graw[j][0]) : (k == 1 ? bf_hi(graw[j][0]) : bf_lo(graw[j][1])); return 1.f / (1.f + __expf(-gl)); };
    LAS unsigned char* ring = F.lds + ATT_KVR;
    const int sr = F.tid >> 3, scc = F.tid & 7, gch = scc ^ ((sr >> 1) & 7);
    int bc = 0;
#define RING_DMA(SLOT, KP, VP, WITHV) do { LAS unsigned char* sl_ = ring + (SLOT) * KVR_SLOT + F.wave * 1024; \
        __builtin_amdgcn_global_load_lds((const unsigned*)(KP), (LAS unsigned*)sl_, 16, 0, 0); \
        if (WITHV) __builtin_amdgcn_global_load_lds((const unsigned*)(VP), (LAS unsigned*)(sl_ + KVR_VOFF), 16, 0, 0); } while (0)
    const int fsw = (i >> 1) & 7;
    const int kofs0 = i * 128 + ((kg ^ fsw) << 4), kofs1 = i * 128 + (((kg + 4) ^ fsw) << 4);
#define RING_K(SL, KF) do { _Pragma("unroll") for (int kt_ = 0; kt_ < 4; ++kt_) { KF[kt_][0] = *(LAS const bf16x8*)((SL) + 2048 * kt_ + kofs0); KF[kt_][1] = *(LAS const bf16x8*)((SL) + 2048 * kt_ + kofs1); } } while (0)
#define RING_K2(SL, HF, KF) do { _Pragma("unroll") for (int kt_ = 0; kt_ < 2; ++kt_) { KF[kt_][0] = *(LAS const bf16x8*)((SL) + 4096 * (HF) + 2048 * kt_ + kofs0); KF[kt_][1] = *(LAS const bf16x8*)((SL) + 4096 * (HF) + 2048 * kt_ + kofs1); } } while (0)
#define RING_V(SL, HF, VV) do { _Pragma("unroll") for (int d_ = 0; d_ < 4; ++d_) VV[d_] = *(LAS const bf16x8*)((SL) + KVR_VOFF + 2048 * d_ + ((HF) ? kofs1 : kofs0)); } while (0)
#define RING_V8(SL, HF, VV) do { const int ca_ = ((((4 * (HF)) + (kg >> 1)) ^ fsw) << 4) + 8 * (kg & 1), cb_ = ((((4 * (HF)) + 2 + (kg >> 1)) ^ fsw) << 4) + 8 * (kg & 1); \
        _Pragma("unroll") for (int d_ = 0; d_ < 4; ++d_) { const u32x2 va_ = *(LAS const volatile u32x2*)((SL) + KVR_VOFF + (i + 16 * d_) * KVR_VROW + ca_), vb_ = *(LAS const volatile u32x2*)((SL) + KVR_VOFF + (i + 16 * d_) * KVR_VROW + cb_); \
        u32x4 vw_ = {va_.x, va_.y, vb_.x, vb_.y}; VV[d_] = __builtin_bit_cast(bf16x8, vw_); } } while (0)
#define RING_BAR() asm volatile("s_waitcnt vmcnt(0) lgkmcnt(0)\n\ts_barrier" ::: "memory")
    auto stage_step = [&](int bcs, int p, int nb, auto ksrc, auto vsrc, bool withv) { const int n0 = 2 * p < nb ? 2 * p : nb - 1, n1 = 2 * p + 1 < nb ? 2 * p + 1 : nb - 1; const int s0 = 2 * (bcs & 1);
        RING_DMA(s0, ksrc(n0), vsrc(n0), withv); RING_DMA(s0 + 1, ksrc(n1), vsrc(n1), withv); };
    auto ring_run = [&](const int nb, auto ksrc, auto vsrc, const bool withv, auto compute, const bool pre, auto nextstage) {
        const int ns = (nb + 1) >> 1;
        if (!pre) { stage_step(bc, 0, nb, ksrc, vsrc, withv); RING_BAR(); }
#pragma unroll 1
        for (int p = 0; p < ns; ++p) {
            const int s0 = 2 * ((bc + p) & 1);
            if (p + 1 < ns) stage_step(bc + p + 1, p + 1, nb, ksrc, vsrc, withv); else nextstage(bc + ns);
            compute(2 * p, (LAS const unsigned char*)(ring + s0 * KVR_SLOT));
            if (2 * p + 1 < nb) compute(2 * p + 1, (LAS const unsigned char*)(ring + (s0 + 1) * KVR_SLOT));
            RING_BAR();
        }
        bc += ns;
    };
    const int blo = cur - 8 > 0 ? cur - 8 : 0;
    const bf16_t* kcs = G.KCMP + ((size_t)bk * 512 + sr) * 64 + gch * 8; const bf16_t* vcs = G.VCT + ((size_t)bk * 64 + sr) * 512 + gch * 8;
    const bf16_t* kws = Pb + (size_t)sr * NP + C_KW + kvh * 64 + gch * 8; const bf16_t* vws = G.VTW + ((size_t)bk * 64 + sr) * SEQ + gch * 8;
    const bf16_t* kgs = Pb + (size_t)sr * NP + C_KS + kvh * 64 + gch * 8; const bf16_t* vgs = G.VTS + ((size_t)bk * 64 + sr) * SEQ + gch * 8;
    auto kc_src = [&](int n) { return kcs + (size_t)n * 64 * 64; }; auto vc_src = [&](int n) { return vcs + n * 64; };
    auto kw_src = [&](int n) { return kws + (size_t)64 * (blo + n) * NP; }; auto vw_src = [&](int n) { return vws + 64 * (blo + n); };
    auto kg_src = [&](int n) { return kgs + (size_t)64 * n * NP; }; auto vg_src = [&](int n) { return vgs + 64 * n; };
    f32x4 out[3][4];
    {
        int NVg = (64 * grp + 63 >= 31) ? ((64 * grp + 63 - 31) >> 4) + 1 : 0; if (NVg > NCMP) NVg = NCMP;
        const int ncb = (NVg + 63) >> 6;
        const f32x4 z = {0.f, 0.f, 0.f, 0.f};
        float m1[3] = {-INFINITY, -INFINITY, -INFINITY}, l1[3] = {0.f, 0.f, 0.f};
        ring_run(ncb, kc_src, vc_src, false, [&](int cb, LAS const unsigned char* sl) {
            const bool cfar = (t0 - 31 - 16 * (64 * cb + 63)) >= 1513;
            bf16x8 kf[4][2]; RING_K(sl, kf);
#pragma unroll
            for (int j = 0; j < 3; ++j) { const float mold = (m1[j] == -INFINITY) ? 0.f : m1[j]; float x[16];
                if (cfar) { const f32x4 c4 = splat4(b31 - mold);
#pragma unroll
                    for (int kt = 0; kt < 4; ++kt) { f32x4 sc = mfma16(kf[kt][0], q[j][0], c4); sc = mfma16(kf[kt][1], q[j][1], sc);
#pragma unroll
                        for (int r = 0; r < 4; ++r) x[4 * kt + r] = sc[r]; }
                } else {
                    LAS const unsigned char* pb1 = BKT + (tcol[j] - 31 - 64 * kg - 1024 * cb - 816); const f32x4 c4 = splat4(-mold);
#pragma unroll
                    for (int kt = 0; kt < 4; ++kt) { f32x4 sc = mfma16(kf[kt][0], q[j][0], c4); sc = mfma16(kf[kt][1], q[j][1], sc);
#pragma unroll
                        for (int r = 0; r < 4; ++r) x[4 * kt + r] = sc[r] + BIASg[pb1[816 - 256 * kt - 16 * r]]; }
                }
                float mx = fmaxf(x[0], x[1]);
#pragma unroll
                for (int k = 2; k < 16; ++k) mx = fmaxf(mx, x[k]);
                const float thr = (m1[j] == -INFINITY) ? -INFINITY : RESC_THR;
                if (__builtin_expect(__any(mx > thr), 0)) { const float mn = fmaxf(m1[j], mx + mold), mref = (mn == -INFINITY) ? 0.f : mn, dm = mref - mold;
                    l1[j] *= ex2(m1[j] - mref); m1[j] = mn;
#pragma unroll
                    for (int k = 0; k < 16; ++k) x[k] -= dm; }
                float sm = 0.f;
#pragma unroll
                for (int k = 0; k < 16; ++k) sm += ex2(x[k]);
                l1[j] += sm; }
        }, false, [&](int bcn) { stage_step(bcn, 0, ncb, kc_src, vc_src, true); });
        float Mr[3], iL[3];
#pragma unroll
        for (int j = 0; j < 3; ++j) { const float Mx = kgmax(m1[j]); const float Mr_ = (Mx == -INFINITY) ? 0.f : Mx; const float L = kgsum(l1[j] * ex2(m1[j] - Mr_));
            Mr[j] = L > 0.f ? Mr_ + __builtin_amdgcn_logf(L) : INFINITY; iL[j] = 1.f; }
        ColState st[3];
#pragma unroll
        for (int j = 0; j < 3; ++j) cs_init(st[j]);
        LAS float* IOWN = (LAS float*)wl; LAS float* ICAR = (LAS float*)(wl + 4096);
        ring_run(ncb, kc_src, vc_src, true, [&](int cb, LAS const unsigned char* sl) {
            const bool cfar = (t0 - 31 - 16 * (64 * cb + 63)) >= 1513;
            const int nvw = t0 + 7 >= 31 ? ((t0 + 7 - 31) >> 4) + 1 : 0;
#pragma unroll 1
            for (int hf = 0; hf < 2; ++hf) {
                if (64 * cb + 32 * hf >= nvw) continue;
                bf16x8 kf2[2][2]; RING_K2(sl, hf, kf2);
                bf16x8 V[4]; RING_V8(sl, hf, V);
                const int kt = 4 * cb + 2 * hf;
                bf16x8 P[3];
#pragma unroll
                for (int j = 0; j < 3; ++j) { const f32x4 c4 = splat4(cfar ? b31 - Mr[j] : -Mr[j]);
                    f32x4 sA = mfma16(kf2[0][0], q[j][0], c4); sA = mfma16(kf2[0][1], q[j][1], sA); f32x4 sB = mfma16(kf2[1][0], q[j][0], c4); sB = mfma16(kf2[1][1], q[j][1], sB);
                    const int db = tcol[j] - 31 - 64 * kg - 256 * kt; float p[8];
                    if (cfar) {
#pragma unroll
                        for (int r = 0; r < 4; ++r) { p[r] = ex2(sA[r]); p[4 + r] = ex2(sB[r]); }
                    } else { LAS const unsigned char* pb2 = BKT + (db - 304);
#pragma unroll
                        for (int r = 0; r < 4; ++r) { p[r] = ex2(sA[r] + BIASg[pb2[304 - 16 * r]]); p[4 + r] = ex2(sB[r] + BIASg[pb2[48 - 16 * r]]); } }
                    const float ownA = sum5((p[0] + p[1]) + (p[2] + 0.5f * p[3])), carA = sum5(0.5f * p[3]), ownB = sum5((p[4] + p[5]) + (p[6] + 0.5f * p[7])), carB = sum5(0.5f * p[7]);
                    if (cv[j] && g == 4) { const int tql = 3 * j + i5; IOWN[tql * 128 + 4 * kt + kg] = ownA; ICAR[tql * 128 + 4 * kt + kg] = carA; IOWN[tql * 128 + 4 * kt + 4 + kg] = ownB; ICAR[tql * 128 + 4 * kt + 4 + kg] = carB; }
                    u32x4 pw = {cvtpk(p[0], p[1]), cvtpk(p[2], p[3]), cvtpk(p[4], p[5]), cvtpk(p[6], p[7])}; P[j] = __builtin_bit_cast(bf16x8, pw); }
#pragma unroll
                for (int d = 0; d < 4; ++d)
#pragma unroll
                    for (int j = 0; j < 3; ++j) st[j].o[d] = mfma16(V[d], P[j], st[j].o[d]);
            }
        }, true, [&](int bcn) { stage_step(bcn, 0, cur - blo + 1, kw_src, vw_src, true); });
#pragma unroll
        for (int j = 0; j < 3; ++j) { const float g0 = gate_of(j, 0);
#pragma unroll
            for (int d = 0; d < 4; ++d) { out[j][d] = st[j].o[d] * g0; AUX_STORE(0, j, d, out[j][d]); } }
    }
    LDS_WAIT(); asm volatile("" ::: "memory");
    unsigned selb[2];
    {
        int l2 = lane; asm volatile("" : "+v"(l2)); const int i = l2 & 15, kg = l2 >> 4;
        LAS const float* IOWN = (LAS const float*)wl; LAS const float* ICAR = (LAS const float*)(wl + 4096);
        const int ncand = cur - 2 > 0 ? cur - 2 : 0, nforced = cur == 0 ? 1 : (cur == 1 ? 2 : 3), nfree = 16 - nforced;
#pragma unroll
        for (int ps = 0; ps < 2; ++ps) { const int tql = ps * 4 + kg; int v[8]; unsigned sb = 0u;
#pragma unroll
            for (int k = 0; k < 8; ++k) { const int s = i + 16 * k; const bool forced = (s == 0) | (s == cur) | (s == cur - 1); const bool cand = (s >= 1) && (s <= cur - 2);
                if (forced && s <= cur) sb |= 1u << k;
                const float imp = cand ? IOWN[tql * 128 + s] + ICAR[tql * 128 + s - 1] : 0.f;
                v[k] = cand ? (int)((__builtin_bit_cast(unsigned, imp) & ~127u) | (unsigned)(127 - s)) : -1; }
            if (ncand <= nfree) {
#pragma unroll
                for (int k = 0; k < 8; ++k) { const int s = i + 16 * k; if ((s >= 1) && (s <= cur - 2)) sb |= 1u << k; }
            } else {
#define TK_CE(A, B) do { const int hi_ = max(v[A], v[B]), lo_ = min(v[A], v[B]); v[A] = hi_; v[B] = lo_; } while (0)
                TK_CE(0, 1); TK_CE(2, 3); TK_CE(4, 5); TK_CE(6, 7); TK_CE(0, 2); TK_CE(1, 3); TK_CE(4, 6); TK_CE(5, 7); TK_CE(1, 2); TK_CE(5, 6); TK_CE(0, 4); TK_CE(3, 7);
                TK_CE(1, 5); TK_CE(2, 6); TK_CE(1, 4); TK_CE(3, 6); TK_CE(2, 4); TK_CE(3, 5); TK_CE(3, 4);
#undef TK_CE
#pragma unroll 1
                for (int rd = 0; rd < nfree; ++rd) {
                    const int rm = rowmax16i(v[0]);
                    const bool win = v[0] == rm;
                    sb |= win ? 1u << ((127 - (rm & 127)) >> 4) : 0u;
#pragma unroll
                    for (int k = 0; k < 7; ++k) v[k] = win ? v[k + 1] : v[k];
                    v[7] = win ? -1 : v[7];
                }
            }
            selb[ps] = sb; }
    }
    LDS_WAIT(); asm volatile("" ::: "memory");
    LAS unsigned char* SELB = wl + 6144;
    SELB[(0 * 4 + kg) * 16 + i] = (unsigned char)selb[0]; SELB[(1 * 4 + kg) * 16 + i] = (unsigned char)selb[1];
    LAS unsigned short* FMC = (LAS unsigned short*)(wl + 6272);
    { LDS_WAIT(); asm volatile("" ::: "memory");
#pragma unroll
      for (int hh = 0; hh < 2; ++hh) { const int s = lane + 64 * hh; unsigned m = 0u;
#pragma unroll
          for (int tk = 0; tk < 8; ++tk) m |= (((unsigned)SELB[tk * 16 + (s & 15)] >> (s >> 4)) & 1u) << tk;

          const int dmin = t0 - 64 * s - 63, dmax = dmin + 70;
          const int bk0 = 25 + (dmin >= 332) + (dmin >= 450) + (dmin >= 609) + (dmin >= 825) + (dmin >= 1117) + (dmin >= 1513), bk1 = 25 + (dmax >= 332) + (dmax >= 450) + (dmax >= 609) + (dmax >= 825) + (dmax >= 1117) + (dmax >= 1513);
          FMC[s] = (unsigned short)(m | (unsigned)((dmin >= 246 && bk0 == bk1) ? bk0 : 255) << 8); }
      LDS_WAIT(); asm volatile("" ::: "memory"); }
#define PARK_OUT() do { _Pragma("unroll") for (int j = 0; j < 3; ++j) _Pragma("unroll") for (int d = 0; d < 4; ++d) \
        *(LAS u32x2*)(wl + ((j * 4 + d) * 64 + lane) * 8) = (u32x2){cvtpk(out[j][d][0], out[j][d][1]), cvtpk(out[j][d][2], out[j][d][3])}; } while (0)
#define UNPARK(J, D) ({ const u32x2 pk_ = *(LAS const u32x2*)(wl + (((J) * 4 + (D)) * 64 + lane) * 8); (f32x4){bf_lo(pk_.x), bf_hi(pk_.x), bf_lo(pk_.y), bf_hi(pk_.y)}; })
    PARK_OUT();
    {
        ColState sw[3];
#pragma unroll
        for (int j = 0; j < 3; ++j) cs_init(sw[j]);
        ring_run(cur - blo + 1, kw_src, vw_src, true, [&](int n_, LAS const unsigned char* sl) {
            const int blk = blo + n_;
            LAS const float* tb = (blk == cur - 8) ? (LAS const float*)(F.lds + ATT_TBWM) + g * TBWM_SZ - TBWM_LO : TBWg;
            const int hf0 = (blk == cur - 8 && F.wave >= 4) ? 1 : 0, hf1 = (blk == cur && F.wave < 4) ? 1 : 2;
#pragma unroll 1
            for (int hf = hf0; hf < hf1; ++hf) {
                bf16x8 kf2[2][2]; RING_K2(sl, hf, kf2);
                bf16x8 V[4]; RING_V(sl, hf, V);
                LAS const float* pw[3];
#pragma unroll
                for (int j = 0; j < 3; ++j) { pw[j] = tb + (tcol[j] - 64 * blk - 32 * hf - 4 * kg - 19); asm volatile("" : "+v"(pw[j])); }
                step32<3>(sw, q, kf2[0][0], kf2[0][1], kf2[1][0], kf2[1][1], V, [&](int c, int tile, int r) -> float { return pw[c][19 - 16 * tile - r]; }); }
        }, true, [&](int bcn) { stage_step(bcn, 0, cur + 1, kg_src, vg_src, true); });
#pragma unroll
        for (int j = 0; j < 3; ++j) { const float sc = gate_of(j, 2) / sw[j].la[0];
#pragma unroll
            for (int d = 0; d < 4; ++d) { AUX_STORE(2, j, d, sw[j].o[d] * sc); out[j][d] = UNPARK(j, d) + sw[j].o[d] * sc; } }
    }
    LDS_WAIT(); asm volatile("" ::: "memory");
    PARK_OUT();
    {
        ColState ss[3];
#pragma unroll
        for (int j = 0; j < 3; ++j) cs_init(ss[j]);
        unsigned fmc_next = FMC[0];
        ring_run(cur + 1, kg_src, vg_src, true, [&](int s, LAS const unsigned char* sl) {
            const unsigned fmc = __builtin_amdgcn_readfirstlane(fmc_next); fmc_next = FMC[s + 1];
            const unsigned fm = fmc & 255u;
            if (fm != 0u) {
                const int cst = (int)(fmc >> 8);
                const bool far = cst != 255;
                const float b31 = BIASg[far ? cst : 0];
                bf16x8 kf[4][2]; RING_K(sl, kf);
                auto ldv = [&](int h, bf16x8 (&VV)[4]) { RING_V(sl, h, VV); };
#pragma unroll
                for (int j = 0; j < 3; ++j) if ((fm >> (3 * j)) & 7u) {
                    const bool colok = cv[j] && ((fm >> (3 * j + i5)) & 1u);
                    f32x2 x[8];
                    const float mref = (ss[j].m == -INFINITY) ? 0.f : ss[j].m;
                    if (far) {
                        const float bc_ = colok ? b31 - mref : -INFINITY;
                        scores64<false>(x, q[j], kf, bc_, [&](int, int) -> float { return 0.f; });
                    } else {
                        LAS const unsigned char* pb = BKT + (colok ? tcol[j] - 64 * s - 4 * kg : -1) - 51;
                        scores64<true>(x, q[j], kf, -mref, [&](int tile, int r) -> float { return BIASg[pb[51 - 16 * tile - r]]; });
                    }
                    step64_tail(ss[j], x, ldv);
                }
            }
        }, true, [&](int) {});
#pragma unroll
        for (int j = 0; j < 3; ++j) { const float sc = gate_of(j, 1) / ss[j].la[0];
#pragma unroll
            for (int d = 0; d < 4; ++d) { AUX_STORE(1, j, d, ss[j].o[d] * sc); out[j][d] = UNPARK(j, d) + ss[j].o[d] * sc; } }
    }
#pragma unroll
    for (int j = 0; j < 3; ++j) if (cv[j]) { bf16_t* op = G.OMIX + (size_t)(b * SEQ + tcol[j]) * D + 384 + hb * 64 + 4 * kg;
#pragma unroll
        for (int d = 0; d < 4; ++d) *(u32x2*)(op + 16 * d) = (u32x2){cvtpk(out[j][d][0], out[j][d][1]), cvtpk(out[j][d][2], out[j][d][3])}; }
    LDS_WAIT(); asm volatile("" ::: "memory");
#undef PARK_OUT
#undef UNPARK
#undef RING_DMA
#undef RING_BAR
#undef RING_K
#undef RING_K2
#undef RING_V
#undef RING_V8
}

__device__ __forceinline__ bool mixa_dynamic(int G) { return G % 8 == 0 && G > 64; }
__device__ __forceinline__ int mixa_early(int G) { return G > 64 ? (G - 32) * NWAVES * 4 : 0; }
__device__ __forceinline__ void mixa_run(Frame& F, const AttnG& G, const unsigned* stop, unsigned stopn, bool early_static) {
    LAS const float* TBA = (LAS const float*)(F.lds + ATT_TBA); const int NGW = F.G * NWAVES, total = 4 * 6 * 512;
    LAS unsigned char* wset = F.lds + MIXL + F.wave * MIXL_WAVE; f32x2* ML = (f32x2*)(F.ws + WS_ML);
    if (mixa_dynamic(F.G)) {
        unsigned* qh = (unsigned*)(F.ws + WS_CTL) + (early_static ? CW_MIXQ : CW_MIXQ2); const int per = NGW / 8, x0 = (int)(blockIdx.x & 7);
        unsigned* qc = (unsigned*)(F.ws + WS_CTL) + CW_CVTQ;
        auto cvt_one = [&](int x) -> bool { int qi = 0;
            if (F.lane == 0) qi = (int)__hip_atomic_fetch_add(qc + 64 * x, 1u, __ATOMIC_RELAXED, __HIP_MEMORY_SCOPE_AGENT);
            qi = __builtin_amdgcn_readfirstlane(qi); if (qi >= MOE_PER_Q) return false;
            const TrDesc d = moe_trdesc(F, x * MOE_PER_Q + qi); f32x4 v[8]; tr_load(v, d, F.lane); tr_finish(v, d, (LAS float*)wset, F.lane); return true; };
        bool cvt_live = early_static && moe_cvt_late(F.G);
        for (int k = 0; k < 8; ++k) { const int x = (x0 + k) & 7;
            const int chunk = early_static ? 1 : 2;
            for (bool more = true; more; ) { int q0 = 0;
                if (F.lane == 0) q0 = (int)__hip_atomic_fetch_add(qh + 64 * x, (unsigned)chunk, __ATOMIC_RELAXED, __HIP_MEMORY_SCOPE_AGENT);
                q0 = __builtin_amdgcn_readfirstlane(q0);
                for (int u = 0; u < chunk; ++u) { const int qi = q0 + u;
                    const int it = (qi / per) * NGW + x * per + (qi % per);
                    if (it >= total / 2) { more = false; break; }
                    const int bh = it >> 8, tile = it & 255, b = bh / 6, h = bh - b * 6;
                    if (early_static) {
                        const int tw = tile & 3, tu = tile >> 2; mixa_item<1>(G, ML, TBA + h * TBA_SZ, wset, b, h, tu & 15, ((tu >> 4) * 4 + tw) * 32, F.lane);
                        if (cvt_live) { cvt_live = cvt_one(x0); if (cvt_live) cvt_live = cvt_one(x0); } }
                    else mixa_item<2>(G, ML, TBA + h * TBA_SZ, wset, b, h, 0, tile * 32, F.lane); } } }
        if (early_static && moe_cvt_late(F.G)) for (int k = 0; k < 8; ++k) { const int x = (x0 + k) & 7; while (cvt_one(x)) { } }
    } else {
        const int n1 = mixa_early(F.G);
        int it, step, end;
        if (early_static) { it = ((int)blockIdx.x - 32) * NWAVES + F.wave; step = (F.G - 32) * NWAVES; end = n1; } else { it = n1 + F.vcu * NWAVES + F.wave; step = NGW; end = total; }
        for (; it < end; it += step) { const int bh = it >> 9, tile = it & 511, b = bh / 6, h = bh - b * 6, tw = tile & 7, tu = tile >> 3, r16 = tu & 15, i0 = ((tu >> 4) * 8 + tw) * 16;
            mixa_item<0>(G, ML, TBA + h * TBA_SZ, wset, b, h, r16, i0, F.lane); }
    }
}
__device__ __forceinline__ void mixa_early_phase(Frame& F) {
    AttnG G{(const bf16_t*)(F.ws + WS_PROJ), (const bf16_t*)(F.ws + WS_KCMP), (const bf16_t*)(F.ws + WS_VCT), (const bf16_t*)(F.ws + WS_VTS), (const bf16_t*)(F.ws + WS_VTW),
            (const bf16_t*)(F.ws + WS_VTA1), (const bf16_t*)(F.ws + WS_VTA4), (const bf16_t*)(F.ws + WS_VTA16), (const bf16_t*)(F.ws + WS_KA1), (const bf16_t*)(F.ws + WS_KA4), (const bf16_t*)(F.ws + WS_KA16), (bf16_t*)(F.ws + WS_XN)};
    attn_tables_mixa(F);
    mixa_run(F, G, (const unsigned*)(F.ws + WS_CTL) + CW_CMPDONE, 32u, true);
}
__device__ __forceinline__ void attn_phase(Frame& F) {
    const int kvh = blockIdx.x & 1;
    AttnG G{(const bf16_t*)(F.ws + WS_PROJ), (const bf16_t*)(F.ws + WS_KCMP), (const bf16_t*)(F.ws + WS_VCT), (const bf16_t*)(F.ws + WS_VTS), (const bf16_t*)(F.ws + WS_VTW),
            (const bf16_t*)(F.ws + WS_VTA1), (const bf16_t*)(F.ws + WS_VTA4), (const bf16_t*)(F.ws + WS_VTA16), (const bf16_t*)(F.ws + WS_KA1), (const bf16_t*)(F.ws + WS_KA4), (const bf16_t*)(F.ws + WS_KA16), (bf16_t*)(F.ws + WS_XN)};
    attn_tables_nsa(F, kvh);
    { for (int idx = (int)(blockIdx.x >> 1); idx < 512; idx += (F.G >> 1)) { const int b = idx >> 7; int grp = idx & 127; if ((b & 1) ^ kvh) grp = 127 - grp;
          nsa_group(F, G, b, kvh, grp); } }
    __syncthreads();
    attn_tables_mixa(F);
    mixa_run(F, G, nullptr, 0u, false);
}

__device__ __forceinline__ void p7_router(Frame& F) {
    const bf16_t* h = (const bf16_t*)(F.ws + WS_HBF); const float* gffn = F.in[11];
    const bf16_t* wrh = (const bf16_t*)(F.ws + WS_WRH); const bf16_t* wrl = (const bf16_t*)(F.ws + WS_WRL);
    constexpr int WROW = 2128, WHALF = 21 * WROW;
    LAS float* LG = (LAS float*)(F.lds + 2 * WHALF + 128) + F.wave * 512;
    LAS int* CLS = (LAS int*)(F.lds + 2 * WHALF + 128 + 8 * 2048);
    for (int c = F.tid; c < 2 * 21 * 128; c += NTHR) { const int hl = c / (21 * 128), r = (c / 128) % 21, ch = c & 127;
        const u32x4 v = r < 20 ? *(const u32x4*)((hl ? wrl : wrh) + (size_t)r * 1024 + ch * 8) : (u32x4){0u, 0u, 0u, 0u};
        *(LAS u32x4*)(F.lds + hl * WHALF + r * WROW + ch * 16) = v; }
    __syncthreads();
    const int lane = F.lane, tl = lane & 15, kg = lane >> 4;
    const int row1 = tl < 4 ? 16 + tl : 20;
    const int tok0 = blockIdx.x * 128 + F.wave * 16;
    if (tok0 < M) {
        f32x4 acc0 = {0.f, 0.f, 0.f, 0.f}, acc1 = {0.f, 0.f, 0.f, 0.f}; float ss = 0.f;
        const bf16_t* hp = h + (size_t)(tok0 + tl) * D + 8 * kg;
#pragma unroll 4
        for (int ks = 0; ks < 32; ++ks) {
            const u32x4 hw = *(const u32x4*)(hp + 32 * ks); const f32x4 a0 = {bf_lo(hw.x), bf_hi(hw.x), bf_lo(hw.y), bf_hi(hw.y)}, a1 = {bf_lo(hw.z), bf_hi(hw.z), bf_lo(hw.w), bf_hi(hw.w)};
            const f32x4 g0 = *(const f32x4*)(gffn + 32 * ks + 8 * kg), g1 = *(const f32x4*)(gffn + 32 * ks + 8 * kg + 4);
            ss += (a0.x * a0.x + a0.y * a0.y) + (a0.z * a0.z + a0.w * a0.w) + (a1.x * a1.x + a1.y * a1.y) + (a1.z * a1.z + a1.w * a1.w);
            float y[8] = {a0.x * g0.x, a0.y * g0.y, a0.z * g0.z, a0.w * g0.w, a1.x * g1.x, a1.y * g1.y, a1.z * g1.z, a1.w * g1.w};
            unsigned hi[8], lo[8];
#pragma unroll
            for (int j = 0; j < 8; ++j) { hi[j] = f2bf(y[j]); lo[j] = f2bf(y[j] - __builtin_bit_cast(float, hi[j] << 16)); }
            u32x4 ah = {hi[0] | (hi[1] << 16), hi[2] | (hi[3] << 16), hi[4] | (hi[5] << 16), hi[6] | (hi[7] << 16)};
            u32x4 al = {lo[0] | (lo[1] << 16), lo[2] | (lo[3] << 16), lo[4] | (lo[5] << 16), lo[6] | (lo[7] << 16)};
            const bf16x8 Ah = __builtin_bit_cast(bf16x8, ah), Al = __builtin_bit_cast(bf16x8, al);
            const int bo = (32 * ks + 8 * kg) * 2;
            const bf16x8 Bh0 = *(LAS const bf16x8*)(F.lds + tl * WROW + bo), Bh1 = *(LAS const bf16x8*)(F.lds + row1 * WROW + bo), Bl0 = *(LAS const bf16x8*)(F.lds + WHALF + tl * WROW + bo), Bl1 = *(LAS const bf16x8*)(F.lds + WHALF + row1 * WROW + bo);
            acc0 = __builtin_amdgcn_mfma_f32_16x16x32_bf16(Ah, Bh0, acc0, 0, 0, 0); acc0 = __builtin_amdgcn_mfma_f32_16x16x32_bf16(Ah, Bl0, acc0, 0, 0, 0); acc0 = __builtin_amdgcn_mfma_f32_16x16x32_bf16(Al, Bh0, acc0, 0, 0, 0);
            acc1 = __builtin_amdgcn_mfma_f32_16x16x32_bf16(Ah, Bh1, acc1, 0, 0, 0); acc1 = __builtin_amdgcn_mfma_f32_16x16x32_bf16(Ah, Bl1, acc1, 0, 0, 0); acc1 = __builtin_amdgcn_mfma_f32_16x16x32_bf16(Al, Bh1, acc1, 0, 0, 0);
        }
        ss += __shfl_xor(ss, 16); ss += __shfl_xor(ss, 32);
        const float rstd = rsqrtf(ss * (1.f / D) + EPS);
#pragma unroll
        for (int r = 0; r < 4; ++r) { LG[(4 * kg + r) * 32 + tl] = acc0[r]; LG[(4 * kg + r) * 32 + 16 + tl] = acc1[r]; }
        LDS_WAIT(); asm volatile("" ::: "memory");
        if (lane < 16) {
            const float* brg = F.in[13]; const float* bre = F.in[15];
            float gl[4]; int gi = 0;
#pragma unroll
            for (int j = 0; j < 4; ++j) gl[j] = LG[lane * 32 + j] * rstd + brg[j];
#pragma unroll
            for (int j = 1; j < 4; ++j) if (gl[j] > gl[gi]) gi = j;
            float gden = 0.f;
#pragma unroll
            for (int j = 0; j < 4; ++j) gden += __expf(gl[j] - gl[gi]);
            const float gprob = 1.f / gden;
            float el[4];
#pragma unroll
            for (int j = 0; j < 4; ++j) el[j] = LG[lane * 32 + 4 + gi * 4 + j] * rstd + bre[gi * 4 + j];
            int i0 = 0;
#pragma unroll
            for (int j = 1; j < 4; ++j) if (el[j] > el[i0]) i0 = j;
            int i1 = (i0 == 0) ? 1 : 0;
#pragma unroll
            for (int j = 0; j < 4; ++j) if (j != i0 && j != i1 && el[j] > el[i1]) i1 = j;
            const float p0 = 1.f / (1.f + __expf(el[i1] - el[i0])), p1 = 1.f - p0;
            const int a = i0 < i1 ? i0 : i1, bb = i0 < i1 ? i1 : i0;
            const int pair = (a == 0 ? 0 : (a == 1 ? 3 : 5)) + (bb - a - 1);
            const int cls = gi * 6 + pair;
            const float ca = gprob * (i0 == a ? p0 : p1), cb = gprob * (i0 == a ? p1 : p0);
            f32x4 ri; ri.x = __builtin_bit_cast(float, cls); ri.y = rstd; ri.z = ca; ri.w = cb;
            *(f32x4*)(F.ws + WS_RINFO + (size_t)(tok0 + lane) * 16) = ri;
            CLS[F.wave * 16 + lane] = cls;
        }
    }
    __syncthreads();
    if (F.tid < NCLS) { int n = 0; if ((int)blockIdx.x * 128 < M) for (int i = 0; i < 128; ++i) n += (CLS[i] == F.tid); ((int*)(F.ws + WS_CTL) + CW_HIST)[blockIdx.x * NCLS + F.tid] = n; }
    __syncthreads();
}
__device__ __forceinline__ void p8_scatter(Frame& F) {
    moe_tables(F, true);
    LAS int* T = (LAS int*)(F.lds + MISC_OFF);
    LAS int* CLS = (LAS int*)(F.lds + 32768); LAS int* DST = (LAS int*)(F.lds + 32768 + 1024);
    int* rowtok = (int*)(F.ws + WS_ROWTOK); f32x4* rowc = (f32x4*)(F.ws + WS_ROWC);
    const int tok0 = blockIdx.x * 128;
    f32x4 ri = {0.f, 0.f, 0.f, 0.f};
    if (F.tid < 128) { ri = *(const f32x4*)(F.ws + WS_RINFO + (size_t)(tok0 + F.tid) * 16); CLS[F.tid] = __builtin_bit_cast(int, ri.x); }
    __syncthreads();
    if (F.tid < 128) { const int c = CLS[F.tid]; int rank = 0; for (int j = 0; j < F.tid; ++j) rank += (CLS[j] == c);
        const int dst = 256 * T[48 + c] + T[24 + c] + rank; DST[F.tid] = dst; rowtok[dst] = tok0 + F.tid; rowc[dst] = (f32x4){ri.z, ri.w, ri.y, 0.f}; }
    if ((int)blockIdx.x < NCLS) { const int c = blockIdx.x; const int lo = 256 * T[48 + c] + T[c], hi = 256 * T[48 + c + 1]; for (int r = lo + F.tid; r < hi; r += NTHR) { rowtok[r] = -1; rowc[r] = (f32x4){0.f, 0.f, 0.f, 0.f}; } }
}
__device__ __forceinline__ void p11_final(Frame& F) {
    const int gw = F.vcu * NWAVES + F.wave, NGW = F.G * NWAVES; const f32x4* gr = (const f32x4*)F.in[19] + F.lane; f32x4 gg[4];
#pragma unroll
    for (int j = 0; j < 4; ++j) gg[j] = gr[64 * j];
    for (int m0 = gw; m0 < M; m0 += 4 * NGW) {
        f32x4 v[4][4];
#pragma unroll
        for (int r = 0; r < 4; ++r) { const int m = m0 + r * NGW < M ? m0 + r * NGW : m0; const f32x4* xr = (const f32x4*)(F.out + (size_t)m * D) + F.lane;
#pragma unroll
            for (int j = 0; j < 4; ++j) v[r][j] = xr[64 * j]; }
#pragma unroll
        for (int r = 0; r < 4; ++r) { const int m = m0 + r * NGW; float s = 0.f;
#pragma unroll
            for (int j = 0; j < 4; ++j) s += (v[r][j].x * v[r][j].x + v[r][j].y * v[r][j].y) + (v[r][j].z * v[r][j].z + v[r][j].w * v[r][j].w);
            const float rstd = rsqrtf(wave_sum(s) * (1.f / D) + EPS);
            if (m < M) { f32x4* xr = (f32x4*)(F.out + (size_t)m * D) + F.lane;
#pragma unroll
                for (int j = 0; j < 4; ++j) xr[64 * j] = v[r][j] * rstd * gg[j]; } } }
}

constexpr int N_PHASES = 13;
__global__ void __launch_bounds__(NTHR, 2) __attribute__((target("no-packed-fp32-ops"))) mk_fwd(Args args) {
    extern __shared__ __attribute__((aligned(16))) unsigned char lds_raw[];
    Frame F;
    F.lds = (LAS unsigned char*)lds_raw; F.ws = args.ws; F.in = args.in; F.out = args.out;
    F.tid = threadIdx.x; F.lane = F.tid & 63; F.wave = __builtin_amdgcn_readfirstlane(F.tid >> 6);
    F.G = gridDim.x; { const int bx = blockIdx.x; F.vcu = (F.G % 8 == 0) ? (bx % 8) * (F.G / 8) + bx / 8 : bx; }
    volatile LAS unsigned* XBW = (volatile LAS unsigned*)(F.lds + LDS_BYTES - 16);
    if (F.tid < 4) XBW[F.tid] = 0u;
    __syncthreads();
    unsigned* ctl = (unsigned*)(F.ws + WS_CTL);
    const int lo = args.ph_lo, hi = args.ph_hi;
    XcdBarrier bar; bar.bar = ctl + CW_BAR; bar.x = 0; bar.st = XBW;
    if (hi - lo > 1) bar = xcd_barrier_post(ctl + CW_BAR, XBW);
#define IN(k) (lo <= (k) && (k) < hi)
#define SEAM(k) do { if (IN(k) && IN((k) + 1)) xcd_barrier(bar); } while (0)
    unsigned char* ws = F.ws;

    if (IN(0)) { p0_prologue(F); } SEAM(0);
    if (IN(1)) {
        SchedGrid S{(const char*)(ws + WS_XN), (const char*)(ws + WS_WIN), (size_t)256 * 2048, (size_t)256 * 2048, 10, (M / 256) * 10, F.G, F.vcu};
        EpiBf16 E{(bf16_t*)(ws + WS_PROJ), NP};
        pg8::gemm_phase(F.lds, pg8::Geo{2048u, 2048u, 128u, 128u, 16, 1 << 30}, S, E);
        p1_gates(F);
    } SEAM(1);
    if (IN(2)) {
        const bool splitk = mixa_dynamic(F.G);
        if (!splitk) vt_phase(F, (int)blockIdx.x * NWAVES + F.wave, F.G * NWAVES);
        else if ((int)blockIdx.x >= 64) vt_phase(F, ((int)blockIdx.x - 64) * NWAVES + F.wave, (F.G - 64) * NWAVES);
        __syncthreads();
        if (F.G <= 64 || (int)blockIdx.x < (splitk ? 64 : 32)) {
        if (!splitk || (blockIdx.x & 1))
        { LAS float* cbl = (LAS float*)(F.lds + MISC_OFF + 4096);
          const int kv = F.tid >> 8, j = F.tid & 255; const float* pp = (const float*)(ws + WS_CB1) + (size_t)kv * 64 * 256 + j; float s = 0.f;
#pragma unroll 16
          for (int c = 0; c < 64; ++c) s += pp[c * 256];
          cbl[F.tid] = s; __syncthreads(); }
        if (splitk) {
            SchedCmp1K S{(const bf16_t*)(ws + WS_PROJ), (const bf16_t*)(ws + WS_CW1), (int)blockIdx.x}; const pg8::Geo geo{16u * NP * 2u, 4096u, NP * 2u, 128u, 16, 1 << 30};
            unsigned* cnt = (unsigned*)(ws + WS_CTL) + CW_CPART;
            if ((blockIdx.x & 1) == 0) { EpiCmpPart E{(float*)(ws + WS_CPART), cnt}; pg8::gemm_phase(F.lds, geo, S, E); }
            else { EpiCmp1K E{(bf16_t*)(ws + WS_H1), (LAS const float*)(F.lds + MISC_OFF + 4096), (const float*)(ws + WS_CPART), cnt}; pg8::gemm_phase(F.lds, geo, S, E);
                asm volatile("s_waitcnt vmcnt(0)" ::: "memory"); __syncthreads();
                { const int L = (int)blockIdx.x >> 1; const int kv = L >> 4, kvh = (L >> 3) & 1, b = (L >> 1) & 3, nh = L & 1; const int orow = (kv * 2 + kvh) * 2048 + b * 512 + nh * 256;
                  p3_cmp2(F, (orow >> 5) + F.wave, (orow >> 5) + 8, 8); } }
        } else {
        SchedCmp1 S{(const bf16_t*)(ws + WS_PROJ), (const bf16_t*)(ws + WS_CW1), F.G, (int)blockIdx.x};
        EpiCmp1 E{(bf16_t*)(ws + WS_H1), (LAS const float*)(F.lds + MISC_OFF + 4096)};
        pg8::gemm_phase(F.lds, pg8::Geo{16u * NP * 2u, 4096u, NP * 2u, 128u, 32, 1 << 30}, S, E);
        asm volatile("s_waitcnt vmcnt(0)" ::: "memory"); __syncthreads();
        for (int L = (int)blockIdx.x; L < 32; L += F.G) { const int kv = L >> 4, kvh = (L >> 3) & 1, b = (L >> 1) & 3, nh = L & 1; const int orow = (kv * 2 + kvh) * 2048 + b * 512 + nh * 256;
            p3_cmp2(F, (orow >> 5) + F.wave, (orow >> 5) + 8, 8); }
        }
        if (F.tid == 0) __hip_atomic_fetch_add((unsigned*)(ws + WS_CTL) + CW_CMPDONE, 1u, __ATOMIC_RELAXED, __HIP_MEMORY_SCOPE_AGENT);
          if (mixa_dynamic(F.G)) { __syncthreads(); mixa_early_phase(F); }
        } else mixa_early_phase(F);
    } SEAM(2);
    if (IN(4)) { attn_phase(F); } SEAM(4);
#if MK_PROBE
    if (IN(5)) { if (MK_PROBE & 1) nv_mixer_a(F); if (MK_PROBE & 6) nv_nsa_a(F); } SEAM(5);
    if (IN(6)) { if (MK_PROBE & 6) nv_nsa_b(F); } SEAM(6);
#endif
    if (IN(7)) {
        SchedGrid S{(const char*)(ws + WS_XN), (const char*)(ws + WS_WOUT), (size_t)256 * 2048, (size_t)256 * 2048, 4, (M / 256) * 4, F.G, F.vcu};
        EpiWout E{F.in[0], (bf16_t*)(ws + WS_HBF)};
        pg8::gemm_phase(F.lds, pg8::Geo{2048u, 2048u, 128u, 128u, 16, 1 << 30}, S, E);
    } SEAM(7);
    if (IN(8)) { p7_router(F); } SEAM(8);
    if (IN(9)) { p8_scatter(F); } SEAM(9);
    if (IN(10)) {
        moe_tables(F, false);
        LAS int* T = (LAS int*)(F.lds + MISC_OFF); unsigned* ready = (unsigned*)(ws + WS_CTL) + CW_READY;
        { SchedUp S{(const char*)(ws + WS_HBF), (const char*)(ws + WS_WGU), T, F.G, F.vcu, (const int*)(ws + WS_ROWTOK)};
          EpiUp E{(bf16_t*)(ws + WS_PROJ), (const f32x4*)(ws + WS_ROWC), ready};
          pg8::gemm_phase<true>(F.lds, pg8::Geo{2048u, 2048u, 128u, 128u, 16, 1 << 30}, S, E); }
        __syncthreads();
        { const int nup = __builtin_amdgcn_readfirstlane(T[48 + NCLS]) * 8; int c = (F.vcu - nup) % F.G; if (c < 0) c += F.G;
          SchedDown S{(const char*)(ws + WS_PROJ), (const char*)(ws + WS_WD), T, F.G, c, ready};
          EpiDownNorm E{F.out, (const bf16_t*)(ws + WS_HBF), (const int*)(ws + WS_ROWTOK), F.in[19], (float*)(ws + WS_XBUF), (unsigned*)(ws + WS_CTL) + CW_PANEL, F.lds + MISC_OFF + 8192};
          pg8::gemm_phase(F.lds, pg8::Geo{2048u, 1024u, 128u, 128u, 16, 8}, S, E); }
    }
#undef IN
#undef SEAM
}

extern "C" void kernel_launch(void* const* d_in, const int* in_sizes, int n_in, void* d_out, int out_size, void* d_ws, size_t ws_size, hipStream_t stream) {
    static int grid = 0;
    if (grid == 0) {
        if (n_in != 20 || in_sizes[0] != M * D || out_size != M * D || ws_size < WS_END) { fprintf(stderr, "kernel_launch: unexpected shapes (n_in %d, in0 %d, out %d, ws %zu); nothing launched\n", n_in, n_in > 0 ? in_sizes[0] : -1, out_size, ws_size); grid = -1; return; }
        int dev = 0, cus = 0, per_cu = 0;
        if (hipGetDevice(&dev) != hipSuccess || hipDeviceGetAttribute(&cus, hipDeviceAttributeMultiprocessorCount, dev) != hipSuccess) { grid = -1; return; }
        if (hipFuncSetAttribute((const void*)mk_fwd, hipFuncAttributeMaxDynamicSharedMemorySize, LDS_BYTES) != hipSuccess) { fprintf(stderr, "kernel_launch: hipFuncSetAttribute failed\n"); grid = -1; return; }
        if (hipOccupancyMaxActiveBlocksPerMultiprocessor(&per_cu, (const void*)mk_fwd, NTHR, LDS_BYTES) != hipSuccess || per_cu < 1) fprintf(stderr, "kernel_launch: occupancy query reports %d\n", per_cu);
        (void)hipGetLastError();
        grid = cus;
        if (grid > 256) grid = 256;
    }
    if (grid < 0) return;
    (void)hipMemsetAsync((char*)d_ws + WS_CTL, 0, CTL_ZERO_BYTES, stream);
    Args a{};
    for (int i = 0; i < 20; ++i) a.in[i] = (const float*)d_in[i];
    a.out = (float*)d_out; a.ws = (unsigned char*)d_ws;
#if MK_N_LAUNCHES == 1
    a.ph_lo = 0; a.ph_hi = N_PHASES;
    hipLaunchKernelGGL(mk_fwd, dim3(grid), dim3(NTHR), LDS_BYTES, stream, a);
#else
    for (int p = 0; p < N_PHASES; ++p) { a.ph_lo = p; a.ph_hi = p + 1; hipLaunchKernelGGL(mk_fwd, dim3(grid), dim3(NTHR), LDS_BYTES, stream, a); }
#endif
}
```
